# Optimizing an MI355X kernel written in HIP

```python
import math
import jax, jax.numpy as jnp
from jax import lax
import numpy as np

D_MODEL = 1024
BATCH = 8
SEQ = 4096
DEPTH = 1

D_MIX = D_MODEL
HEAD_DIM = 64
ATTN_HEADS = 8
ATTN_WIDTH = ATTN_HEADS * HEAD_DIM
CONV_WIDTH = D_MIX - ATTN_WIDTH
CONV_GROUPS = 8
CONV_GROUP_DIM = CONV_WIDTH // CONV_GROUPS
CONV_K = 3
IDX_HEADS = 8
IDX_DIM = 64
TOPK_MAX = 256
Q_BLOCK = 128
N_BUCKETS = 32
MAX_DISTANCE = 128
N_GROUPS = 4
EXPERTS_PER_GROUP = 8
N_EXPERTS = N_GROUPS * EXPERTS_PER_GROUP
EXPERT_FF = 256
TOP_K_EXPERTS = 2
EPS = 1e-6
SPLITS = (ATTN_WIDTH, ATTN_WIDTH, ATTN_WIDTH, IDX_HEADS * IDX_DIM, IDX_DIM, IDX_HEADS,
          CONV_WIDTH, CONV_WIDTH, CONV_WIDTH)
N_IN = ATTN_WIDTH * 3 + IDX_HEADS * IDX_DIM + IDX_DIM + IDX_HEADS + CONV_WIDTH * 3

kernel_name = "hybrid_dsa_shortconv_hmoe_block"


def rmsnorm(x, g):
    xf = x.astype(jnp.float32)
    y = xf * lax.rsqrt(jnp.mean(xf * xf, axis=-1, keepdims=True) + EPS)
    return (y * g.astype(jnp.float32)).astype(x.dtype)


def t5_bucket(rel):
    max_exact = N_BUCKETS // 2
    n = jnp.maximum(rel, 0)
    nf = jnp.maximum(n, 1).astype(jnp.float32)
    large = max_exact + (jnp.log(nf / max_exact) / math.log(MAX_DISTANCE / max_exact)
                         * (N_BUCKETS - max_exact)).astype(jnp.int32)
    large = jnp.minimum(large, N_BUCKETS - 1)
    return jnp.where(n < max_exact, n, large)


def split_cols(p):
    offs = [int(o) for o in np.cumsum(np.array(SPLITS))[:-1]]
    return jnp.split(p, offs, axis=-1)


def dsa_attention(q, k, v, qi, ki, wi, rel_bias):
    B, L = q.shape[0], q.shape[1]
    topk = min(TOPK_MAX, L // 4)
    qb = min(Q_BLOCK, L)
    n_blocks = L // qb
    scale = HEAD_DIM ** -0.5
    idx_scale = (IDX_DIM ** -0.5) * (IDX_HEADS ** -0.5)
    key_pos = jnp.arange(L, dtype=jnp.int32)
    kif = ki.astype(jnp.float32)
    gather = jax.vmap(lambda arr, ids: arr[ids])

    def block(b):
        t0 = b * qb
        q_b = lax.dynamic_slice_in_dim(q, t0, qb, axis=1)
        qi_b = lax.dynamic_slice_in_dim(qi, t0, qb, axis=1).astype(jnp.float32)
        wi_b = lax.dynamic_slice_in_dim(wi, t0, qb, axis=1).astype(jnp.float32)
        q_pos = t0 + jnp.arange(qb, dtype=jnp.int32)
        dots = jnp.einsum('bqhd,bsd->bqhs', qi_b, kif)
        score = jnp.einsum('bqhs,bqh->bqs', jax.nn.relu(dots), wi_b) * idx_scale
        causal = key_pos[None, :] <= q_pos[:, None]
        score = jnp.where(causal[None], score, -jnp.inf)
        _, sel = lax.top_k(score, topk)
        k_sel = gather(k, sel)
        v_sel = gather(v, sel)
        logits = jnp.einsum('bqhd,bqkhd->bhqk', q_b, k_sel).astype(jnp.float32) * scale
        rel = q_pos[None, :, None] - sel
        bias = rel_bias[t5_bucket(rel)].astype(jnp.float32)
        logits = logits + jnp.transpose(bias, (0, 3, 1, 2))
        logits = jnp.where((rel >= 0)[:, None], logits, -jnp.inf)
        p = jax.nn.softmax(logits, axis=-1).astype(v.dtype)
        return jnp.einsum('bhqk,bqkhd->bqhd', p, v_sel)

    out = lax.map(block, jnp.arange(n_blocks, dtype=jnp.int32))
    return jnp.transpose(out, (1, 0, 2, 3, 4)).reshape(B, L, ATTN_HEADS, HEAD_DIM)


def hybrid_mixer(h, w_in, q_norm, k_norm, conv_w, attn_out_norm, conv_out_norm, w_out, rel_bias):
    B, L, _ = h.shape
    proj = jnp.einsum('btd,dn->btn', h, w_in)
    q, k, v, qi, ki, wi, gate_b, gate_c, u = split_cols(proj)
    q = rmsnorm(q.reshape(B, L, ATTN_HEADS, HEAD_DIM), q_norm)
    k = rmsnorm(k.reshape(B, L, ATTN_HEADS, HEAD_DIM), k_norm)
    v = v.reshape(B, L, ATTN_HEADS, HEAD_DIM)
    qi = qi.reshape(B, L, IDX_HEADS, IDX_DIM)
    attn = dsa_attention(q, k, v, qi, ki, wi, rel_bias)
    z = gate_c * u
    conv = lax.conv_general_dilated(
        z, conv_w[:, None, :].astype(z.dtype), window_strides=(1,),
        padding=[(CONV_K - 1, 0)], dimension_numbers=('NWC', 'WIO', 'NWC'),
        feature_group_count=CONV_WIDTH)
    y_conv = (gate_b * conv).reshape(B, L, CONV_GROUPS, CONV_GROUP_DIM)
    merged = jnp.concatenate([
        rmsnorm(attn, attn_out_norm).reshape(B, L, ATTN_WIDTH),
        rmsnorm(y_conv, conv_out_norm).reshape(B, L, CONV_WIDTH)], axis=-1)
    return jnp.einsum('btm,md->btd', merged, w_out)


def hier_moe(h, w_group_router, b_group_router, w_expert_router, b_expert_router,
             w_gate, w_up, w_down):
    B, L, D = h.shape
    xt = h.reshape(-1, D)
    g_logits = (xt @ w_group_router + b_group_router).astype(jnp.float32)
    g_prob = jax.nn.softmax(g_logits, axis=-1)
    g_sel = jnp.argmax(g_logits, axis=-1)
    p_g = jnp.take_along_axis(g_prob, g_sel[:, None], axis=1)[:, 0]
    e_logits = (xt @ w_expert_router + b_expert_router).astype(jnp.float32)
    e_logits = e_logits.reshape(-1, N_GROUPS, EXPERTS_PER_GROUP)
    e_in = jnp.take_along_axis(e_logits, g_sel[:, None, None], axis=1)[:, 0]
    e_prob = jax.nn.softmax(e_in, axis=-1)
    top_w, top_i = lax.top_k(e_prob, TOP_K_EXPERTS)
    top_w = top_w / jnp.sum(top_w, axis=-1, keepdims=True)
    w_e = jnp.einsum('nk,nke->ne', top_w, jax.nn.one_hot(top_i, EXPERTS_PER_GROUP, dtype=jnp.float32))
    combine = (jax.nn.one_hot(g_sel, N_GROUPS, dtype=jnp.float32)[:, :, None]
               * (p_g[:, None] * w_e)[:, None, :]).astype(xt.dtype)
    wg = w_gate.reshape(N_GROUPS, EXPERTS_PER_GROUP, D, EXPERT_FF)
    wu = w_up.reshape(N_GROUPS, EXPERTS_PER_GROUP, D, EXPERT_FF)
    wd = w_down.reshape(N_GROUPS, EXPERTS_PER_GROUP, EXPERT_FF, D)
    y = jnp.zeros_like(xt)
    for g in range(N_GROUPS):
        a = jnp.einsum('nd,edf->nef', xt, wg[g])
        b = jnp.einsum('nd,edf->nef', xt, wu[g])
        hid = jax.nn.silu(a) * b * combine[:, g, :, None]
        y = y + jnp.einsum('nef,efd->nd', hid, wd[g])
    return y.reshape(B, L, D)


def setup_inputs(seed: int = 0) -> dict:
    key = jax.random.key(seed)
    ks = jax.random.split(key, 24)
    f32 = jnp.float32

    def nrm(k, shape, scale):
        return jax.random.normal(k, shape, f32) * scale

    def gain(k, shape):
        return jnp.ones(shape, f32) + 0.02 * jax.random.normal(k, shape, f32)

    D, Dp = D_MODEL, DEPTH
    return {
        "x": nrm(ks[0], (BATCH, SEQ, D), 1.0),
        "c": nrm(ks[1], (BATCH, D), 1.0),
        "rel_bias": nrm(ks[2], (N_BUCKETS, ATTN_HEADS), 0.5),
        "w_ada": nrm(ks[3], (Dp, D, 6 * D), 0.5 * D ** -0.5),
        "b_ada": nrm(ks[4], (Dp, 6 * D), 0.02),
        "norm1": gain(ks[5], (Dp, D)),
        "w_in": nrm(ks[6], (Dp, D, N_IN), D ** -0.5),
        "q_norm": gain(ks[7], (Dp, HEAD_DIM)),
        "k_norm": gain(ks[8], (Dp, HEAD_DIM)),
        "conv_w": nrm(ks[9], (Dp, CONV_K, CONV_WIDTH), CONV_K ** -0.5),
        "attn_out_norm": gain(ks[10], (Dp, ATTN_HEADS, HEAD_DIM)),
        "conv_out_norm": gain(ks[11], (Dp, CONV_GROUPS, CONV_GROUP_DIM)),
        "w_out": nrm(ks[12], (Dp, D_MIX, D), D_MIX ** -0.5),
        "norm2": gain(ks[13], (Dp, D)),
        "w_group_router": nrm(ks[14], (Dp, D, N_GROUPS), D ** -0.5),
        "b_group_router": nrm(ks[15], (Dp, N_GROUPS), 0.01),
        "w_expert_router": nrm(ks[16], (Dp, D, N_EXPERTS), D ** -0.5),
        "b_expert_router": nrm(ks[17], (Dp, N_EXPERTS), 0.01),
        "w_gate": nrm(ks[18], (Dp, N_EXPERTS, D, EXPERT_FF), D ** -0.5),
        "w_up": nrm(ks[19], (Dp, N_EXPERTS, D, EXPERT_FF), D ** -0.5),
        "w_down": nrm(ks[20], (Dp, N_EXPERTS, EXPERT_FF, D), EXPERT_FF ** -0.5),
    }


def reference(x, c, rel_bias, w_ada, b_ada, norm1, w_in, q_norm, k_norm, conv_w,
              attn_out_norm, conv_out_norm, w_out, norm2, w_group_router, b_group_router,
              w_expert_router, b_expert_router, w_gate, w_up, w_down):
    c_act = jax.nn.silu(c)
    for l in range(DEPTH):
        mod = jnp.einsum('bd,dm->bm', c_act, w_ada[l]) + b_ada[l]
        shift1, scale1, gate1, shift2, scale2, gate2 = jnp.split(mod[:, None, :], 6, axis=-1)
        h = rmsnorm(x, norm1[l]) * (1 + scale1) + shift1
        mix = hybrid_mixer(h, w_in[l], q_norm[l], k_norm[l], conv_w[l], attn_out_norm[l],
                           conv_out_norm[l], w_out[l], rel_bias)
        x = x + gate1 * mix
        h2 = rmsnorm(x, norm2[l]) * (1 + scale2) + shift2
        ffn = hier_moe(h2, w_group_router[l], b_group_router[l], w_expert_router[l],
                       b_expert_router[l], w_gate[l], w_up[l], w_down[l])
        x = x + gate2 * ffn
    return x
```

```cpp
#include <hip/hip_runtime.h>
#include <hip/hip_cooperative_groups.h>
#include <cstdio>
#include <cstdint>
namespace cg = cooperative_groups;

#ifndef MK_N_LAUNCHES

#define MK_N_LAUNCHES 1
#endif

#define LAS __attribute__((address_space(3)))
#define GAS __attribute__((address_space(1)))
typedef _Float16 h16;
typedef _Float16 f16x8 __attribute__((ext_vector_type(8)));
typedef _Float16 f16x4 __attribute__((ext_vector_type(4)));
typedef _Float16 f16x2 __attribute__((ext_vector_type(2)));
typedef short s16x4 __attribute__((ext_vector_type(4)));
typedef float f32x2 __attribute__((ext_vector_type(2)));
typedef float f32x4 __attribute__((ext_vector_type(4)));
typedef float f32x16 __attribute__((ext_vector_type(16)));
typedef unsigned u32x2 __attribute__((ext_vector_type(2)));
typedef unsigned u32x4 __attribute__((ext_vector_type(4)));
typedef unsigned long long u64;

constexpr int BATCH = 8, SEQ = 4096, DM = 1024, M = BATCH * SEQ;
constexpr int NINP = 3840;
constexpr int NEXP = 32, EFF = 256;
constexpr int MAXROWS = 2 * M + NEXP * 256;
constexpr float EPS = 1e-6f;
constexpr float LOG2E = 1.4426950408889634f;
constexpr float QSCALE = 0.125f * LOG2E;
constexpr float IDX_SCALE = 0.125f * 0.35355339059327373f;
constexpr int NWAVES = 8, NTHR = 512;

constexpr size_t MiB = 1u << 20;
constexpr size_t WS_CTL = 0, CTL_ZERO_BYTES = 64 * 1024;
constexpr size_t WS_MODP = 1 * MiB;
constexpr size_t WS_MOD = 4 * MiB;
constexpr size_t WS_ROUTE = 5 * MiB;
constexpr size_t WS_ROWMAP = 6 * MiB + 512 * 1024;
constexpr size_t WS_WINT = 8 * MiB;
constexpr size_t WS_WOUTT = 16 * MiB;
constexpr size_t WS_WRL = 18 * MiB;
constexpr size_t WS_WGUT = 20 * MiB;
constexpr size_t WS_WDT = 52 * MiB;
constexpr size_t WS_H = 72 * MiB;
constexpr size_t WS_Q = 136 * MiB, WS_K = 168 * MiB, WS_V = 200 * MiB, WS_QI = 232 * MiB;
constexpr size_t WS_KI = 264 * MiB;
constexpr size_t WS_WI = 268 * MiB;
constexpr size_t WS_GB = 270 * MiB, WS_Z = 302 * MiB;
constexpr size_t WS_BM = 334 * MiB;
constexpr size_t WS_MERGED = 350 * MiB;
constexpr size_t WS_HID = 416 * MiB;
constexpr size_t WS_Y = 136 * MiB;
constexpr size_t WS_END = 456 * MiB;
static_assert(WS_Y + (size_t)MAXROWS * 1024 * 2 <= WS_Z + 32 * MiB, "Y overlay");
static_assert(WS_HID + (size_t)MAXROWS * 256 * 2 <= WS_END, "HID");
constexpr int CW_GCNT = 64;
constexpr int CW_BAR = 4096;

constexpr int LDS_BYTES = 147456;
constexpr int RING_BYTES = 131072;
constexpr int MISC_OFF = 147456 - 256;

__device__ const unsigned char T5_BKT[129] = {0, 1, 2, 3, 4, 5, 6, 7, 8, 9, 10, 11, 12, 13, 14, 15, 16, 16, 16, 17, 17, 18, 18, 18, 19, 19, 19, 20, 20, 20, 20, 21, 21, 21, 21, 22, 22, 22, 22, 22, 23, 23, 23, 23, 23, 23, 24, 24, 24, 24, 24, 24, 25, 25, 25, 25, 25, 25, 25, 26, 26, 26, 26, 26, 26, 26, 26, 27, 27, 27, 27, 27, 27, 27, 27, 27, 27, 28, 28, 28, 28, 28, 28, 28, 28, 28, 28, 29, 29, 29, 29, 29, 29, 29, 29, 29, 29, 29, 29, 30, 30, 30, 30, 30, 30, 30, 30, 30, 30, 30, 30, 30, 30, 31, 31, 31, 31, 31, 31, 31, 31, 31, 31, 31, 31, 31, 31, 31, 31};

#define LDS_WAIT() asm volatile("s_waitcnt lgkmcnt(0)" ::: "memory")
#define VM_WAIT() asm volatile("s_waitcnt vmcnt(0)" ::: "memory")
#define RLX_AGENT __ATOMIC_RELAXED, __HIP_MEMORY_SCOPE_AGENT
__device__ __forceinline__ unsigned pk2h(float lo, float hi) { f32x2 v = {lo, hi}; f16x2 h = __builtin_convertvector(v, f16x2); return __builtin_bit_cast(unsigned, h); }
__device__ __forceinline__ u32x4 pk8h(f32x4 a, f32x4 b) { u32x4 w; w.x = pk2h(a[0], a[1]); w.y = pk2h(a[2], a[3]); w.z = pk2h(b[0], b[1]); w.w = pk2h(b[2], b[3]); return w; }
__device__ __forceinline__ float wave_sum(float v) {
#pragma unroll
    for (int o = 1; o < 64; o <<= 1) v += __shfl_xor(v, o);
    return v;
}
__device__ __forceinline__ unsigned dpp_sum_u32(unsigned v) {
    v += (unsigned)__builtin_amdgcn_update_dpp(0, (int)v, 0xB1, 0xf, 0xf, false);
    v += (unsigned)__builtin_amdgcn_update_dpp(0, (int)v, 0x4E, 0xf, 0xf, false);
    v += (unsigned)__builtin_amdgcn_update_dpp(0, (int)v, 0x141, 0xf, 0xf, false);
    v += (unsigned)__builtin_amdgcn_update_dpp(0, (int)v, 0x140, 0xf, 0xf, false);
    return __builtin_amdgcn_readlane(v, 0) + __builtin_amdgcn_readlane(v, 16) + __builtin_amdgcn_readlane(v, 32) + __builtin_amdgcn_readlane(v, 48);
}
__device__ __forceinline__ float dpp_sum_f32(float v) {
    v += __builtin_bit_cast(float, __builtin_amdgcn_update_dpp(0, __builtin_bit_cast(int, v), 0xB1, 0xf, 0xf, false));
    v += __builtin_bit_cast(float, __builtin_amdgcn_update_dpp(0, __builtin_bit_cast(int, v), 0x4E, 0xf, 0xf, false));
    v += __builtin_bit_cast(float, __builtin_amdgcn_update_dpp(0, __builtin_bit_cast(int, v), 0x141, 0xf, 0xf, false));
    v += __builtin_bit_cast(float, __builtin_amdgcn_update_dpp(0, __builtin_bit_cast(int, v), 0x140, 0xf, 0xf, false));
    return __builtin_bit_cast(float, __builtin_amdgcn_readlane(__builtin_bit_cast(int, v), 0)) + __builtin_bit_cast(float, __builtin_amdgcn_readlane(__builtin_bit_cast(int, v), 16)) +
           __builtin_bit_cast(float, __builtin_amdgcn_readlane(__builtin_bit_cast(int, v), 32)) + __builtin_bit_cast(float, __builtin_amdgcn_readlane(__builtin_bit_cast(int, v), 48));
}
__device__ __forceinline__ float dpp_max_f32(float v) {
    v = fmaxf(v, __builtin_bit_cast(float, __builtin_amdgcn_update_dpp(__builtin_bit_cast(int, v), __builtin_bit_cast(int, v), 0xB1, 0xf, 0xf, false)));
    v = fmaxf(v, __builtin_bit_cast(float, __builtin_amdgcn_update_dpp(__builtin_bit_cast(int, v), __builtin_bit_cast(int, v), 0x4E, 0xf, 0xf, false)));
    v = fmaxf(v, __builtin_bit_cast(float, __builtin_amdgcn_update_dpp(__builtin_bit_cast(int, v), __builtin_bit_cast(int, v), 0x141, 0xf, 0xf, false)));
    v = fmaxf(v, __builtin_bit_cast(float, __builtin_amdgcn_update_dpp(__builtin_bit_cast(int, v), __builtin_bit_cast(int, v), 0x140, 0xf, 0xf, false)));
    float a = __builtin_bit_cast(float, __builtin_amdgcn_readlane(__builtin_bit_cast(int, v), 0)), b = __builtin_bit_cast(float, __builtin_amdgcn_readlane(__builtin_bit_cast(int, v), 16));
    float c = __builtin_bit_cast(float, __builtin_amdgcn_readlane(__builtin_bit_cast(int, v), 32)), d = __builtin_bit_cast(float, __builtin_amdgcn_readlane(__builtin_bit_cast(int, v), 48));
    return fmaxf(fmaxf(a, b), fmaxf(c, d));
}
__device__ __forceinline__ float dpp_min_f32(float v) { return -dpp_max_f32(-v); }
__device__ __forceinline__ float silu_f(float v) { return v / (1.f + __expf(-v)); }

namespace pg8 {
#define PG8_LAS __attribute__((address_space(3)))
constexpr int BM = 256, BK = 64, HALF = 128, HTB = HALF * BK * 2, STAGE_BYTES = 8 * HTB, NXCD = 8, WGM = 8;
__host__ __device__ __forceinline__ int lds_byte(int r, int c) { const int st = (r >> 4) * 2 + (c >> 5), rr = r & 15, cc = c & 31, ob = rr * 64 + cc * 2; return st * 1024 + (ob ^ (((ob >> 9) & 1) << 5)); }
__host__ __device__ __forceinline__ void stage_rc(int b, int& R, int& C) { const int st = b / 1024, sb = b % 1024, swz = sb ^ (((sb >> 9) & 1) << 5); R = (st >> 1) * 16 + swz / 64; C = (st & 1) * 32 + (swz % 64) / 2; }
__host__ __device__ __forceinline__ int perm32(int rho) { const int n = rho >> 4, i = rho & 15; return 8 * (i >> 2) + 4 * n + (i & 3); }

struct Unit { int pm, pn, eb; };
struct Gemm { const h16* A; const h16* Bt; int M, N, K; size_t bstride; const int* rowmap; };

struct StaticOrder {
    int nM, nN, nwg, G, c;
    __device__ void init(int M_, int N_, int G_, int c_) { nM = M_ / BM; nN = N_ / BM; nwg = nM * nN; G = G_; c = c_; }
    __device__ bool next(int i, Unit& u) const {
        const long L = (long)i * G + c; if (L >= nwg) return false;
        int wgid = (int)L; { const int q = nwg / NXCD, r = nwg % NXCD, xcd = wgid % NXCD, off = wgid / NXCD; wgid = (xcd < r ? xcd * (q + 1) : r * (q + 1) + (xcd - r) * q) + off; }
        const int nig = WGM * nN, gid = wgid / nig, fm = gid * WGM, gsz = (nM - fm) < WGM ? (nM - fm) : WGM;
        u.pm = fm + ((wgid % nig) % gsz); u.pn = (wgid % nig) / gsz; u.eb = 0; return true;
    }
};
struct GroupedOrder {
    const int* tile_e; int ntiles, nN, G, v;
    __device__ bool next(int i, Unit& u) const {
        const long L = (long)i * G + v; if (L >= (long)ntiles * nN) return false;
        u.pm = (int)(L / nN); u.pn = (int)(L % nN); u.eb = tile_e[u.pm]; return true;
    }
};

template <class Epi, class Sched, bool GATHER>
__device__ __forceinline__ void gemm_phase(PG8_LAS unsigned char* lds, const Gemm g, const Sched& S, const Epi& E) {
    const int tid = threadIdx.x, wid = __builtin_amdgcn_readfirstlane(tid >> 6), lane = tid & 63, wr = wid >> 2, wc = wid & 3, fr = lane & 15, fq = lane >> 4;
    int K_ = g.K; asm volatile("" : "+s"(K_));
    const int K = K_, nt = K / BK;
    unsigned voffB[2]; unsigned cC[2]; int cR[2];
    unsigned vA0[2], vA1[2];
#pragma unroll
    for (int i = 0; i < 2; ++i) { int R, C; stage_rc(tid * 16 + i * 8192, R, C); const int Rb = Epi::PERM ? ((R & ~31) + perm32(R & 31)) : R;
        cR[i] = R; cC[i] = (unsigned)C * 2u; voffB[i] = (unsigned)(Rb * K + C) * 2u; vA0[i] = (unsigned)(R * K + C) * 2u; vA1[i] = vA0[i]; }
    const size_t kstep = (size_t)(BK * 2);
    const size_t hstep = (size_t)HALF * K * 2;
    const size_t tstep = 2 * hstep;
    const unsigned ldsw = (unsigned)wid * 1024u;
    const int aoff = lds_byte(wr * 64 + fr, fq * 8), boff = lds_byte(wc * 32 + fr, fq * 8);
#define PG8_SA(b, h) (((b) * 2 + (h)) * HTB)
#define PG8_SB(b, h) ((4 + (b) * 2 + (h)) * HTB)
#define PG8_STAGE(bufoff, gbase, voff) do { _Pragma("unroll") for (int _i = 0; _i < 2; ++_i) \
        __builtin_amdgcn_global_load_lds((const unsigned*)((const char*)(gbase) + (voff)[_i]), (PG8_LAS unsigned*)(lds + (bufoff) + ldsw + _i * 8192), 16, 0, 0); } while (0)
#define PG8_LDA(dst, b, h) do { _Pragma("unroll") for (int m = 0; m < 4; ++m) _Pragma("unroll") for (int k = 0; k < 2; ++k) dst[m][k] = *(const PG8_LAS f16x8*)(lds + PG8_SA(b, h) + aoff + m * 2048 + k * 1024); } while (0)
#define PG8_LDB(dst, b, h) do { _Pragma("unroll") for (int n = 0; n < 2; ++n) _Pragma("unroll") for (int k = 0; k < 2; ++k) dst[n][k] = *(const PG8_LAS f16x8*)(lds + PG8_SB(b, h) + boff + n * 2048 + k * 1024); } while (0)
#define PG8_MMA(ai, bj, At, Bt) do { __builtin_amdgcn_s_setprio(1); _Pragma("unroll") for (int m = 0; m < 4; ++m) _Pragma("unroll") for (int n = 0; n < 2; ++n) _Pragma("unroll") for (int k = 0; k < 2; ++k) \
        acc[ai][bj][m][n] = __builtin_amdgcn_mfma_f32_16x16x32_f16(Bt[n][k], At[m][k], acc[ai][bj][m][n], 0, 0, 0); __builtin_amdgcn_s_setprio(0); } while (0)
#define PG8_WAIT_V(n) asm volatile("s_waitcnt vmcnt(" #n ")" ::: "memory")
#define PG8_WAIT_L(n) asm volatile("s_waitcnt lgkmcnt(" #n ")" ::: "memory")
#define PG8_BAR __builtin_amdgcn_s_barrier()
#define PG8_SCHED __builtin_amdgcn_sched_barrier(0)
#define PG8_ABASE(u_) (GATHER ? (const char*)g.A : (const char*)g.A + (size_t)(u_).pm * tstep)
#define PG8_AH1 (GATHER ? (size_t)0 : hstep)
#define PG8_GATHER_OFF(u_, d0, d1) do { if (GATHER) { _Pragma("unroll") for (int _i = 0; _i < 2; ++_i) { \
        int r0_ = g.rowmap[(u_).pm * BM + cR[_i]], r1_ = g.rowmap[(u_).pm * BM + HALF + cR[_i]]; r0_ = r0_ < 0 ? 0 : r0_; r1_ = r1_ < 0 ? 0 : r1_; \
        d0[_i] = (unsigned)r0_ * (unsigned)(K * 2) + cC[_i]; d1[_i] = (unsigned)r1_ * (unsigned)(K * 2) + cC[_i]; } } } while (0)
    Unit cur, nxt; int ui = 0;
    if (!S.next(0, cur)) return;
    f32x4 acc[2][2][4][2];
#pragma unroll
    for (int a = 0; a < 2; ++a)
#pragma unroll
        for (int b = 0; b < 2; ++b)
#pragma unroll
            for (int m = 0; m < 4; ++m)
#pragma unroll
                for (int n = 0; n < 2; ++n) acc[a][b][m][n] = (f32x4){0.f, 0.f, 0.f, 0.f};
    f16x8 At[4][2], B0[2][2], B1[2][2];
    PG8_GATHER_OFF(cur, vA0, vA1);
    const char* cA = PG8_ABASE(cur); const char* cB = (const char*)g.Bt + (size_t)cur.eb * g.bstride + (size_t)cur.pn * tstep;
    PG8_STAGE(PG8_SB(0, 0), cB, voffB); PG8_STAGE(PG8_SB(0, 1), cB + hstep, voffB); PG8_STAGE(PG8_SA(0, 0), cA, vA0); PG8_STAGE(PG8_SA(0, 1), cA + PG8_AH1, vA1);
    if (wr == 1) PG8_BAR;
    PG8_WAIT_V(2); PG8_BAR;
    PG8_STAGE(PG8_SB(1, 0), cB + kstep, voffB); PG8_STAGE(PG8_SA(1, 0), cA + kstep, vA0); PG8_STAGE(PG8_SB(1, 1), cB + hstep + kstep, voffB);
    PG8_WAIT_V(6); PG8_BAR;
    for (;;) {
        const bool has_next = S.next(ui + 1, nxt);
        unsigned nA0[2] = {vA0[0], vA0[1]}, nA1[2] = {vA1[0], vA1[1]};
        if (has_next) PG8_GATHER_OFF(nxt, nA0, nA1);
        const char* nA = has_next ? PG8_ABASE(nxt) : cA; const char* nB = has_next ? (const char*)g.Bt + (size_t)nxt.eb * g.bstride + (size_t)nxt.pn * tstep : cB;
        for (int t = 0; t < nt; t += 2) {
            const bool last = (t == nt - 2);
            const char* a1 = cA + (size_t)(t + 1) * kstep;
            const char* a2 = last ? nA : cA + (size_t)(t + 2) * kstep; const char* b2 = last ? nB : cB + (size_t)(t + 2) * kstep;
            const char* a3 = a2 + kstep; const char* b3 = b2 + kstep;
            unsigned w0[2], w1[2];
#pragma unroll
            for (int i = 0; i < 2; ++i) { w0[i] = last ? nA0[i] : vA0[i]; w1[i] = last ? nA1[i] : vA1[i]; }
            PG8_LDB(B0, 0, 0); PG8_LDB(B1, 0, 1); PG8_SCHED; PG8_LDA(At, 0, 0); PG8_STAGE(PG8_SA(1, 1), a1 + PG8_AH1, vA1);
            PG8_WAIT_V(8); PG8_WAIT_L(0); PG8_BAR; PG8_MMA(0, 0, At, B0); PG8_MMA(0, 1, At, B1); PG8_BAR; PG8_SCHED;
            PG8_LDA(At, 0, 1); PG8_STAGE(PG8_SB(0, 0), b2, voffB); PG8_STAGE(PG8_SB(0, 1), b2 + hstep, voffB); PG8_STAGE(PG8_SA(0, 0), a2, w0);
            PG8_WAIT_V(8); PG8_WAIT_L(0); PG8_BAR; PG8_MMA(1, 0, At, B0); PG8_MMA(1, 1, At, B1); PG8_BAR; PG8_SCHED;
            PG8_LDB(B0, 1, 0); PG8_LDB(B1, 1, 1); PG8_SCHED; PG8_LDA(At, 1, 0); PG8_STAGE(PG8_SA(0, 1), a2 + PG8_AH1, w1);
            PG8_WAIT_V(8); PG8_WAIT_L(0); PG8_BAR; PG8_MMA(0, 0, At, B0); PG8_MMA(0, 1, At, B1); PG8_BAR; PG8_SCHED;
            PG8_LDA(At, 1, 1); PG8_STAGE(PG8_SB(1, 0), b3, voffB); PG8_STAGE(PG8_SB(1, 1), b3 + hstep, voffB); PG8_STAGE(PG8_SA(1, 0), a3, w0);
            PG8_WAIT_V(8); PG8_WAIT_L(0); PG8_BAR; PG8_MMA(1, 0, At, B0); PG8_MMA(1, 1, At, B1); PG8_BAR; PG8_SCHED;
        }
        if (wr == 0) PG8_BAR;
        E(acc, cur, wr, wc, fr, fq);
        if (!has_next) break;
#pragma unroll
        for (int a = 0; a < 2; ++a)
#pragma unroll
            for (int b = 0; b < 2; ++b)
#pragma unroll
                for (int m = 0; m < 4; ++m)
#pragma unroll
                    for (int n = 0; n < 2; ++n) acc[a][b][m][n] = (f32x4){0.f, 0.f, 0.f, 0.f};
        cur = nxt; cA = nA; cB = nB; ++ui;
#pragma unroll
        for (int i = 0; i < 2; ++i) { vA0[i] = nA0[i]; vA1[i] = nA1[i]; }
        if (wr == 1) PG8_BAR;
    }
    PG8_WAIT_V(0);
    PG8_BAR;
#undef PG8_SA
#undef PG8_SB
#undef PG8_STAGE
#undef PG8_LDA
#undef PG8_LDB
#undef PG8_MMA
#undef PG8_WAIT_V
#undef PG8_WAIT_L
#undef PG8_BAR
#undef PG8_SCHED
#undef PG8_ABASE
#undef PG8_AH1
#undef PG8_GATHER_OFF
}
}

struct EpiInProj {
    static constexpr bool PERM = true;
    h16 *Q, *K, *V, *QI, *KI, *GB, *Z; float* WI; const float *qn, *kn;
    __device__ __forceinline__ void operator()(const f32x4 (&acc)[2][2][4][2], const pg8::Unit& u, int wr, int wc, int fr, int fq) const {
        const int row0 = u.pm * 256 + wr * 64 + fr; const int pn = u.pn;
        if (pn < 4) {
            const bool isq = pn < 2; const float* g = isq ? qn : kn; h16* O = isq ? Q : K; const int head = 4 * (pn & 1) + wc; const float sc = isq ? QSCALE : 1.f;
            f32x4 gv[2][2];
#pragma unroll
            for (int bj = 0; bj < 2; ++bj)
#pragma unroll
                for (int n = 0; n < 2; ++n) gv[bj][n] = *(const f32x4*)(g + 32 * bj + 8 * fq + 4 * n) * sc;
#pragma unroll
            for (int ai = 0; ai < 2; ++ai)
#pragma unroll
                for (int m = 0; m < 4; ++m) {
                    float ss = 0.f;
#pragma unroll
                    for (int bj = 0; bj < 2; ++bj)
#pragma unroll
                        for (int n = 0; n < 2; ++n) { const f32x4 v = acc[ai][bj][m][n]; ss += (v[0] * v[0] + v[1] * v[1]) + (v[2] * v[2] + v[3] * v[3]); }
                    ss += __shfl_xor(ss, 16); ss += __shfl_xor(ss, 32);
                    const float rstd = rsqrtf(ss * (1.f / 64.f) + EPS);
                    const int R = row0 + ai * 128 + m * 16;
                    if (isq) { h16* rowp = O + (size_t)R * 512 + head * 64 + 8 * fq;
#pragma unroll
                        for (int bj = 0; bj < 2; ++bj) *(u32x4*)(rowp + 32 * bj) = pk8h(acc[ai][bj][m][0] * rstd * gv[bj][0], acc[ai][bj][m][1] * rstd * gv[bj][1]); }
                    else {
                        h16* tp = O + ((size_t)((R >> 12) * 8 + head) * 64 + ((R & 4095) >> 6)) * 4096 + (R & 63) * 8;
#pragma unroll
                        for (int bj = 0; bj < 2; ++bj) *(u32x4*)(tp + (4 * bj + fq) * 512) = pk8h(acc[ai][bj][m][0] * rstd * gv[bj][0], acc[ai][bj][m][1] * rstd * gv[bj][1]); }
                }
        } else if (pn < 8) {
            h16* O = pn < 6 ? V : QI; const int head = 4 * (pn & 1) + wc;
#pragma unroll
            for (int ai = 0; ai < 2; ++ai)
#pragma unroll
                for (int m = 0; m < 4; ++m) { const int R = row0 + ai * 128 + m * 16;
                    if (pn >= 6) { h16* rowp = O + (size_t)R * 512 + head * 64 + 8 * fq;
#pragma unroll
                        for (int bj = 0; bj < 2; ++bj) *(u32x4*)(rowp + 32 * bj) = pk8h(acc[ai][bj][m][0], acc[ai][bj][m][1]); }
                    else {
                        const int kv = R & 63; h16* tp = O + ((size_t)((R >> 12) * 8 + head) * 64 + ((R & 4095) >> 6)) * 4096 + ((kv >> 4) * 64 + (kv & 15) * 4 + fq) * 8;
#pragma unroll
                        for (int bj = 0; bj < 2; ++bj) *(u32x4*)(tp + bj * 2048) = pk8h(acc[ai][bj][m][0], acc[ai][bj][m][1]); } }
        } else if (pn == 8) {
#pragma unroll
            for (int ai = 0; ai < 2; ++ai)
#pragma unroll
                for (int m = 0; m < 4; ++m) { const size_t row = (size_t)(row0 + ai * 128 + m * 16);
                    if (wc < 2) { const int R = (int)row, c8 = 4 * wc + fq;
                        *(u32x4*)(KI + ((((size_t)(R >> 12) * 128 + ((R & 4095) >> 5)) * 4 + (c8 >> 1)) * 64 + (R & 31) + 32 * (c8 & 1)) * 8) = pk8h(acc[ai][0][m][0], acc[ai][0][m][1]); }
                    else if (wc == 2 && fq == 0) { *(f32x4*)(WI + row * 8) = acc[ai][0][m][0]; *(f32x4*)(WI + row * 8 + 4) = acc[ai][0][m][1]; } }
        } else if (pn < 11) {
            const int colb = 256 * (pn - 9) + 32 * wc + 8 * fq;
#pragma unroll
            for (int ai = 0; ai < 2; ++ai)
#pragma unroll
                for (int m = 0; m < 4; ++m) { h16* rowp = GB + (size_t)(row0 + ai * 128 + m * 16) * 512 + colb;
#pragma unroll
                    for (int bj = 0; bj < 2; ++bj) *(u32x4*)(rowp + 128 * bj) = pk8h(acc[ai][bj][m][0], acc[ai][bj][m][1]); }
        } else {
            const int ch = 128 * (pn - 11) + 32 * wc + 8 * fq;
#pragma unroll
            for (int ai = 0; ai < 2; ++ai)
#pragma unroll
                for (int m = 0; m < 4; ++m) *(u32x4*)(Z + (size_t)(row0 + ai * 128 + m * 16) * 512 + ch) = pk8h(acc[ai][0][m][0] * acc[ai][1][m][0], acc[ai][0][m][1] * acc[ai][1][m][1]);
        }
    }
};
struct EpiOutProj {
    static constexpr bool PERM = false;
    const float* x; float* out; const float* mod;
    __device__ __forceinline__ void operator()(const f32x4 (&acc)[2][2][4][2], const pg8::Unit& u, int wr, int wc, int fr, int fq) const {
        const int row0 = u.pm * 256 + wr * 64 + fr; const int b = (u.pm * 256) >> 12; const int col0 = u.pn * 256 + wc * 32 + 4 * fq;
        f32x4 gv[2][2];
#pragma unroll
        for (int bj = 0; bj < 2; ++bj)
#pragma unroll
            for (int n = 0; n < 2; ++n) gv[bj][n] = *(const f32x4*)(mod + (size_t)b * 6144 + 2048 + col0 + bj * 128 + n * 16);
#pragma unroll
        for (int ai = 0; ai < 2; ++ai)
#pragma unroll
            for (int m = 0; m < 4; ++m) { const size_t off = (size_t)(row0 + ai * 128 + m * 16) * 1024 + col0;
#pragma unroll
                for (int bj = 0; bj < 2; ++bj)
#pragma unroll
                    for (int n = 0; n < 2; ++n) { const f32x4 xv = *(const f32x4*)(x + off + bj * 128 + n * 16); *(f32x4*)(out + off + bj * 128 + n * 16) = xv + gv[bj][n] * acc[ai][bj][m][n]; } }
    }
};
struct EpiMoeUp {
    static constexpr bool PERM = true;
    h16* HID;
    __device__ __forceinline__ void operator()(const f32x4 (&acc)[2][2][4][2], const pg8::Unit& u, int wr, int wc, int fr, int fq) const {
        const int row0 = u.pm * 256 + wr * 64 + fr; const int f0 = 128 * u.pn + 32 * wc + 8 * fq;
#pragma unroll
        for (int ai = 0; ai < 2; ++ai)
#pragma unroll
            for (int m = 0; m < 4; ++m) { f32x4 hv[2];
#pragma unroll
                for (int n = 0; n < 2; ++n) { const f32x4 a = acc[ai][0][m][n], bb = acc[ai][1][m][n];
#pragma unroll
                    for (int i = 0; i < 4; ++i) hv[n][i] = silu_f(a[i]) * bb[i]; }
                *(u32x4*)(HID + (size_t)(row0 + ai * 128 + m * 16) * 256 + f0) = pk8h(hv[0], hv[1]); }
    }
};
struct EpiMoeDown {
    static constexpr bool PERM = true;
    h16* Y;
    __device__ __forceinline__ void operator()(const f32x4 (&acc)[2][2][4][2], const pg8::Unit& u, int wr, int wc, int fr, int fq) const {
        const int row0 = u.pm * 256 + wr * 64 + fr; const int c0 = 256 * u.pn + 32 * wc + 8 * fq;
#pragma unroll
        for (int ai = 0; ai < 2; ++ai)
#pragma unroll
            for (int m = 0; m < 4; ++m) { h16* rowp = Y + (size_t)(row0 + ai * 128 + m * 16) * 1024 + c0;
#pragma unroll
                for (int bj = 0; bj < 2; ++bj) *(u32x4*)(rowp + 128 * bj) = pk8h(acc[ai][bj][m][0], acc[ai][bj][m][1]); }
    }
};

struct Args { const float* in[21]; float* out; unsigned char* ws; int ph_lo, ph_hi; };
struct Frame {
    LAS unsigned char* lds; unsigned char* ldsg;
    int tid, lane, wave, vcu, G;
    const float* const __attribute__((address_space(4)))* in; float* out; unsigned char* ws;
};

#define XB_TMO      128
#define XB_XCNT(j)  (256  + 64 * (j))
#define XB_XSUB(j)  (1280 + 64 * (j))
#define XB_XGEN(j)  (2304 + 64 * (j))
#define XB_TOP      3328
#define XB_TOPGEN   3392
#define XCD_BAR_WORDS 3456
#define XB_SPIN_CAP (1u << 20)
__device__ __forceinline__ unsigned xb_ld(unsigned* p)              { return __hip_atomic_load(p, __ATOMIC_RELAXED, __HIP_MEMORY_SCOPE_AGENT); }
__device__ __forceinline__ unsigned xb_add(unsigned* p, unsigned v) { return __hip_atomic_fetch_add(p, v, __ATOMIC_RELAXED, __HIP_MEMORY_SCOPE_AGENT); }
__device__ __forceinline__ unsigned xb_xcc_id() { return (unsigned)__builtin_amdgcn_s_getreg((3 << 11) | 20) & 0xFu; }
#define XB_SPIN(cond, bar) do { unsigned _sp = 0; while (cond) { __builtin_amdgcn_s_sleep(1); \
    if ((++_sp & 255u) == 0u) { if (xb_ld(&(bar)[XB_TMO])) break; if (_sp > XB_SPIN_CAP) { atomicAdd(&(bar)[XB_TMO], 1u); break; } } } } while (0)
struct XcdBarrier { unsigned* bar; unsigned x; volatile LAS unsigned* st; };
__device__ __forceinline__ XcdBarrier xcd_barrier_post(unsigned* bar, volatile LAS unsigned* st) {
    XcdBarrier b; b.bar = bar; b.x = xb_xcc_id(); b.st = st;
    if (threadIdx.x == 0) (void)xb_add(&bar[XB_XCNT(b.x)], 1u);
    return b;
}
__device__ __forceinline__ void xcd_barrier_complete(unsigned* bar, unsigned x, unsigned& nloc, unsigned& nx) {
    const unsigned G = gridDim.x * gridDim.y * gridDim.z;
    unsigned sum, cnt, mine, sp = 0u;
    for (;;) {
        sum = 0u; cnt = 0u; mine = 0u;
#pragma unroll
        for (unsigned j = 0; j < 16; ++j) { const unsigned c = xb_ld(&bar[XB_XCNT(j)]); sum += c; cnt += (c > 0u) ? 1u : 0u; mine = (j == x) ? c : mine; }
        if (sum == G) break;
        __builtin_amdgcn_s_sleep(1);
        if ((++sp & 255u) == 0u) { if (xb_ld(&bar[XB_TMO])) break; if (sp > XB_SPIN_CAP) { atomicAdd(&bar[XB_TMO], 1u); break; } }
    }
    nloc = mine > 0u ? mine : 1u; nx = cnt > 0u ? cnt : 1u;
}
__device__ __forceinline__ void xcd_barrier(const XcdBarrier& b) {
    asm volatile("s_waitcnt vmcnt(0)" ::: "memory");
    __syncthreads();
    if (threadIdx.x == 0) {
        unsigned* bar = b.bar;
        __builtin_amdgcn_s_waitcnt(0);
        unsigned nloc = b.st[0], nx = b.st[1];
        if (nloc == 0u) { xcd_barrier_complete(bar, b.x, nloc, nx); b.st[0] = nloc; b.st[1] = nx; }
        const unsigned old = xb_add(&bar[XB_XSUB(b.x)], 1u);
        const unsigned gen = old / nloc;
        if (old + 1u == (gen + 1u) * nloc) {
            __builtin_amdgcn_fence(__ATOMIC_RELEASE, "agent");
            asm volatile("s_waitcnt vmcnt(0)" ::: "memory");
            const unsigned og = xb_add(&bar[XB_TOP], 1u);
            const unsigned tg = og / nx;
            if (og + 1u == (tg + 1u) * nx) xb_add(&bar[XB_TOPGEN], 1u);
            else XB_SPIN(xb_ld(&bar[XB_TOPGEN]) == tg, bar);
            __builtin_amdgcn_fence(__ATOMIC_ACQUIRE, "agent");
            xb_add(&bar[XB_XGEN(b.x)], 1u);
            asm volatile("s_waitcnt vmcnt(0)" ::: "memory");
        } else {
            XB_SPIN(xb_ld(&bar[XB_XGEN(b.x)]) == gen, bar);
            __builtin_amdgcn_fence(__ATOMIC_ACQUIRE, "agent");
            asm volatile("s_waitcnt vmcnt(0)" ::: "memory");
        }
    }
    __syncthreads();
}

__device__ __forceinline__ void transpose_item(const float* src, int ldw, int nvalid, int k0, h16* dst, int K, LAS float* scr, int lane) {
    const int c4 = lane & 7, rsub = lane >> 3;
    f32x4 v[8];
#pragma unroll
    for (int i = 0; i < 8; ++i) v[i] = (4 * c4 < nvalid) ? *(const f32x4*)(src + (size_t)(k0 + 8 * i + rsub) * ldw + 4 * c4) : (f32x4){0.f, 0.f, 0.f, 0.f};
#pragma unroll
    for (int i = 0; i < 8; ++i) { LAS float* p = scr + (8 * i + rsub) * 33 + 4 * c4; p[0] = v[i][0]; p[1] = v[i][1]; p[2] = v[i][2]; p[3] = v[i][3]; }
    LDS_WAIT(); asm volatile("" ::: "memory");
    const int c = lane & 7;
#pragma unroll
    for (int j = 0; j < 4; ++j) { const int nn = (lane >> 3) + 8 * j; const LAS float* s = scr + (8 * c) * 33 + nn;
        u32x4 o; o.x = pk2h(s[0 * 33], s[1 * 33]); o.y = pk2h(s[2 * 33], s[3 * 33]); o.z = pk2h(s[4 * 33], s[5 * 33]); o.w = pk2h(s[6 * 33], s[7 * 33]);
        *(u32x4*)(dst + (size_t)nn * K + k0 + 8 * c) = o; }
    LDS_WAIT(); asm volatile("" ::: "memory");
}
__device__ __forceinline__ int win_group_src(int g, int& nvalid) {
    const int tile = g >> 3, p = (g & 7) * 32, bj = p >> 7, wc = (p >> 5) & 3; nvalid = 32;
    if (tile < 8) { const int seg = tile >> 1; return seg * 512 + 64 * (4 * (tile & 1) + wc) + 32 * bj; }
    if (tile == 8) { if (p < 64) return 2048 + p; if (p == 64) { nvalid = 8; return 2112; } nvalid = 0; return 0; }
    if (tile < 11) return 2120 + 256 * (tile - 9) + p;
    return (bj == 0 ? 2632 : 3144) + 128 * (tile - 11) + 32 * wc;
}
__device__ __forceinline__ void p0_prologue(Frame& F) {
    LAS float* scr = (LAS float*)(F.lds + F.wave * 16384);
    const int gw = F.vcu * NWAVES + F.wave, NGW = F.G * NWAVES;
    const float* w_in = F.in[6]; const float* w_out = F.in[12]; const float* w_gate = F.in[18]; const float* w_up = F.in[19]; const float* w_down = F.in[20];
    h16* WINT = (h16*)(F.ws + WS_WINT); h16* WOUTT = (h16*)(F.ws + WS_WOUTT); h16* WGUT = (h16*)(F.ws + WS_WGUT); h16* WDT = (h16*)(F.ws + WS_WDT);
    constexpr int I_IN = 120 * 16, I_OUT = 32 * 16, I_GU = 32 * 16 * 16, I_D = 32 * 32 * 4, I_MOD = 96 * 16;
    constexpr int NITEMS = I_IN + I_OUT + I_GU + I_D + I_MOD;
    for (int it = gw; it < NITEMS; it += NGW) {
        int r = it;
        if (r < I_MOD) {
            const int cc = r % 96, ks = r / 96; const int col = cc * 64 + F.lane, k0 = ks * 64;
            const float* c = F.in[1]; const float* w_ada = F.in[3];
            float ca[8];
#pragma unroll
            for (int b = 0; b < 8; ++b) ca[b] = silu_f(c[b * 1024 + k0 + F.lane]);
            float a[8] = {0.f, 0.f, 0.f, 0.f, 0.f, 0.f, 0.f, 0.f};
#pragma unroll 8
            for (int kk = 0; kk < 64; ++kk) { const float w = w_ada[(size_t)(k0 + kk) * 6144 + col];
#pragma unroll
                for (int b = 0; b < 8; ++b) a[b] += __builtin_bit_cast(float, __builtin_amdgcn_readlane(__builtin_bit_cast(int, ca[b]), kk)) * w; }
            float* mp = (float*)(F.ws + WS_MODP) + (size_t)ks * 8 * 6144;
#pragma unroll
            for (int b = 0; b < 8; ++b) mp[b * 6144 + col] = a[b];
            continue;
        }
        r -= I_MOD;
        if (r < I_IN) { const int g = r >> 4, kb = r & 15; int nv; const int s0 = win_group_src(g, nv); transpose_item(w_in + s0, 3656, nv, kb * 64, WINT + (size_t)g * 32 * 1024, 1024, scr, F.lane); continue; } r -= I_IN;
        if (r < I_OUT) { const int g = r >> 4, kb = r & 15; transpose_item(w_out + g * 32, 1024, 32, kb * 64, WOUTT + (size_t)g * 32 * 1024, 1024, scr, F.lane); continue; } r -= I_OUT;
        if (r < I_GU) { const int e = r >> 8, g = (r >> 4) & 15, kb = r & 15; const int p = g * 32, t2 = p >> 8, bj = (p >> 7) & 1, wc = (p >> 5) & 3; const int f = 128 * t2 + 32 * wc;
            transpose_item((bj == 0 ? w_gate : w_up) + (size_t)e * 1024 * 256 + f, 256, 32, kb * 64, WGUT + ((size_t)e * 512 + p) * 1024, 1024, scr, F.lane); continue; } r -= I_GU;
        { const int e = r >> 7, g = (r >> 2) & 31, kb = r & 3; transpose_item(w_down + (size_t)e * 256 * 1024 + g * 32, 1024, 32, kb * 64, WDT + ((size_t)e * 1024 + g * 32) * 256, 256, scr, F.lane); }
    }
    { const float* wgr = F.in[14]; const float* wer = F.in[16]; h16* WRL = (h16*)(F.ws + WS_WRL);
      for (int idx = F.vcu * NTHR + F.tid; idx < 36 * 1024; idx += F.G * NTHR) { const int o = idx >> 10, rem = idx & 1023, ln = rem >> 4, ji = rem & 15, col = 4 * ln + 256 * (ji >> 2) + (ji & 3);
          WRL[idx] = (h16)(o < 4 ? wgr[col * 4 + o] : wer[col * 32 + (o - 4)]); } }
}

__device__ __forceinline__ void p1_norm1(Frame& F) {
    const float* modp = (const float*)(F.ws + WS_MODP); float* mod = (float*)(F.ws + WS_MOD); const float* b_ada = F.in[4];
    LAS float* sh = (LAS float*)F.lds; LAS float* sc = sh + 1024;
    const int b = F.vcu >> 5;
    for (int i = F.tid; i < 2048; i += NTHR) { float s = b_ada[i];
#pragma unroll
        for (int ks = 0; ks < 16; ++ks) s += modp[((size_t)ks * 8 + b) * 6144 + i];
        sh[i] = s; }
    if (F.tid < 192) { const int idx = F.vcu * 192 + F.tid; const int bb = idx / 6144, cc = idx % 6144; float s = b_ada[cc];
#pragma unroll
        for (int ks = 0; ks < 16; ++ks) s += modp[((size_t)ks * 8 + bb) * 6144 + cc];
        mod[idx] = s; }
    __syncthreads();
    const float* x = F.in[0]; const float* g1 = F.in[5]; h16* H = (h16*)(F.ws + WS_H);
    f32x4 gg[4], s1[4], h1[4];
#pragma unroll
    for (int j = 0; j < 4; ++j) { const int col = 4 * F.lane + 256 * j; gg[j] = *(const f32x4*)(g1 + col); h1[j] = *(const LAS f32x4*)(sh + col); s1[j] = *(const LAS f32x4*)(sc + col);
        gg[j] = gg[j] * (s1[j] + 1.f); }
    f32x4 vn[4];
    { const size_t row = (size_t)F.vcu * 128 + F.wave * 16;
#pragma unroll
      for (int j = 0; j < 4; ++j) vn[j] = *(const f32x4*)(x + row * 1024 + 4 * F.lane + 256 * j); }
    for (int rr = 0; rr < 16; ++rr) {
        const size_t row = (size_t)F.vcu * 128 + F.wave * 16 + rr; const size_t rown = row + (rr < 15 ? 1 : 0);
        f32x4 v[4]; float ss = 0.f;
#pragma unroll
        for (int j = 0; j < 4; ++j) { v[j] = vn[j]; vn[j] = *(const f32x4*)(x + rown * 1024 + 4 * F.lane + 256 * j); ss += (v[j][0] * v[j][0] + v[j][1] * v[j][1]) + (v[j][2] * v[j][2] + v[j][3] * v[j][3]); }
        const float rstd = rsqrtf(dpp_sum_f32(ss) * (1.f / 1024.f) + EPS);
#pragma unroll
        for (int j = 0; j < 4; ++j) { const f32x4 o = v[j] * rstd * gg[j] + h1[j]; u32x2 w; w.x = pk2h(o[0], o[1]); w.y = pk2h(o[2], o[3]); *(u32x2*)(H + row * 1024 + 4 * F.lane + 256 * j) = w; }
    }
}

__device__ __forceinline__ void p3_conv(Frame& F) {
    const h16* Z = (const h16*)(F.ws + WS_Z); const h16* GB = (const h16*)(F.ws + WS_GB); h16* MG = (h16*)(F.ws + WS_MERGED);
    const float* cw = F.in[9]; const float* cn = F.in[11];
    const int gw = F.vcu * NWAVES + F.wave, NGW = F.G * NWAVES; const int ch = 8 * F.lane;
    float w0[8], w1[8], w2[8], gn[8];
#pragma unroll
    for (int i = 0; i < 8; ++i) { w0[i] = cw[ch + i]; w1[i] = cw[512 + ch + i]; w2[i] = cw[1024 + ch + i]; gn[i] = cn[ch + i]; }
    for (int it = gw; it < M / 32; it += NGW) {
        const int t0 = it * 32; const bool first = (t0 & (SEQ - 1)) == 0;
        f16x8 zm2 = {}, zm1 = {};
        if (!first) { zm2 = *(const f16x8*)(Z + (size_t)(t0 - 2) * 512 + ch); zm1 = *(const f16x8*)(Z + (size_t)(t0 - 1) * 512 + ch); }
        for (int tt = 0; tt < 32; ++tt) {
            const size_t t = (size_t)t0 + tt;
            const f16x8 z0 = *(const f16x8*)(Z + t * 512 + ch); const f16x8 gb = *(const f16x8*)(GB + t * 512 + ch);
            float y[8]; float ss = 0.f;
#pragma unroll
            for (int i = 0; i < 8; ++i) { y[i] = (float)gb[i] * (w0[i] * (float)zm2[i] + w1[i] * (float)zm1[i] + w2[i] * (float)z0[i]); ss += y[i] * y[i]; }
            ss += __shfl_xor(ss, 1); ss += __shfl_xor(ss, 2); ss += __shfl_xor(ss, 4);
            const float rstd = rsqrtf(ss * (1.f / 64.f) + EPS);
            u32x4 o; o.x = pk2h(y[0] * rstd * gn[0], y[1] * rstd * gn[1]); o.y = pk2h(y[2] * rstd * gn[2], y[3] * rstd * gn[3]); o.z = pk2h(y[4] * rstd * gn[4], y[5] * rstd * gn[5]); o.w = pk2h(y[6] * rstd * gn[6], y[7] * rstd * gn[7]);
            *(u32x4*)(MG + t * 1024 + 512 + ch) = o;
            zm2 = zm1; zm1 = z0;
        }
    }
}

constexpr int IX_ROW = 4352, IX_NEG = 8 * IX_ROW * 4, IX_BM = IX_NEG + 256, IX_ST = IX_BM + 4096;
__device__ __forceinline__ unsigned fkey(float f) { const unsigned u = __builtin_bit_cast(unsigned, f); return u ^ ((u >> 31) ? 0xFFFFFFFFu : 0x80000000u); }
__device__ __forceinline__ float fkey_inv(unsigned k) { const unsigned u = (k >> 31) ? (k ^ 0x80000000u) : ~k; return __builtin_bit_cast(float, u); }
__device__ __forceinline__ float probit_lo(float p) {
    if (p < 0.02425f) { const float q = sqrtf(-2.f * __logf(p));
        return (((((-7.784894002430293e-03f * q - 3.223964580411365e-01f) * q - 2.400758277161838e+00f) * q - 2.549732539343734e+00f) * q + 4.374664141464968e+00f) * q + 2.938163982698783e+00f) /
               ((((7.784695709041462e-03f * q + 3.224671290700398e-01f) * q + 2.445134137142996e+00f) * q + 3.754408661907416e+00f) * q + 1.f); }
    const float q = p - 0.5f, r = q * q;
    return (((((-3.969683028665376e+01f * r + 2.209460984245205e+02f) * r - 2.759285104469687e+02f) * r + 1.383577518672690e+02f) * r - 3.066479806614716e+01f) * r + 2.506628277459239e+00f) * q /
           (((((-5.447609879822406e+01f * r + 1.615858368580409e+02f) * r - 1.556989798598866e+02f) * r + 6.680131188771972e+01f) * r - 1.328068155288572e+01f) * r + 1.f);
}
__device__ __forceinline__ void row_sum2(float v, float& h0, float& h1) {
    v += __builtin_bit_cast(float, __builtin_amdgcn_update_dpp(0, __builtin_bit_cast(int, v), 0xB1, 0xf, 0xf, false));
    v += __builtin_bit_cast(float, __builtin_amdgcn_update_dpp(0, __builtin_bit_cast(int, v), 0x4E, 0xf, 0xf, false));
    v += __builtin_bit_cast(float, __builtin_amdgcn_update_dpp(0, __builtin_bit_cast(int, v), 0x141, 0xf, 0xf, false));
    v += __builtin_bit_cast(float, __builtin_amdgcn_update_dpp(0, __builtin_bit_cast(int, v), 0x140, 0xf, 0xf, false));
    h0 = __builtin_bit_cast(float, __builtin_amdgcn_readlane(__builtin_bit_cast(int, v), 0)) + __builtin_bit_cast(float, __builtin_amdgcn_readlane(__builtin_bit_cast(int, v), 16));
    h1 = __builtin_bit_cast(float, __builtin_amdgcn_readlane(__builtin_bit_cast(int, v), 32)) + __builtin_bit_cast(float, __builtin_amdgcn_readlane(__builtin_bit_cast(int, v), 48));
}
__device__ __forceinline__ unsigned eval_mask(const float (&v)[64], float x, unsigned& a, unsigned& b) {
    unsigned ma = 0u, mb = 0u;
#pragma unroll
    for (int i = 31; i >= 0; --i) { ma = __builtin_amdgcn_alignbit(ma, __builtin_bit_cast(unsigned, v[i] - x), 31); mb = __builtin_amdgcn_alignbit(mb, __builtin_bit_cast(unsigned, v[32 + i] - x), 31); }
    a = ma; b = mb;
    return dpp_sum_u32(64u - (unsigned)__builtin_popcount(ma) - (unsigned)__builtin_popcount(mb));
}
__device__ __forceinline__ float probit(float p) { return p > 0.5f ? -probit_lo(1.f - p) : probit_lo(p); }
__device__ __forceinline__ unsigned count_ge(const float (&v)[64], float x) {
    unsigned c = 0;
#pragma unroll
    for (int i = 0; i < 64; ++i) c += (v[i] >= x) ? 1u : 0u;
    return dpp_sum_u32(c);
}
__device__ __forceinline__ float relu_i(float x) { const int i = __builtin_bit_cast(int, x); return __builtin_bit_cast(float, i > 0 ? i : 0); }
constexpr int IX_CTR = IX_ST + 512;
__device__ __forceinline__ void p3_indexer(Frame& F) {
    const h16* QI = (const h16*)(F.ws + WS_QI); const h16* KI = (const h16*)(F.ws + WS_KI); const float* WI = (const float*)(F.ws + WS_WI); u64* BM = (u64*)(F.ws + WS_BM);
    LAS float* sc = (LAS float*)F.lds;
    LAS float* st = (LAS float*)(F.lds + IX_ST);
    LAS unsigned* ctr = (LAS unsigned*)(F.lds + IX_CTR);
    const int lane = F.lane, wid = F.wave, r32 = lane & 31, hi = lane >> 5;
    if (F.tid < 64) ((LAS float*)(F.lds + IX_NEG))[F.tid] = -__builtin_inff();
    if (F.tid < 2) ctr[F.tid] = 0u;
    __syncthreads();
    const int hq = (r32 >> 2) & 1, rr = (r32 & 3) + 4 * (r32 >> 3), jq = 2 * hq + (rr >> 3), hh = rr & 7;
    f16x8 af[2][4]; f32x4 wraw[2][2][2];
#define IX_QLOAD(u_) do { const int idx_ = (u_) * 256 + (((u_) & 1) ? (255 - F.vcu) : F.vcu); const size_t rb_ = (size_t)(idx_ & 7) * SEQ + (size_t)(idx_ >> 3) * 8; \
        _Pragma("unroll") for (int rb = 0; rb < 2; ++rb) { const h16* qp = QI + (rb_ + 4 * rb + jq) * 512 + hh * 64 + hi * 8; \
            _Pragma("unroll") for (int ks = 0; ks < 4; ++ks) af[rb][ks] = *(const f16x8*)(qp + ks * 16); \
            _Pragma("unroll") for (int j2 = 0; j2 < 2; ++j2) { const float* wp = WI + (rb_ + 4 * rb + 2 * hi + j2) * 8; wraw[rb][j2][0] = *(const f32x4*)wp; wraw[rb][j2][1] = *(const f32x4*)(wp + 4); } } } while (0)
    IX_QLOAD(0);
    for (int u = 0; u < 16; ++u) {
        const int idx = u * 256 + ((u & 1) ? (255 - F.vcu) : F.vcu);
        const int b = idx & 7, t0 = (idx >> 3) * 8;
        const size_t rowb = (size_t)b * SEQ;
        const int nj = (t0 + 8 + 63) >> 6;
        {
            float wv[2][16];
#pragma unroll
            for (int rb = 0; rb < 2; ++rb)
#pragma unroll
                for (int j2 = 0; j2 < 2; ++j2)
#pragma unroll
                    for (int i = 0; i < 4; ++i) { wv[rb][8 * j2 + i] = wraw[rb][j2][0][i] * IDX_SCALE; wv[rb][8 * j2 + 4 + i] = wraw[rb][j2][1][i] * IDX_SCALE; }
            float ssum[2][2] = {{0.f, 0.f}, {0.f, 0.f}}, ssq[2][2] = {{0.f, 0.f}, {0.f, 0.f}};
            const h16* kbase = KI + (size_t)b * (128 * 2048) + lane * 8;
#define IX_GRAB(g_) do { unsigned t_ = 0; if (lane == 0) t_ = __hip_atomic_fetch_add(ctr + (u & 1), 1u, __ATOMIC_RELAXED, __HIP_MEMORY_SCOPE_WORKGROUP); g_ = (int)__builtin_amdgcn_readfirstlane(t_); } while (0)
#define IX_LOAD(dst, g_) do { const int gg_ = (g_) < nj ? (g_) : nj - 1; _Pragma("unroll") for (int q = 0; q < 2; ++q) { const h16* kp = kbase + (size_t)(2 * gg_ + q) * 2048; \
                _Pragma("unroll") for (int ks = 0; ks < 4; ++ks) dst[q][ks] = *(const f16x8*)(kp + ks * 512); } } while (0)
#define IX_COMP(kf, g_) do { _Pragma("unroll") for (int q = 0; q < 2; ++q) { const int tile = 2 * (g_) + q; \
                const int key = tile * 32 + r32; const int pos = key + 4 * (key >> 6); const bool diag = (tile * 32 + 31 > t0); \
                f32x16 a0 = {}, a1 = {}; \
                _Pragma("unroll") for (int ks = 0; ks < 4; ++ks) a0 = __builtin_amdgcn_mfma_f32_32x32x16_f16(af[0][ks], kf[q][ks], a0, 0, 0, 0); \
                _Pragma("unroll") for (int ks = 0; ks < 4; ++ks) a1 = __builtin_amdgcn_mfma_f32_32x32x16_f16(af[1][ks], kf[q][ks], a1, 0, 0, 0); \
                _Pragma("unroll") for (int rb = 0; rb < 2; ++rb) { float s0 = 0.f, s1 = 0.f; \
                    _Pragma("unroll") for (int r = 0; r < 8; ++r) { const float d0 = rb ? a1[r] : a0[r], d1 = rb ? a1[8 + r] : a0[8 + r]; \
                        s0 = __builtin_fmaf(relu_i(d0), wv[rb][r], s0); s1 = __builtin_fmaf(relu_i(d1), wv[rb][8 + r], s1); } \
                    float z0 = s0, z1 = s1; \
                    if (diag) { const int tq = t0 + 4 * rb + 2 * hi; const bool v0 = key <= tq, v1 = key <= tq + 1; z0 = v0 ? s0 : 0.f; z1 = v1 ? s1 : 0.f; s0 = v0 ? s0 : -__builtin_inff(); s1 = v1 ? s1 : -__builtin_inff(); } \
                    ssum[rb][0] += z0; ssq[rb][0] = __builtin_fmaf(z0, z0, ssq[rb][0]); ssum[rb][1] += z1; ssq[rb][1] = __builtin_fmaf(z1, z1, ssq[rb][1]); \
                    sc[(4 * rb + 2 * hi) * IX_ROW + pos] = s0; sc[(4 * rb + 2 * hi + 1) * IX_ROW + pos] = s1; } } } while (0)
            int gc, gn;
            IX_GRAB(gc);
            if (gc < nj) {
                f16x8 kA[2][4], kB[2][4];
                IX_LOAD(kA, gc);
                for (;;) {
                    IX_GRAB(gn); IX_LOAD(kB, gn); IX_COMP(kA, gc);
                    if (gn >= nj) break;
                    gc = gn;
                    IX_GRAB(gn); IX_LOAD(kA, gn); IX_COMP(kB, gc);
                    if (gn >= nj) break;
                    gc = gn;
                }
            }
#undef IX_GRAB
#undef IX_LOAD
#undef IX_COMP
#pragma unroll
            for (int rb = 0; rb < 2; ++rb)
#pragma unroll
                for (int j2 = 0; j2 < 2; ++j2) { float s0_, s1_, q0_, q1_; row_sum2(ssum[rb][j2], s0_, s1_); row_sum2(ssq[rb][j2], q0_, q1_);
                    if (lane == 0) { LAS float* sp = st + wid * 16 + (4 * rb + j2) * 2; sp[0] = s0_; sp[1] = q0_; sp[4] = s1_; sp[5] = q1_; } }
            IX_QLOAD(u < 15 ? u + 1 : 15);
        }
        __syncthreads();
        if (F.tid == 0) ctr[(u + 1) & 1] = 0u;
        const int t = t0 + wid, n = t + 1;
        float v[64]; float ssum_ = 0.f, ssq_ = 0.f;
        if (n > 256) {
            const LAS float* cp = (lane < nj) ? (sc + wid * IX_ROW + lane * 68) : (const LAS float*)(F.lds + IX_NEG);
#pragma unroll
            for (int i = 0; i < 16; ++i) { const f32x4 x = *(const LAS f32x4*)(cp + 4 * i); v[4 * i] = x[0]; v[4 * i + 1] = x[1]; v[4 * i + 2] = x[2]; v[4 * i + 3] = x[3]; }
#pragma unroll
            for (int w = 0; w < NWAVES; ++w) { ssum_ += st[w * 16 + wid * 2]; ssq_ += st[w * 16 + wid * 2 + 1]; }
        } else {
#pragma unroll
            for (int i = 0; i < 64; ++i) v[i] = 0.f;
        }
        __syncthreads();
        unsigned mlo = 0u, mhi = 0u;
        if (n <= 256) {
            const int rem = n - 64 * lane;
            if (rem > 0) { mlo = rem >= 32 ? 0xFFFFFFFFu : ((1u << rem) - 1u); mhi = rem >= 64 ? 0xFFFFFFFFu : (rem > 32 ? ((1u << (rem - 32)) - 1u) : 0u); }
        } else {
            const float fn = (float)n, mean = ssum_ / fn; const float var = fmaxf(ssq_ / fn - mean * mean, 1e-20f), sd = sqrtf(var);
            const float zq = -probit(256.f / fn);
            const float dens = fmaxf(fn * 0.3989423f * __expf(-0.5f * zq * zq) / sd, 1e-3f);
            float xl = -3.0e38f, xh = __builtin_inff(), cl = fn, ch = 0.f; bool hasL = false, hasH = false; int side = 0, zst = 0;
            float x = mean + fminf(fmaxf(zq, -6.f), 6.f) * sd, step = 0.f; unsigned na = 0u, nb = 0u;
            float tie_v = 0.f; int tie_need = 0;
            const float DMIN = __builtin_bit_cast(float, 1u);
            int it = 0;
            for (;;) {
                ++it;
                unsigned kx = fkey(x); const unsigned kl = fkey(xl), kh = fkey(xh);
                if (!(kx > kl && kx < kh)) kx = kl + ((kh - kl) >> 1);
                x = fkey_inv(kx);
                const unsigned c = eval_mask(v, x, na, nb);
                if (c == 256u) break;
                if (c > 256u) { xl = x; cl = (float)c; hasL = true; if (side == 1) ch = 256.f + 0.5f * (ch - 256.f); side = 1; }
                else          { xh = x; ch = (float)c; hasH = true; if (side == 2) cl = 256.f + 0.5f * (cl - 256.f); side = 2; }
                const unsigned kl2 = fkey(xl), kh2 = fkey(xh);
                if (kh2 - kl2 <= 1u) {
                    const unsigned chx = eval_mask(v, xh, na, nb); tie_v = xl; tie_need = 256 - (int)chx; break; }
                if (!(hasL && hasH)) { step = (step == 0.f) ? fminf(fabsf((float)c - 256.5f) / dens * 1.25f + 0.02f * sd, 2.f * sd) : 2.f * step; x = (c > 256u) ? x + step : x - step; }
                else if (zst == 0 && it >= 2 && xl <= 0.f && xh > DMIN) { zst = 1; x = DMIN; }
                else if (zst == 1 && xh == DMIN && xl < 0.f) { zst = 2; x = 0.f; }
                else if (it >= 8 && (it & 1)) x = fkey_inv(kl2 + ((kh2 - kl2) >> 1));
                else x = xl + (xh - xl) * ((cl - 256.5f) / (cl - ch));
            }
            mlo = ~na; mhi = ~nb;
            if (tie_need > 0) {
                unsigned ce = 0;
#pragma unroll
                for (int i = 0; i < 64; ++i) ce += (v[i] == tie_v) ? 1u : 0u;
                unsigned pre = ce;
#pragma unroll
                for (int o = 1; o < 64; o <<= 1) { const unsigned y = __shfl_up(pre, o); pre += (lane >= o) ? y : 0u; }
                int allow = tie_need - (int)(pre - ce); allow = allow < 0 ? 0 : allow;
#pragma unroll
                for (int i = 0; i < 64; ++i) { if (v[i] == tie_v && allow > 0) { if (i < 32) mlo |= 1u << i; else mhi |= 1u << (i - 32); --allow; } }
            }
        }
        if (lane <= 4 * (t0 >> 8) + 3) BM[((size_t)b * 64 + lane) * 4096 + t] = ((u64)mhi << 32) | mlo;
    }
    __syncthreads();
}

constexpr int AL_K = 0, AL_V = 16384, AL_M = 32768, AL_LUT = 36864, AL_WS = 37888, AL_OST = 40960;
constexpr int OST_STRIDE = 68;
__device__ __forceinline__ int crow(int r, int hi) { return (r & 3) + 8 * (r >> 2) + 4 * hi; }
__device__ __forceinline__ void attn_unit(Frame& F, int b, int h, int qb) {
    const h16* Q = (const h16*)(F.ws + WS_Q); const h16* Kg = (const h16*)(F.ws + WS_K); const h16* Vg = (const h16*)(F.ws + WS_V); const u64* BM = (const u64*)(F.ws + WS_BM);
    h16* MG = (h16*)(F.ws + WS_MERGED);
    const int tid = F.tid, lane = F.lane, wid = F.wave, r32 = lane & 31, hi = lane >> 5;
    const size_t rowb = (size_t)b * SEQ; const int q0 = qb * 256;
    LAS unsigned char* L = F.lds;
    LAS float* lut = (LAS float*)(L + AL_LUT); LAS float* wsf = (LAS float*)(L + AL_WS) + wid * 64; LAS float* ost = (LAS float*)(L + AL_OST) + wid * (32 * OST_STRIDE);
    if (tid < 129) lut[tid] = F.in[2][T5_BKT[tid] * 8 + h] * LOG2E;
    const float cfar = F.in[2][31 * 8 + h] * LOG2E;
    const int NT = (q0 + 256) / 64;
    const h16* ksrc = Kg + (size_t)(b * 8 + h) * 64 * 4096 + wid * 512 + lane * 8;
    const h16* vsrc = Vg + (size_t)(b * 8 + h) * 64 * 4096 + wid * 512 + lane * 8;
    const u64* msrc = BM + (size_t)b * 64 * 4096 + q0 + (tid & 255);
    u32x4 kreg, vreg; u64 mreg = 0;
#define A_LOAD(t) do { kreg = *(const u32x4*)(ksrc + (size_t)(t) * 4096); vreg = *(const u32x4*)(vsrc + (size_t)(t) * 4096); if (tid < 256) mreg = msrc[(size_t)(t) * 4096]; } while (0)
#define A_STORE(buf) do { *(LAS u32x4*)(L + AL_K + (buf) * 8192 + wid * 1024 + lane * 16) = kreg; *(LAS u32x4*)(L + AL_V + (buf) * 8192 + wid * 1024 + lane * 16) = vreg; if (tid < 256) *(LAS u64*)(L + AL_M + (buf) * 2048 + tid * 8) = mreg; } while (0)
    A_LOAD(0);
    f16x8 qr[4];
    { const h16* qp = Q + (rowb + q0 + wid * 32 + r32) * 512 + h * 64 + hi * 8;
#pragma unroll
      for (int d0 = 0; d0 < 4; ++d0) qr[d0] = *(const f16x8*)(qp + d0 * 16); }
    A_STORE(0);
    __syncthreads();
    float mref = 0.f, lrun = 0.f; bool hasmass = false; f32x16 o[2]; o[0] = f32x16{}; o[1] = f32x16{};
    const int qpos = q0 + wid * 32 + r32;
    const int qmin = q0 + wid * 32;
    const int vboff = ((lane >> 4) & 1) * 32 + (lane & 3) * 8 + (4 * hi + ((lane & 15) >> 2)) * 64;
    const unsigned NEGINF = 0xFF800000u;
    for (int t = 0; t < NT; ++t) {
        const int cur = t & 1;
        if (t + 1 < NT) A_LOAD(t + 1);
        const u64 mw = *(const LAS u64*)(L + AL_M + cur * 2048 + (wid * 32 + r32) * 8);
        f16x8 kfr[8];
        { const LAS unsigned char* kb = L + AL_K + cur * 8192 + hi * 1024 + r32 * 16;
#pragma unroll
          for (int d0 = 0; d0 < 4; ++d0) { kfr[2 * d0] = *(const LAS f16x8*)(kb + d0 * 2048); kfr[2 * d0 + 1] = *(const LAS f16x8*)(kb + d0 * 2048 + 512); } }
        __builtin_amdgcn_sched_barrier(0);
        const unsigned wl = (unsigned)mw >> (4 * hi), wh = (unsigned)(mw >> 32) >> (4 * hi);
        const bool far = (qmin - (64 * t + 63)) >= 128;
        f32x16 p0, p1;
        if (far) {
            const unsigned cb = __builtin_bit_cast(unsigned, cfar - mref);
#pragma unroll
            for (int r = 0; r < 16; ++r) { const int c = (r & 3) + 8 * (r >> 2); const unsigned s0 = (unsigned)__builtin_amdgcn_sbfe((int)wl, c, 1), s1 = (unsigned)__builtin_amdgcn_sbfe((int)wh, c, 1);
                p0[r] = __builtin_bit_cast(float, (s0 & cb) | (~s0 & NEGINF)); p1[r] = __builtin_bit_cast(float, (s1 & cb) | (~s1 & NEGINF)); }
        } else {
            const int base = qpos - 64 * t - 4 * hi;
#pragma unroll
            for (int r = 0; r < 16; ++r) { const int c = (r & 3) + 8 * (r >> 2); int i0 = base - c, i1 = base - c - 32; i0 = i0 < 0 ? 0 : (i0 > 128 ? 128 : i0); i1 = i1 < 0 ? 0 : (i1 > 128 ? 128 : i1);
                const unsigned s0 = (unsigned)__builtin_amdgcn_sbfe((int)wl, c, 1), s1 = (unsigned)__builtin_amdgcn_sbfe((int)wh, c, 1);
                const unsigned c0 = __builtin_bit_cast(unsigned, lut[i0] - mref), c1 = __builtin_bit_cast(unsigned, lut[i1] - mref);
                p0[r] = __builtin_bit_cast(float, (s0 & c0) | (~s0 & NEGINF)); p1[r] = __builtin_bit_cast(float, (s1 & c1) | (~s1 & NEGINF)); }
        }
        __builtin_amdgcn_sched_barrier(0);
#pragma unroll
        for (int d0 = 0; d0 < 4; ++d0) { p0 = __builtin_amdgcn_mfma_f32_32x32x16_f16(kfr[2 * d0], qr[d0], p0, 0, 0, 0); p1 = __builtin_amdgcn_mfma_f32_32x32x16_f16(kfr[2 * d0 + 1], qr[d0], p1, 0, 0, 0); }
        s16x4 vlo[8], vhi[8];
        { LAS unsigned char* vb = L + AL_V + cur * 8192 + vboff;
#pragma unroll
          for (int i = 0; i < 8; ++i) { vlo[i] = __builtin_amdgcn_ds_read_tr16_b64_v4i16((LAS s16x4*)(vb + (i >> 2) * 4096 + (i & 3) * 1024)); vhi[i] = __builtin_amdgcn_ds_read_tr16_b64_v4i16((LAS s16x4*)(vb + (i >> 2) * 4096 + (i & 3) * 1024 + 512)); } }
        __builtin_amdgcn_sched_barrier(0);
        float rs = 0.f;
#pragma unroll
        for (int r = 0; r < 16; ++r) { p0[r] = __builtin_amdgcn_exp2f(p0[r]); p1[r] = __builtin_amdgcn_exp2f(p1[r]); rs += p0[r] + p1[r]; }
        const float pm = rs + __shfl_xor(rs, 32);
        const bool need = (pm > 256.f) || (!hasmass && pm > 0.f);
        if (__any(need)) {
            const float f = need ? 1.f / pm : 1.f;
            mref += need ? __builtin_amdgcn_logf(pm) : 0.f;
            rs *= f; lrun *= f;
#pragma unroll
            for (int r = 0; r < 16; ++r) { p0[r] *= f; p1[r] *= f; }
            if (hi == 0) wsf[r32] = f;
            LDS_WAIT();
#pragma unroll
            for (int r = 0; r < 16; ++r) { const float a = wsf[crow(r, hi)]; o[0][r] *= a; o[1][r] *= a; }
        }
        hasmass = hasmass || (pm > 0.f);
        lrun += rs;
        u32x4 pw[4];
        pw[0] = (u32x4){pk2h(p0[0], p0[1]), pk2h(p0[2], p0[3]), pk2h(p0[4], p0[5]), pk2h(p0[6], p0[7])};
        pw[1] = (u32x4){pk2h(p0[8], p0[9]), pk2h(p0[10], p0[11]), pk2h(p0[12], p0[13]), pk2h(p0[14], p0[15])};
        pw[2] = (u32x4){pk2h(p1[0], p1[1]), pk2h(p1[2], p1[3]), pk2h(p1[4], p1[5]), pk2h(p1[6], p1[7])};
        pw[3] = (u32x4){pk2h(p1[8], p1[9]), pk2h(p1[10], p1[11]), pk2h(p1[12], p1[13]), pk2h(p1[14], p1[15])};
        __builtin_amdgcn_sched_barrier(0);
#pragma unroll
        for (int d0 = 0; d0 < 2; ++d0)
#pragma unroll
            for (int ks = 0; ks < 4; ++ks) { const int i = d0 * 4 + ks;
                typedef short s16x8 __attribute__((ext_vector_type(8)));
                const s16x8 vv = {vlo[i][0], vlo[i][1], vlo[i][2], vlo[i][3], vhi[i][0], vhi[i][1], vhi[i][2], vhi[i][3]};
                o[d0] = __builtin_amdgcn_mfma_f32_32x32x16_f16(__builtin_bit_cast(f16x8, pw[ks]), __builtin_bit_cast(f16x8, vv), o[d0], 0, 0, 0); }
        if (t + 1 < NT) A_STORE(cur ^ 1);
        __syncthreads();
    }
#undef A_LOAD
#undef A_STORE
    lrun += __shfl_xor(lrun, 32);
    if (hi == 0) wsf[r32] = 1.f / lrun;
    LDS_WAIT();
#pragma unroll
    for (int r = 0; r < 16; ++r) { const float rl = wsf[crow(r, hi)]; const int qrow = crow(r, hi);
        ost[qrow * OST_STRIDE + r32] = o[0][r] * rl; ost[qrow * OST_STRIDE + 32 + r32] = o[1][r] * rl; }
    LDS_WAIT();
    { const int row = lane >> 1, hf = lane & 1; const LAS float* rp = ost + row * OST_STRIDE + hf * 32;
      f32x4 xv[8]; float ss = 0.f;
#pragma unroll
      for (int i = 0; i < 8; ++i) { xv[i] = *(const LAS f32x4*)(rp + 4 * i); ss += (xv[i][0] * xv[i][0] + xv[i][1] * xv[i][1]) + (xv[i][2] * xv[i][2] + xv[i][3] * xv[i][3]); }
      ss += __shfl_xor(ss, 1);
      const float rstd = rsqrtf(ss * (1.f / 64.f) + EPS);
      const float* gn = F.in[10] + h * 64 + hf * 32;
      h16* op = MG + (rowb + q0 + wid * 32 + row) * 1024 + h * 64 + hf * 32;
#pragma unroll
      for (int i = 0; i < 4; ++i) { const f32x4 g0 = *(const f32x4*)(gn + 8 * i), g1 = *(const f32x4*)(gn + 8 * i + 4);
          *(u32x4*)(op + 8 * i) = pk8h(xv[2 * i] * rstd * g0, xv[2 * i + 1] * rstd * g1); } }
    __syncthreads();
}
__device__ __forceinline__ void p4_attention(Frame& F) {
    const int bh = F.vcu >> 2, c = F.vcu & 3;
    for (int i = 0; i < 4; ++i) { const int qb = (i == 0) ? 2 * c : (i == 1) ? 15 - 2 * c : (i == 2) ? 2 * c + 1 : 14 - 2 * c; attn_unit(F, bh >> 3, bh & 7, qb); }
}

__device__ __forceinline__ void p6_norm2_route(Frame& F) {
    const float* mod = (const float*)(F.ws + WS_MOD); const float* g2 = F.in[13]; h16* H2 = (h16*)(F.ws + WS_H); const float* x1 = F.out;
    const h16* WRLg = (const h16*)(F.ws + WS_WRL);
    LAS h16* wrl = (LAS h16*)F.lds;
    LAS unsigned* lcnt = (LAS unsigned*)(F.lds + 73728);
    LAS unsigned* lbase = lcnt + 32;
    LAS unsigned* rinfo = (LAS unsigned*)(F.lds + 73728 + 256);
    for (int i = F.tid; i < 36 * 1024 / 8; i += NTHR) *(LAS u32x4*)(wrl + i * 8) = *(const u32x4*)(WRLg + i * 8);
    if (F.tid < 32) lcnt[F.tid] = 0u;
    __syncthreads();
    const int b = F.vcu >> 5;
    const float* bgr = F.in[15]; const float* ber = F.in[17];
    f32x4 gg[4], hh[4];
#pragma unroll
    for (int j = 0; j < 4; ++j) { const int col = 4 * F.lane + 256 * j; gg[j] = *(const f32x4*)(g2 + col) * (*(const f32x4*)(mod + (size_t)b * 6144 + 4096 + col) + 1.f); hh[j] = *(const f32x4*)(mod + (size_t)b * 6144 + 3072 + col); }
    f32x4 vn[4];
    { const size_t row = (size_t)F.vcu * 128 + F.wave * 16;
#pragma unroll
      for (int j = 0; j < 4; ++j) vn[j] = *(const f32x4*)(x1 + row * 1024 + 4 * F.lane + 256 * j); }
    for (int rr = 0; rr < 16; ++rr) {
        const int lrow = F.wave * 16 + rr; const size_t row = (size_t)F.vcu * 128 + lrow; const size_t rown = row + (rr < 15 ? 1 : 0);
        f32x4 v[4]; float ss = 0.f;
#pragma unroll
        for (int j = 0; j < 4; ++j) { v[j] = vn[j]; vn[j] = *(const f32x4*)(x1 + rown * 1024 + 4 * F.lane + 256 * j); ss += (v[j][0] * v[j][0] + v[j][1] * v[j][1]) + (v[j][2] * v[j][2] + v[j][3] * v[j][3]); }
        const float rstd = rsqrtf(dpp_sum_f32(ss) * (1.f / 1024.f) + EPS);
#pragma unroll
        for (int j = 0; j < 4; ++j) { v[j] = v[j] * rstd * gg[j] + hh[j]; u32x2 w; w.x = pk2h(v[j][0], v[j][1]); w.y = pk2h(v[j][2], v[j][3]); *(u32x2*)(H2 + row * 1024 + 4 * F.lane + 256 * j) = w; }
        float lg[4];
#pragma unroll
        for (int o = 0; o < 4; ++o) { const f16x8 wa = *(const LAS f16x8*)(wrl + (o * 64 + F.lane) * 16), wb = *(const LAS f16x8*)(wrl + (o * 64 + F.lane) * 16 + 8);
            float s = 0.f;
#pragma unroll
            for (int i = 0; i < 4; ++i) { s += v[0][i] * (float)wa[i]; s += v[1][i] * (float)wa[4 + i]; s += v[2][i] * (float)wb[i]; s += v[3][i] * (float)wb[4 + i]; }
            lg[o] = dpp_sum_f32(s) + bgr[o]; }
        int gs = 0; float gm = lg[0];
#pragma unroll
        for (int g = 1; g < 4; ++g) if (lg[g] > gm) { gm = lg[g]; gs = g; }
        float gden = 0.f;
#pragma unroll
        for (int g = 0; g < 4; ++g) gden += __expf(lg[g] - gm);
        const float pg = 1.f / gden;
        gs = __builtin_amdgcn_readfirstlane(gs);
        float el[8];
        { const LAS h16* wsel = wrl + ((4 + 8 * gs) * 64 + F.lane) * 16; const float* bsel = ber + 8 * gs;
#pragma unroll
          for (int e = 0; e < 8; ++e) { const f16x8 wa = *(const LAS f16x8*)(wsel + e * 1024), wb = *(const LAS f16x8*)(wsel + e * 1024 + 8);
            float s = 0.f;
#pragma unroll
            for (int i = 0; i < 4; ++i) { s += v[0][i] * (float)wa[i]; s += v[1][i] * (float)wa[4 + i]; s += v[2][i] * (float)wb[i]; s += v[3][i] * (float)wb[4 + i]; }
            el[e] = dpp_sum_f32(s) + bsel[e]; } }
        int e0 = 0; float m0 = el[0];
#pragma unroll
        for (int e = 1; e < 8; ++e) if (el[e] > m0) { m0 = el[e]; e0 = e; }
        int e1 = -1; float m1 = -__builtin_inff();
#pragma unroll
        for (int e = 0; e < 8; ++e) if (e != e0 && el[e] > m1) { m1 = el[e]; e1 = e; }
        const float p1 = __expf(m1 - m0); const float w0 = pg / (1.f + p1), w1 = pg * p1 / (1.f + p1);
        if (F.lane == 0) {
            const unsigned E0 = (unsigned)(gs * 8 + e0), E1 = (unsigned)(gs * 8 + e1);
            const unsigned r0 = atomicAdd((unsigned*)(lcnt + E0), 1u), r1 = atomicAdd((unsigned*)(lcnt + E1), 1u);
            rinfo[lrow * 8 + 0] = E0; rinfo[lrow * 8 + 1] = r0; rinfo[lrow * 8 + 2] = __builtin_bit_cast(unsigned, w0);
            rinfo[lrow * 8 + 3] = E1; rinfo[lrow * 8 + 4] = r1; rinfo[lrow * 8 + 5] = __builtin_bit_cast(unsigned, w1);
        }
    }
    __syncthreads();
    unsigned* gcnt = (unsigned*)(F.ws + WS_CTL) + CW_GCNT;
    if (F.tid < 32) lbase[F.tid] = atomicAdd(gcnt + F.tid, lcnt[F.tid]);
    __syncthreads();
    if (F.tid < 128) { unsigned* ro = (unsigned*)(F.ws + WS_ROUTE) + ((size_t)F.vcu * 128 + F.tid) * 8;
        const unsigned E0 = rinfo[F.tid * 8 + 0], E1 = rinfo[F.tid * 8 + 3];
        ro[0] = E0; ro[1] = lbase[E0] + rinfo[F.tid * 8 + 1]; ro[2] = rinfo[F.tid * 8 + 2]; ro[3] = E1; ro[4] = lbase[E1] + rinfo[F.tid * 8 + 4]; ro[5] = rinfo[F.tid * 8 + 5]; }
    __syncthreads();
}
__device__ __forceinline__ void expert_offsets(Frame& F, LAS unsigned* off) {
    const unsigned* gcnt = (const unsigned*)(F.ws + WS_CTL) + CW_GCNT;
    if (F.tid == 0) { unsigned a = 0; for (int e = 0; e < 32; ++e) { off[e] = a; a += (__hip_atomic_load(gcnt + e, RLX_AGENT) + 255u) & ~255u; } off[32] = a; }
    __syncthreads();
}
__device__ __forceinline__ void p7_rowmap(Frame& F) {
    LAS unsigned* off = (LAS unsigned*)F.lds;
    expert_offsets(F, off);
    int* rowmap = (int*)(F.ws + WS_ROWMAP); const unsigned* gcnt = (const unsigned*)(F.ws + WS_CTL) + CW_GCNT; int* tile_e = (int*)(F.ws + WS_CTL) + 1024;
    if (F.tid < 128) { const size_t tok = (size_t)F.vcu * 128 + F.tid; const unsigned* ro = (const unsigned*)(F.ws + WS_ROUTE) + tok * 8;
        rowmap[off[ro[0]] + ro[1]] = (int)tok; rowmap[off[ro[3]] + ro[4]] = (int)tok; }
    if (F.vcu < 32) { const int e = F.vcu; const unsigned c = __hip_atomic_load(gcnt + e, RLX_AGENT); for (unsigned r = off[e] + c + F.tid; r < off[e + 1]; r += NTHR) rowmap[r] = -1;
        for (unsigned t = off[e] / 256 + F.tid; t < off[e + 1] / 256; t += NTHR) tile_e[t] = e; }
    __syncthreads();
}
__device__ __forceinline__ void p10_combine(Frame& F) {
    LAS unsigned* off = (LAS unsigned*)F.lds;
    expert_offsets(F, off);
    const float* mod = (const float*)(F.ws + WS_MOD); const h16* Y = (const h16*)(F.ws + WS_Y); float* out = F.out;
    const int b = F.vcu >> 5;
    f32x4 g2[4];
#pragma unroll
    for (int j = 0; j < 4; ++j) g2[j] = *(const f32x4*)(mod + (size_t)b * 6144 + 5120 + 4 * F.lane + 256 * j);
    const size_t rowbase = (size_t)F.vcu * 128 + F.wave * 16;
    unsigned P0l = 0u, P1l = 0u; float C0l = 0.f, C1l = 0.f;
    if (F.lane < 16) { const unsigned* ro = (const unsigned*)(F.ws + WS_ROUTE) + (rowbase + F.lane) * 8; P0l = off[ro[0]] + ro[1]; P1l = off[ro[3]] + ro[4]; C0l = __builtin_bit_cast(float, ro[2]); C1l = __builtin_bit_cast(float, ro[5]); }
    f16x4 y0n[4], y1n[4]; f32x4 xn[4];
    { const size_t p0 = (unsigned)__shfl((int)P0l, 0), p1 = (unsigned)__shfl((int)P1l, 0);
#pragma unroll
      for (int j = 0; j < 4; ++j) { const int col = 4 * F.lane + 256 * j; y0n[j] = *(const f16x4*)(Y + p0 * 1024 + col); y1n[j] = *(const f16x4*)(Y + p1 * 1024 + col); xn[j] = *(const f32x4*)(out + rowbase * 1024 + col); } }
    for (int rr = 0; rr < 16; ++rr) {
        const size_t row = rowbase + rr; const int rn = rr < 15 ? rr + 1 : rr;
        const float c0 = __shfl(C0l, rr), c1 = __shfl(C1l, rr);
        const size_t p0n = (unsigned)__shfl((int)P0l, rn), p1n = (unsigned)__shfl((int)P1l, rn);
#pragma unroll
        for (int j = 0; j < 4; ++j) { const int col = 4 * F.lane + 256 * j;
            const f16x4 y0 = y0n[j], y1 = y1n[j]; f32x4 xv = xn[j];
            y0n[j] = *(const f16x4*)(Y + p0n * 1024 + col); y1n[j] = *(const f16x4*)(Y + p1n * 1024 + col); xn[j] = *(const f32x4*)(out + (rowbase + rn) * 1024 + col);
#pragma unroll
            for (int i = 0; i < 4; ++i) xv[i] += g2[j][i] * (c0 * (float)y0[i] + c1 * (float)y1[i]);
            *(f32x4*)(out + row * 1024 + col) = xv; }
    }
}
constexpr int N_PHASES = 11;
__global__ void __launch_bounds__(NTHR, 2) mega_fwd(Args args) {
    extern __shared__ __attribute__((aligned(16))) unsigned char lds_raw[];
    Frame F;
    F.lds = (LAS unsigned char*)lds_raw; F.ldsg = lds_raw;
    F.tid = threadIdx.x; F.lane = F.tid & 63; F.wave = __builtin_amdgcn_readfirstlane(F.tid >> 6);
    F.G = gridDim.x; { const int bx = blockIdx.x; F.vcu = (F.G % 8 == 0) ? (bx % 8) * (F.G / 8) + bx / 8 : bx; }
    F.in = (const float* const __attribute__((address_space(4)))*)__builtin_amdgcn_kernarg_segment_ptr();
    F.out = args.out; F.ws = args.ws;
    volatile LAS unsigned* MISC = (volatile LAS unsigned*)(F.lds + MISC_OFF);
    if (F.tid < 16) MISC[F.tid] = 0u;
    __syncthreads();
    const int lo = args.ph_lo, hi = args.ph_hi;
    XcdBarrier bar; bar.bar = (unsigned*)(F.ws + WS_CTL) + CW_BAR; bar.x = 0; bar.st = nullptr;
    if (hi - lo > 1) bar = xcd_barrier_post((unsigned*)(F.ws + WS_CTL) + CW_BAR, MISC + 8);
#define IN(k) (lo <= (k) && (k) < hi)
#define STAMP(k) do {} while (0)
#define SEAM(k) do { if (IN(k) && IN((k) + 1)) xcd_barrier(bar); STAMP((k) + 1); } while (0)
    STAMP(0);
    if (IN(0)) { p0_prologue(F); }
    if (lo < 0) { cg::this_grid().sync(); }
    SEAM(0);
    if (IN(1)) { p1_norm1(F); }
    SEAM(1);
    if (IN(2)) {
        pg8::Gemm g{(const h16*)(F.ws + WS_H), (const h16*)(F.ws + WS_WINT), M, NINP, DM, 0, nullptr}; pg8::StaticOrder S; S.init(M, NINP, F.G, (int)blockIdx.x);
        EpiInProj E{(h16*)(F.ws + WS_Q), (h16*)(F.ws + WS_K), (h16*)(F.ws + WS_V), (h16*)(F.ws + WS_QI), (h16*)(F.ws + WS_KI), (h16*)(F.ws + WS_GB), (h16*)(F.ws + WS_Z), (float*)(F.ws + WS_WI), F.in[7], F.in[8]};
        pg8::gemm_phase<EpiInProj, pg8::StaticOrder, false>(F.lds, g, S, E);
    }
    SEAM(2);
    if (IN(3)) { p3_conv(F); p3_indexer(F); }
    SEAM(3);
    if (IN(4)) { p4_attention(F); }
    SEAM(4);
    if (IN(5)) {
        pg8::Gemm g{(const h16*)(F.ws + WS_MERGED), (const h16*)(F.ws + WS_WOUTT), M, DM, DM, 0, nullptr}; pg8::StaticOrder S; S.init(M, DM, F.G, (int)blockIdx.x);
        EpiOutProj E{F.in[0], F.out, (const float*)(F.ws + WS_MOD)};
        pg8::gemm_phase<EpiOutProj, pg8::StaticOrder, false>(F.lds, g, S, E);
    }
    SEAM(5);
    if (IN(6)) { p6_norm2_route(F); }
    SEAM(6);
    if (IN(7)) { p7_rowmap(F); }
    SEAM(7);
    if (IN(8)) {
        LAS unsigned* off = (LAS unsigned*)(F.lds + RING_BYTES); expert_offsets(F, off); const int ntiles = (int)(off[32] / 256u); __syncthreads();
        pg8::Gemm g{(const h16*)(F.ws + WS_H), (const h16*)(F.ws + WS_WGUT), 0, 512, DM, (size_t)512 * 1024 * 2, (const int*)(F.ws + WS_ROWMAP)};
        pg8::GroupedOrder S{(const int*)(F.ws + WS_CTL) + 1024, ntiles, 2, F.G, F.vcu};
        EpiMoeUp E{(h16*)(F.ws + WS_HID)};
        pg8::gemm_phase<EpiMoeUp, pg8::GroupedOrder, true>(F.lds, g, S, E);
    }
    SEAM(8);
    if (IN(9)) {
        LAS unsigned* off = (LAS unsigned*)(F.lds + RING_BYTES); expert_offsets(F, off); const int ntiles = (int)(off[32] / 256u); __syncthreads();
        pg8::Gemm g{(const h16*)(F.ws + WS_HID), (const h16*)(F.ws + WS_WDT), 0, 1024, EFF, (size_t)1024 * 256 * 2, nullptr};
        pg8::GroupedOrder S{(const int*)(F.ws + WS_CTL) + 1024, ntiles, 4, F.G, F.vcu};
        EpiMoeDown E{(h16*)(F.ws + WS_Y)};
        pg8::gemm_phase<EpiMoeDown, pg8::GroupedOrder, false>(F.lds, g, S, E);
    }
    SEAM(9);
    if (IN(10)) { p10_combine(F); }

#undef IN
#undef SEAM
}

extern "C" void kernel_launch(void* const* d_in, const int* in_sizes, int n_in, void* d_out, int out_size, void* d_ws, size_t ws_size, hipStream_t stream) {
    static int grid = 0;
    if (grid == 0) {
        if (n_in != 21 || out_size != M * DM || ws_size < WS_END) { fprintf(stderr, "kernel_launch: unexpected shapes (n_in %d out %d ws %zu)\n", n_in, out_size, ws_size); grid = -1; return; }
        int dev = 0, cus = 0, per_cu = 0;
        (void)hipGetDevice(&dev); (void)hipDeviceGetAttribute(&cus, hipDeviceAttributeMultiprocessorCount, dev);
        if (hipFuncSetAttribute((const void*)mega_fwd, hipFuncAttributeMaxDynamicSharedMemorySize, LDS_BYTES) != hipSuccess) { fprintf(stderr, "kernel_launch: hipFuncSetAttribute failed\n"); grid = -1; return; }
        if (hipOccupancyMaxActiveBlocksPerMultiprocessor(&per_cu, (const void*)mega_fwd, NTHR, LDS_BYTES) != hipSuccess || per_cu < 1) { fprintf(stderr, "kernel_launch: occupancy query says %d\n", per_cu); per_cu = 1; }
        (void)hipGetLastError();
        grid = cus;
        if (grid != 256) { fprintf(stderr, "kernel_launch: built for 256 CUs, got %d\n", grid); }
    }
    if (grid < 0) return;
    (void)hipMemsetAsync((char*)d_ws + WS_CTL, 0, CTL_ZERO_BYTES, stream);
    Args a{};
    for (int i = 0; i < 21; ++i) a.in[i] = (const float*)d_in[i];
    a.out = (float*)d_out; a.ws = (unsigned char*)d_ws;
#if MK_N_LAUNCHES == 1
    a.ph_lo = 0; a.ph_hi = N_PHASES;
    void* kargs[] = {&a};
    hipError_t e = hipLaunchCooperativeKernel((const void*)mega_fwd, dim3(grid), dim3(NTHR), kargs, LDS_BYTES, stream);
    if (e != hipSuccess) fprintf(stderr, "cooperative launch failed: %s\n", hipGetErrorString(e));
#else
    for (int p = 0; p < N_PHASES; ++p) { a.ph_lo = p; a.ph_hi = p + 1; hipLaunchKernelGGL(mega_fwd, dim3(grid), dim3(NTHR), LDS_BYTES, stream, a); }
#endif
}
```

```cpp
#include <hip/hip_runtime.h>
#include <hip/hip_cooperative_groups.h>
#include <cstdio>
#include <cstdint>
namespace cg = cooperative_groups;

#ifndef MK_N_LAUNCHES

#define MK_N_LAUNCHES 1
#endif

#define LAS __attribute__((address_space(3)))
#define GAS __attribute__((address_space(1)))
typedef _Float16 h16;
typedef _Float16 f16x8 __attribute__((ext_vector_type(8)));
typedef _Float16 f16x4 __attribute__((ext_vector_type(4)));
typedef _Float16 f16x2 __attribute__((ext_vector_type(2)));
typedef short s16x4 __attribute__((ext_vector_type(4)));
typedef float f32x2 __attribute__((ext_vector_type(2)));
typedef float f32x4 __attribute__((ext_vector_type(4)));
typedef float f32x16 __attribute__((ext_vector_type(16)));
typedef unsigned u32x2 __attribute__((ext_vector_type(2)));
typedef unsigned u32x4 __attribute__((ext_vector_type(4)));
typedef unsigned long long u64;

constexpr int BATCH = 8, SEQ = 4096, DM = 1024, M = BATCH * SEQ;
constexpr int NINP = 3840;
constexpr int NEXP = 32, EFF = 256;
constexpr int MAXROWS = 2 * M + NEXP * 256;
constexpr float EPS = 1e-6f;
constexpr float LOG2E = 1.4426950408889634f;
constexpr float QSCALE = 0.125f * LOG2E;
constexpr float IDX_SCALE = 0.125f * 0.35355339059327373f;
constexpr int NWAVES = 8, NTHR = 512;

constexpr size_t MiB = 1u << 20;
constexpr size_t WS_CTL = 0, CTL_ZERO_BYTES = 64 * 1024;
constexpr size_t WS_MODP = 1 * MiB;
constexpr size_t WS_MOD = 4 * MiB;
constexpr size_t WS_ROUTE = 5 * MiB;
constexpr size_t WS_ROWMAP = 6 * MiB + 512 * 1024;
constexpr size_t WS_WINT = 8 * MiB;
constexpr size_t WS_WOUTT = 16 * MiB;
constexpr size_t WS_WRL = 18 * MiB;
constexpr size_t WS_WGUT = 20 * MiB;
constexpr size_t WS_WDT = 52 * MiB;
constexpr size_t WS_H = 72 * MiB;
constexpr size_t WS_Q = 136 * MiB, WS_K = 168 * MiB, WS_V = 200 * MiB, WS_QI = 232 * MiB;
constexpr size_t WS_KI = 264 * MiB;
constexpr size_t WS_WI = 268 * MiB;
constexpr size_t WS_GB = 270 * MiB, WS_Z = 302 * MiB;
constexpr size_t WS_BM = 334 * MiB;
constexpr size_t WS_MERGED = 350 * MiB;
constexpr size_t WS_HID = 416 * MiB;
constexpr size_t WS_Y = 136 * MiB;
constexpr size_t WS_END = 456 * MiB;
static_assert(WS_Y + (size_t)MAXROWS * 1024 * 2 <= WS_Z + 32 * MiB, "Y overlay");
static_assert(WS_HID + (size_t)MAXROWS * 256 * 2 <= WS_END, "HID");
constexpr int CW_GCNT = 64;
constexpr int CW_BAR = 4096;

constexpr int LDS_BYTES = 147456;
constexpr int RING_BYTES = 131072;
constexpr int MISC_OFF = 147456 - 256;

__device__ const unsigned char T5_BKT[129] = {0, 1, 2, 3, 4, 5, 6, 7, 8, 9, 10, 11, 12, 13, 14, 15, 16, 16, 16, 17, 17, 18, 18, 18, 19, 19, 19, 20, 20, 20, 20, 21, 21, 21, 21, 22, 22, 22, 22, 22, 23, 23, 23, 23, 23, 23, 24, 24, 24, 24, 24, 24, 25, 25, 25, 25, 25, 25, 25, 26, 26, 26, 26, 26, 26, 26, 26, 27, 27, 27, 27, 27, 27, 27, 27, 27, 27, 28, 28, 28, 28, 28, 28, 28, 28, 28, 28, 29, 29, 29, 29, 29, 29, 29, 29, 29, 29, 29, 29, 30, 30, 30, 30, 30, 30, 30, 30, 30, 30, 30, 30, 30, 30, 31, 31, 31, 31, 31, 31, 31, 31, 31, 31, 31, 31, 31, 31, 31, 31};

#define LDS_WAIT() asm volatile("s_waitcnt lgkmcnt(0)" ::: "memory")
#define VM_WAIT() asm volatile("s_waitcnt vmcnt(0)" ::: "memory")
#define RLX_AGENT __ATOMIC_RELAXED, __HIP_MEMORY_SCOPE_AGENT
__device__ __forceinline__ unsigned pk2h(float lo, float hi) { f32x2 v = {lo, hi}; f16x2 h = __builtin_convertvector(v, f16x2); return __builtin_bit_cast(unsigned, h); }
__device__ __forceinline__ u32x4 pk8h(f32x4 a, f32x4 b) { u32x4 w; w.x = pk2h(a[0], a[1]); w.y = pk2h(a[2], a[3]); w.z = pk2h(b[0], b[1]); w.w = pk2h(b[2], b[3]); return w; }
__device__ __forceinline__ float wave_sum(float v) {
#pragma unroll
    for (int o = 1; o < 64; o <<= 1) v += __shfl_xor(v, o);
    return v;
}
__device__ __forceinline__ unsigned dpp_sum_u32(unsigned v) {
    v += (unsigned)__builtin_amdgcn_update_dpp(0, (int)v, 0xB1, 0xf, 0xf, false);
    v += (unsigned)__builtin_amdgcn_update_dpp(0, (int)v, 0x4E, 0xf, 0xf, false);
    v += (unsigned)__builtin_amdgcn_update_dpp(0, (int)v, 0x141, 0xf, 0xf, false);
    v += (unsigned)__builtin_amdgcn_update_dpp(0, (int)v, 0x140, 0xf, 0xf, false);
    return __builtin_amdgcn_readlane(v, 0) + __builtin_amdgcn_readlane(v, 16) + __builtin_amdgcn_readlane(v, 32) + __builtin_amdgcn_readlane(v, 48);
}
__device__ __forceinline__ float dpp_sum_f32(float v) {
    v += __builtin_bit_cast(float, __builtin_amdgcn_update_dpp(0, __builtin_bit_cast(int, v), 0xB1, 0xf, 0xf, false));
    v += __builtin_bit_cast(float, __builtin_amdgcn_update_dpp(0, __builtin_bit_cast(int, v), 0x4E, 0xf, 0xf, false));
    v += __builtin_bit_cast(float, __builtin_amdgcn_update_dpp(0, __builtin_bit_cast(int, v), 0x141, 0xf, 0xf, false));
    v += __builtin_bit_cast(float, __builtin_amdgcn_update_dpp(0, __builtin_bit_cast(int, v), 0x140, 0xf, 0xf, false));
    return __builtin_bit_cast(float, __builtin_amdgcn_readlane(__builtin_bit_cast(int, v), 0)) + __builtin_bit_cast(float, __builtin_amdgcn_readlane(__builtin_bit_cast(int, v), 16)) +
           __builtin_bit_cast(float, __builtin_amdgcn_readlane(__builtin_bit_cast(int, v), 32)) + __builtin_bit_cast(float, __builtin_amdgcn_readlane(__builtin_bit_cast(int, v), 48));
}
__device__ __forceinline__ float dpp_max_f32(float v) {
    v = fmaxf(v, __builtin_bit_cast(float, __builtin_amdgcn_update_dpp(__builtin_bit_cast(int, v), __builtin_bit_cast(int, v), 0xB1, 0xf, 0xf, false)));
    v = fmaxf(v, __builtin_bit_cast(float, __builtin_amdgcn_update_dpp(__builtin_bit_cast(int, v), __builtin_bit_cast(int, v), 0x4E, 0xf, 0xf, false)));
    v = fmaxf(v, __builtin_bit_cast(float, __builtin_amdgcn_update_dpp(__builtin_bit_cast(int, v), __builtin_bit_cast(int, v), 0x141, 0xf, 0xf, false)));
    v = fmaxf(v, __builtin_bit_cast(float, __builtin_amdgcn_update_dpp(__builtin_bit_cast(int, v), __builtin_bit_cast(int, v), 0x140, 0xf, 0xf, false)));
    float a = __builtin_bit_cast(float, __builtin_amdgcn_readlane(__builtin_bit_cast(int, v), 0)), b = __builtin_bit_cast(float, __builtin_amdgcn_readlane(__builtin_bit_cast(int, v), 16));
    float c = __builtin_bit_cast(float, __builtin_amdgcn_readlane(__builtin_bit_cast(int, v), 32)), d = __builtin_bit_cast(float, __builtin_amdgcn_readlane(__builtin_bit_cast(int, v), 48));
    return fmaxf(fmaxf(a, b), fmaxf(c, d));
}
__device__ __forceinline__ float dpp_min_f32(float v) { return -dpp_max_f32(-v); }
__device__ __forceinline__ float silu_f(float v) { return v / (1.f + __expf(-v)); }

namespace pg8 {
#define PG8_LAS __attribute__((address_space(3)))
constexpr int BM = 256, BK = 64, HALF = 128, HTB = HALF * BK * 2, STAGE_BYTES = 8 * HTB, NXCD = 8, WGM = 8;
__host__ __device__ __forceinline__ int lds_byte(int r, int c) { const int st = (r >> 4) * 2 + (c >> 5), rr = r & 15, cc = c & 31, ob = rr * 64 + cc * 2; return st * 1024 + (ob ^ (((ob >> 9) & 1) << 5)); }
__host__ __device__ __forceinline__ void stage_rc(int b, int& R, int& C) { const int st = b / 1024, sb = b % 1024, swz = sb ^ (((sb >> 9) & 1) << 5); R = (st >> 1) * 16 + swz / 64; C = (st & 1) * 32 + (swz % 64) / 2; }
__host__ __device__ __forceinline__ int perm32(int rho) { const int n = rho >> 4, i = rho & 15; return 8 * (i >> 2) + 4 * n + (i & 3); }

struct Unit { int pm, pn, eb; };
struct Gemm { const h16* A; const h16* Bt; int M, N, K; size_t bstride; const int* rowmap; };

struct StaticOrder {
    int nM, nN, nwg, G, c;
    __device__ void init(int M_, int N_, int G_, int c_) { nM = M_ / BM; nN = N_ / BM; nwg = nM * nN; G = G_; c = c_; }
    __device__ bool next(int i, Unit& u) const {
        const long L = (long)i * G + c; if (L >= nwg) return false;
        int wgid = (int)L; { const int q = nwg / NXCD, r = nwg % NXCD, xcd = wgid % NXCD, off = wgid / NXCD; wgid = (xcd < r ? xcd * (q + 1) : r * (q + 1) + (xcd - r) * q) + off; }
        const int nig = WGM * nN, gid = wgid / nig, fm = gid * WGM, gsz = (nM - fm) < WGM ? (nM - fm) : WGM;
        u.pm = fm + ((wgid % nig) % gsz); u.pn = (wgid % nig) / gsz; u.eb = 0; return true;
    }
};
struct GroupedOrder {
    const int* tile_e; int ntiles, nN, G, v;
    __device__ bool next(int i, Unit& u) const {
        const long L = (long)i * G + v; if (L >= (long)ntiles * nN) return false;
        u.pm = (int)(L / nN); u.pn = (int)(L % nN); u.eb = tile_e[u.pm]; return true;
    }
};

template <class Epi, class Sched, bool GATHER>
__device__ __forceinline__ void gemm_phase(PG8_LAS unsigned char* lds, const Gemm g, const Sched& S, const Epi& E) {
    const int tid = threadIdx.x, wid = __builtin_amdgcn_readfirstlane(tid >> 6), lane = tid & 63, wr = wid >> 2, wc = wid & 3, fr = lane & 15, fq = lane >> 4;
    int K_ = g.K; asm volatile("" : "+s"(K_));
    const int K = K_, nt = K / BK;
    unsigned voffB[2]; unsigned cC[2]; int cR[2];
    unsigned vA0[2], vA1[2];
#pragma unroll
    for (int i = 0; i < 2; ++i) { int R, C; stage_rc(tid * 16 + i * 8192, R, C); const int Rb = Epi::PERM ? ((R & ~31) + perm32(R & 31)) : R;
        cR[i] = R; cC[i] = (unsigned)C * 2u; voffB[i] = (unsigned)(Rb * K + C) * 2u; vA0[i] = (unsigned)(R * K + C) * 2u; vA1[i] = vA0[i]; }
    const size_t kstep = (size_t)(BK * 2);
    const size_t hstep = (size_t)HALF * K * 2;
    const size_t tstep = 2 * hstep;
    const unsigned ldsw = (unsigned)wid * 1024u;
    const int aoff = lds_byte(wr * 64 + fr, fq * 8), boff = lds_byte(wc * 32 + fr, fq * 8);
#define PG8_SA(b, h) (((b) * 2 + (h)) * HTB)
#define PG8_SB(b, h) ((4 + (b) * 2 + (h)) * HTB)
#define PG8_STAGE(bufoff, gbase, voff) do { _Pragma("unroll") for (int _i = 0; _i < 2; ++_i) \
        __builtin_amdgcn_global_load_lds((const unsigned*)((const char*)(gbase) + (voff)[_i]), (PG8_LAS unsigned*)(lds + (bufoff) + ldsw + _i * 8192), 16, 0, 0); } while (0)
#define PG8_LDA(dst, b, h) do { _Pragma("unroll") for (int m = 0; m < 4; ++m) _Pragma("unroll") for (int k = 0; k < 2; ++k) dst[m][k] = *(const PG8_LAS f16x8*)(lds + PG8_SA(b, h) + aoff + m * 2048 + k * 1024); } while (0)
#define PG8_LDB(dst, b, h) do { _Pragma("unroll") for (int n = 0; n < 2; ++n) _Pragma("unroll") for (int k = 0; k < 2; ++k) dst[n][k] = *(const PG8_LAS f16x8*)(lds + PG8_SB(b, h) + boff + n * 2048 + k * 1024); } while (0)
#define PG8_MMA(ai, bj, At, Bt) do { __builtin_amdgcn_s_setprio(1); _Pragma("unroll") for (int m = 0; m < 4; ++m) _Pragma("unroll") for (int n = 0; n < 2; ++n) _Pragma("unroll") for (int k = 0; k < 2; ++k) \
        acc[ai][bj][m][n] = __builtin_amdgcn_mfma_f32_16x16x32_f16(Bt[n][k], At[m][k], acc[ai][bj][m][n], 0, 0, 0); __builtin_amdgcn_s_setprio(0); } while (0)
#define PG8_WAIT_V(n) asm volatile("s_waitcnt vmcnt(" #n ")" ::: "memory")
#define PG8_WAIT_L(n) asm volatile("s_waitcnt lgkmcnt(" #n ")" ::: "memory")
#define PG8_BAR __builtin_amdgcn_s_barrier()
#define PG8_SCHED __builtin_amdgcn_sched_barrier(0)
#define PG8_ABASE(u_) (GATHER ? (const char*)g.A : (const char*)g.A + (size_t)(u_).pm * tstep)
#define PG8_AH1 (GATHER ? (size_t)0 : hstep)
#define PG8_GATHER_OFF(u_, d0, d1) do { if (GATHER) { _Pragma("unroll") for (int _i = 0; _i < 2; ++_i) { \
        int r0_ = g.rowmap[(u_).pm * BM + cR[_i]], r1_ = g.rowmap[(u_).pm * BM + HALF + cR[_i]]; r0_ = r0_ < 0 ? 0 : r0_; r1_ = r1_ < 0 ? 0 : r1_; \
        d0[_i] = (unsigned)r0_ * (unsigned)(K * 2) + cC[_i]; d1[_i] = (unsigned)r1_ * (unsigned)(K * 2) + cC[_i]; } } } while (0)
    Unit cur, nxt; int ui = 0;
    if (!S.next(0, cur)) return;
    f32x4 acc[2][2][4][2];
#pragma unroll
    for (int a = 0; a < 2; ++a)
#pragma unroll
        for (int b = 0; b < 2; ++b)
#pragma unroll
            for (int m = 0; m < 4; ++m)
#pragma unroll
                for (int n = 0; n < 2; ++n) acc[a][b][m][n] = (f32x4){0.f, 0.f, 0.f, 0.f};
    f16x8 At[4][2], B0[2][2], B1[2][2];
    PG8_GATHER_OFF(cur, vA0, vA1);
    const char* cA = PG8_ABASE(cur); const char* cB = (const char*)g.Bt + (size_t)cur.eb * g.bstride + (size_t)cur.pn * tstep;
    PG8_STAGE(PG8_SB(0, 0), cB, voffB); PG8_STAGE(PG8_SB(0, 1), cB + hstep, voffB); PG8_STAGE(PG8_SA(0, 0), cA, vA0); PG8_STAGE(PG8_SA(0, 1), cA + PG8_AH1, vA1);
    if (wr == 1) PG8_BAR;
    PG8_WAIT_V(2); PG8_BAR;
    PG8_STAGE(PG8_SB(1, 0), cB + kstep, voffB); PG8_STAGE(PG8_SA(1, 0), cA + kstep, vA0); PG8_STAGE(PG8_SB(1, 1), cB + hstep + kstep, voffB);
    PG8_WAIT_V(6); PG8_BAR;
    for (;;) {
        const bool has_next = S.next(ui + 1, nxt);
        unsigned nA0[2] = {vA0[0], vA0[1]}, nA1[2] = {vA1[0], vA1[1]};
        if (has_next) PG8_GATHER_OFF(nxt, nA0, nA1);
        const char* nA = has_next ? PG8_ABASE(nxt) : cA; const char* nB = has_next ? (const char*)g.Bt + (size_t)nxt.eb * g.bstride + (size_t)nxt.pn * tstep : cB;
        for (int t = 0; t < nt; t += 2) {
            const bool last = (t == nt - 2);
            const char* a1 = cA + (size_t)(t + 1) * kstep;
            const char* a2 = last ? nA : cA + (size_t)(t + 2) * kstep; const char* b2 = last ? nB : cB + (size_t)(t + 2) * kstep;
            const char* a3 = a2 + kstep; const char* b3 = b2 + kstep;
            unsigned w0[2], w1[2];
#pragma unroll
            for (int i = 0; i < 2; ++i) { w0[i] = last ? nA0[i] : vA0[i]; w1[i] = last ? nA1[i] : vA1[i]; }
            PG8_LDB(B0, 0, 0); PG8_LDB(B1, 0, 1); PG8_SCHED; PG8_LDA(At, 0, 0); PG8_STAGE(PG8_SA(1, 1), a1 + PG8_AH1, vA1);
            PG8_WAIT_V(8); PG8_WAIT_L(0); PG8_BAR; PG8_MMA(0, 0, At, B0); PG8_MMA(0, 1, At, B1); PG8_BAR; PG8_SCHED;
            PG8_LDA(At, 0, 1); PG8_STAGE(PG8_SB(0, 0), b2, voffB); PG8_STAGE(PG8_SB(0, 1), b2 + hstep, voffB); PG8_STAGE(PG8_SA(0, 0), a2, w0);
            PG8_WAIT_V(8); PG8_WAIT_L(0); PG8_BAR; PG8_MMA(1, 0, At, B0); PG8_MMA(1, 1, At, B1); PG8_BAR; PG8_SCHED;
            PG8_LDB(B0, 1, 0); PG8_LDB(B1, 1, 1); PG8_SCHED; PG8_LDA(At, 1, 0); PG8_STAGE(PG8_SA(0, 1), a2 + PG8_AH1, w1);
            PG8_WAIT_V(8); PG8_WAIT_L(0); PG8_BAR; PG8_MMA(0, 0, At, B0); PG8_MMA(0, 1, At, B1); PG8_BAR; PG8_SCHED;
            PG8_LDA(At, 1, 1); PG8_STAGE(PG8_SB(1, 0), b3, voffB); PG8_STAGE(PG8_SB(1, 1), b3 + hstep, voffB); PG8_STAGE(PG8_SA(1, 0), a3, w0);
            PG8_WAIT_V(8); PG8_WAIT_L(0); PG8_BAR; PG8_MMA(1, 0, At, B0); PG8_MMA(1, 1, At, B1); PG8_BAR; PG8_SCHED;
        }
        if (wr == 0) PG8_BAR;
        E(acc, cur, wr, wc, fr, fq);
        if (!has_next) break;
#pragma unroll
        for (int a = 0; a < 2; ++a)
#pragma unroll
            for (int b = 0; b < 2; ++b)
#pragma unroll
                for (int m = 0; m < 4; ++m)
#pragma unroll
                    for (int n = 0; n < 2; ++n) acc[a][b][m][n] = (f32x4){0.f, 0.f, 0.f, 0.f};
        cur = nxt; cA = nA; cB = nB; ++ui;
#pragma unroll
        for (int i = 0; i < 2; ++i) { vA0[i] = nA0[i]; vA1[i] = nA1[i]; }
        if (wr == 1) PG8_BAR;
    }
    PG8_WAIT_V(0);
    PG8_BAR;
#undef PG8_SA
#undef PG8_SB
#undef PG8_STAGE
#undef PG8_LDA
#undef PG8_LDB
#undef PG8_MMA
#undef PG8_WAIT_V
#undef PG8_WAIT_L
#undef PG8_BAR
#undef PG8_SCHED
#undef PG8_ABASE
#undef PG8_AH1
#undef PG8_GATHER_OFF
}
}

struct EpiInProj {
    static constexpr bool PERM = true;
    h16 *Q, *K, *V, *QI, *KI, *GB, *Z; float* WI; const float *qn, *kn;
    __device__ __forceinline__ void operator()(const f32x4 (&acc)[2][2][4][2], const pg8::Unit& u, int wr, int wc, int fr, int fq) const {
        const int row0 = u.pm * 256 + wr * 64 + fr; const int pn = u.pn;
        if (pn < 4) {
            const bool isq = pn < 2; const float* g = isq ? qn : kn; h16* O = isq ? Q : K; const int head = 4 * (pn & 1) + wc; const float sc = isq ? QSCALE : 1.f;
            f32x4 gv[2][2];
#pragma unroll
            for (int bj = 0; bj < 2; ++bj)
#pragma unroll
                for (int n = 0; n < 2; ++n) gv[bj][n] = *(const f32x4*)(g + 32 * bj + 8 * fq + 4 * n) * sc;
#pragma unroll
            for (int ai = 0; ai < 2; ++ai)
#pragma unroll
                for (int m = 0; m < 4; ++m) {
                    float ss = 0.f;
#pragma unroll
                    for (int bj = 0; bj < 2; ++bj)
#pragma unroll
                        for (int n = 0; n < 2; ++n) { const f32x4 v = acc[ai][bj][m][n]; ss += (v[0] * v[0] + v[1] * v[1]) + (v[2] * v[2] + v[3] * v[3]); }
                    ss += __shfl_xor(ss, 16); ss += __shfl_xor(ss, 32);
                    const float rstd = rsqrtf(ss * (1.f / 64.f) + EPS);
                    const int R = row0 + ai * 128 + m * 16;
                    if (isq) { h16* rowp = O + (size_t)R * 512 + head * 64 + 8 * fq;
#pragma unroll
                        for (int bj = 0; bj < 2; ++bj) *(u32x4*)(rowp + 32 * bj) = pk8h(acc[ai][bj][m][0] * rstd * gv[bj][0], acc[ai][bj][m][1] * rstd * gv[bj][1]); }
                    else {
                        h16* tp = O + ((size_t)((R >> 12) * 8 + head) * 64 + ((R & 4095) >> 6)) * 4096 + (R & 63) * 8;
#pragma unroll
                        for (int bj = 0; bj < 2; ++bj) *(u32x4*)(tp + (4 * bj + fq) * 512) = pk8h(acc[ai][bj][m][0] * rstd * gv[bj][0], acc[ai][bj][m][1] * rstd * gv[bj][1]); }
                }
        } else if (pn < 8) {
            h16* O = pn < 6 ? V : QI; const int head = 4 * (pn & 1) + wc;
#pragma unroll
            for (int ai = 0; ai < 2; ++ai)
#pragma unroll
                for (int m = 0; m < 4; ++m) { const int R = row0 + ai * 128 + m * 16;
                    if (pn >= 6) { h16* rowp = O + (size_t)R * 512 + head * 64 + 8 * fq;
#pragma unroll
                        for (int bj = 0; bj < 2; ++bj) *(u32x4*)(rowp + 32 * bj) = pk8h(acc[ai][bj][m][0], acc[ai][bj][m][1]); }
                    else {
                        const int kv = R & 63; h16* tp = O + ((size_t)((R >> 12) * 8 + head) * 64 + ((R & 4095) >> 6)) * 4096 + ((kv >> 4) * 64 + (kv & 15) * 4 + fq) * 8;
#pragma unroll
                        for (int bj = 0; bj < 2; ++bj) *(u32x4*)(tp + bj * 2048) = pk8h(acc[ai][bj][m][0], acc[ai][bj][m][1]); } }
        } else if (pn == 8) {
#pragma unroll
            for (int ai = 0; ai < 2; ++ai)
#pragma unroll
                for (int m = 0; m < 4; ++m) { const size_t row = (size_t)(row0 + ai * 128 + m * 16);
                    if (wc < 2) { const int R = (int)row, c8 = 4 * wc + fq;
                        *(u32x4*)(KI + ((((size_t)(R >> 12) * 128 + ((R & 4095) >> 5)) * 4 + (c8 >> 1)) * 64 + (R & 31) + 32 * (c8 & 1)) * 8) = pk8h(acc[ai][0][m][0], acc[ai][0][m][1]); }
                    else if (wc == 2 && fq == 0) { *(f32x4*)(WI + row * 8) = acc[ai][0][m][0]; *(f32x4*)(WI + row * 8 + 4) = acc[ai][0][m][1]; } }
        } else if (pn < 11) {
            const int colb = 256 * (pn - 9) + 32 * wc + 8 * fq;
#pragma unroll
            for (int ai = 0; ai < 2; ++ai)
#pragma unroll
                for (int m = 0; m < 4; ++m) { h16* rowp = GB + (size_t)(row0 + ai * 128 + m * 16) * 512 + colb;
#pragma unroll
                    for (int bj = 0; bj < 2; ++bj) *(u32x4*)(rowp + 128 * bj) = pk8h(acc[ai][bj][m][0], acc[ai][bj][m][1]); }
        } else {
            const int ch = 128 * (pn - 11) + 32 * wc + 8 * fq;
#pragma unroll
            for (int ai = 0; ai < 2; ++ai)
#pragma unroll
                for (int m = 0; m < 4; ++m) *(u32x4*)(Z + (size_t)(row0 + ai * 128 + m * 16) * 512 + ch) = pk8h(acc[ai][0][m][0] * acc[ai][1][m][0], acc[ai][0][m][1] * acc[ai][1][m][1]);
        }
    }
};
struct EpiOutProj {
    static constexpr bool PERM = false;
    const float* x; float* out; const float* mod;
    __device__ __forceinline__ void operator()(const f32x4 (&acc)[2][2][4][2], const pg8::Unit& u, int wr, int wc, int fr, int fq) const {
        const int row0 = u.pm * 256 + wr * 64 + fr; const int b = (u.pm * 256) >> 12; const int col0 = u.pn * 256 + wc * 32 + 4 * fq;
        f32x4 gv[2][2];
#pragma unroll
        for (int bj = 0; bj < 2; ++bj)
#pragma unroll
            for (int n = 0; n < 2; ++n) gv[bj][n] = *(const f32x4*)(mod + (size_t)b * 6144 + 2048 + col0 + bj * 128 + n * 16);
#pragma unroll
        for (int ai = 0; ai < 2; ++ai)
#pragma unroll
            for (int m = 0; m < 4; ++m) { const size_t off = (size_t)(row0 + ai * 128 + m * 16) * 1024 + col0;
#pragma unroll
                for (int bj = 0; bj < 2; ++bj)
#pragma unroll
                    for (int n = 0; n < 2; ++n) { const f32x4 xv = *(const f32x4*)(x + off + bj * 128 + n * 16); *(f32x4*)(out + off + bj * 128 + n * 16) = xv + gv[bj][n] * acc[ai][bj][m][n]; } }
    }
};
struct EpiMoeUp {
    static constexpr bool PERM = true;
    h16* HID;
    __device__ __forceinline__ void operator()(const f32x4 (&acc)[2][2][4][2], const pg8::Unit& u, int wr, int wc, int fr, int fq) const {
        const int row0 = u.pm * 256 + wr * 64 + fr; const int f0 = 128 * u.pn + 32 * wc + 8 * fq;
#pragma unroll
        for (int ai = 0; ai < 2; ++ai)
#pragma unroll
            for (int m = 0; m < 4; ++m) { f32x4 hv[2];
#pragma unroll
                for (int n = 0; n < 2; ++n) { const f32x4 a = acc[ai][0][m][n], bb = acc[ai][1][m][n];
#pragma unroll
                    for (int i = 0; i < 4; ++i) hv[n][i] = silu_f(a[i]) * bb[i]; }
                *(u32x4*)(HID + (size_t)(row0 + ai * 128 + m * 16) * 256 + f0) = pk8h(hv[0], hv[1]); }
    }
};
struct EpiMoeDown {
    static constexpr bool PERM = true;
    h16* Y;
    __device__ __forceinline__ void operator()(const f32x4 (&acc)[2][2][4][2], const pg8::Unit& u, int wr, int wc, int fr, int fq) const {
        const int row0 = u.pm * 256 + wr * 64 + fr; const int c0 = 256 * u.pn + 32 * wc + 8 * fq;
#pragma unroll
        for (int ai = 0; ai < 2; ++ai)
#pragma unroll
            for (int m = 0; m < 4; ++m) { h16* rowp = Y + (size_t)(row0 + ai * 128 + m * 16) * 1024 + c0;
#pragma unroll
                for (int bj = 0; bj < 2; ++bj) *(u32x4*)(rowp + 128 * bj) = pk8h(acc[ai][bj][m][0], acc[ai][bj][m][1]); }
    }
};

struct Args { const float* in[21]; float* out; unsigned char* ws; int ph_lo, ph_hi; };
struct Frame {
    LAS unsigned char* lds; unsigned char* ldsg;
    int tid, lane, wave, vcu, G;
    const float* const __attribute__((address_space(4)))* in; float* out; unsigned char* ws;
};

#define XB_TMO      128
#define XB_XCNT(j)  (256  + 64 * (j))
#define XB_XSUB(j)  (1280 + 64 * (j))
#define XB_XGEN(j)  (2304 + 64 * (j))
#define XB_TOP      3328
#define XB_TOPGEN   3392
#define XCD_BAR_WORDS 3456
#define XB_SPIN_CAP (1u << 20)
__device__ __forceinline__ unsigned xb_ld(unsigned* p)              { return __hip_atomic_load(p, __ATOMIC_RELAXED, __HIP_MEMORY_SCOPE_AGENT); }
__device__ __forceinline__ unsigned xb_add(unsigned* p, unsigned v) { return __hip_atomic_fetch_add(p, v, __ATOMIC_RELAXED, __HIP_MEMORY_SCOPE_AGENT); }
__device__ __forceinline__ unsigned xb_xcc_id() { return (unsigned)__builtin_amdgcn_s_getreg((3 << 11) | 20) & 0xFu; }
#define XB_SPIN(cond, bar) do { unsigned _sp = 0; while (cond) { __builtin_amdgcn_s_sleep(1); \
    if ((++_sp & 255u) == 0u) { if (xb_ld(&(bar)[XB_TMO])) break; if (_sp > XB_SPIN_CAP) { atomicAdd(&(bar)[XB_TMO], 1u); break; } } } } while (0)
struct XcdBarrier { unsigned* bar; unsigned x; volatile LAS unsigned* st; };
__device__ __forceinline__ XcdBarrier xcd_barrier_post(unsigned* bar, volatile LAS unsigned* st) {
    XcdBarrier b; b.bar = bar; b.x = xb_xcc_id(); b.st = st;
    if (threadIdx.x == 0) (void)xb_add(&bar[XB_XCNT(b.x)], 1u);
    return b;
}
__device__ __forceinline__ void xcd_barrier_complete(unsigned* bar, unsigned x, unsigned& nloc, unsigned& nx) {
    const unsigned G = gridDim.x * gridDim.y * gridDim.z;
    unsigned sum, cnt, mine, sp = 0u;
    for (;;) {
        sum = 0u; cnt = 0u; mine = 0u;
#pragma unroll
        for (unsigned j = 0; j < 16; ++j) { const unsigned c = xb_ld(&bar[XB_XCNT(j)]); sum += c; cnt += (c > 0u) ? 1u : 0u; mine = (j == x) ? c : mine; }
        if (sum == G) break;
        __builtin_amdgcn_s_sleep(1);
        if ((++sp & 255u) == 0u) { if (xb_ld(&bar[XB_TMO])) break; if (sp > XB_SPIN_CAP) { atomicAdd(&bar[XB_TMO], 1u); break; } }
    }
    nloc = mine > 0u ? mine : 1u; nx = cnt > 0u ? cnt : 1u;
}
__device__ __forceinline__ void xcd_barrier(const XcdBarrier& b) {
    asm volatile("s_waitcnt vmcnt(0)" ::: "memory");
    __syncthreads();
    if (threadIdx.x == 0) {
        unsigned* bar = b.bar;
        __builtin_amdgcn_s_waitcnt(0);
        unsigned nloc = b.st[0], nx = b.st[1];
        if (nloc == 0u) { xcd_barrier_complete(bar, b.x, nloc, nx); b.st[0] = nloc; b.st[1] = nx; }
        const unsigned old = xb_add(&bar[XB_XSUB(b.x)], 1u);
        const unsigned gen = old / nloc;
        if (old + 1u == (gen + 1u) * nloc) {
            __builtin_amdgcn_fence(__ATOMIC_RELEASE, "agent");
            asm volatile("s_waitcnt vmcnt(0)" ::: "memory");
            const unsigned og = xb_add(&bar[XB_TOP], 1u);
            const unsigned tg = og / nx;
            if (og + 1u == (tg + 1u) * nx) xb_add(&bar[XB_TOPGEN], 1u);
            else XB_SPIN(xb_ld(&bar[XB_TOPGEN]) == tg, bar);
            __builtin_amdgcn_fence(__ATOMIC_ACQUIRE, "agent");
            xb_add(&bar[XB_XGEN(b.x)], 1u);
            asm volatile("s_waitcnt vmcnt(0)" ::: "memory");
        } else {
            XB_SPIN(xb_ld(&bar[XB_XGEN(b.x)]) == gen, bar);
            __builtin_amdgcn_fence(__ATOMIC_ACQUIRE, "agent");
            asm volatile("s_waitcnt vmcnt(0)" ::: "memory");
        }
    }
    __syncthreads();
}

__device__ __forceinline__ void transpose_item(const float* src, int ldw, int nvalid, int k0, h16* dst, int K, LAS float* scr, int lane) {
    const int c4 = lane & 7, rsub = lane >> 3;
    f32x4 v[8];
#pragma unroll
    for (int i = 0; i < 8; ++i) v[i] = (4 * c4 < nvalid) ? *(const f32x4*)(src + (size_t)(k0 + 8 * i + rsub) * ldw + 4 * c4) : (f32x4){0.f, 0.f, 0.f, 0.f};
#pragma unroll
    for (int i = 0; i < 8; ++i) { LAS float* p = scr + (8 * i + rsub) * 33 + 4 * c4; p[0] = v[i][0]; p[1] = v[i][1]; p[2] = v[i][2]; p[3] = v[i][3]; }
    LDS_WAIT(); asm volatile("" ::: "memory");
    const int c = lane & 7;
#pragma unroll
    for (int j = 0; j < 4; ++j) { const int nn = (lane >> 3) + 8 * j; const LAS float* s = scr + (8 * c) * 33 + nn;
        u32x4 o; o.x = pk2h(s[0 * 33], s[1 * 33]); o.y = pk2h(s[2 * 33], s[3 * 33]); o.z = pk2h(s[4 * 33], s[5 * 33]); o.w = pk2h(s[6 * 33], s[7 * 33]);
        *(u32x4*)(dst + (size_t)nn * K + k0 + 8 * c) = o; }
    LDS_WAIT(); asm volatile("" ::: "memory");
}
__device__ __forceinline__ int win_group_src(int g, int& nvalid) {
    const int tile = g >> 3, p = (g & 7) * 32, bj = p >> 7, wc = (p >> 5) & 3; nvalid = 32;
    if (tile < 8) { const int seg = tile >> 1; return seg * 512 + 64 * (4 * (tile & 1) + wc) + 32 * bj; }
    if (tile == 8) { if (p < 64) return 2048 + p; if (p == 64) { nvalid = 8; return 2112; } nvalid = 0; return 0; }
    if (tile < 11) return 2120 + 256 * (tile - 9) + p;
    return (bj == 0 ? 2632 : 3144) + 128 * (tile - 11) + 32 * wc;
}
__device__ __forceinline__ void p0_prologue(Frame& F) {
    LAS float* scr = (LAS float*)(F.lds + F.wave * 16384);
    const int gw = F.vcu * NWAVES + F.wave, NGW = F.G * NWAVES;
    const float* w_in = F.in[6]; const float* w_out = F.in[12]; const float* w_gate = F.in[18]; const float* w_up = F.in[19]; const float* w_down = F.in[20];
    h16* WINT = (h16*)(F.ws + WS_WINT); h16* WOUTT = (h16*)(F.ws + WS_WOUTT); h16* WGUT = (h16*)(F.ws + WS_WGUT); h16* WDT = (h16*)(F.ws + WS_WDT);
    constexpr int I_IN = 120 * 16, I_OUT = 32 * 16, I_GU = 32 * 16 * 16, I_D = 32 * 32 * 4, I_MOD = 96 * 16;
    constexpr int NITEMS = I_IN + I_OUT + I_GU + I_D + I_MOD;
    for (int it = gw; it < NITEMS; it += NGW) {
        int r = it;
        if (r < I_MOD) {
            const int cc = r % 96, ks = r / 96; const int col = cc * 64 + F.lane, k0 = ks * 64;
            const float* c = F.in[1]; const float* w_ada = F.in[3];
            float ca[8];
#pragma unroll
            for (int b = 0; b < 8; ++b) ca[b] = silu_f(c[b * 1024 + k0 + F.lane]);
            float a[8] = {0.f, 0.f, 0.f, 0.f, 0.f, 0.f, 0.f, 0.f};
#pragma unroll 8
            for (int kk = 0; kk < 64; ++kk) { const float w = w_ada[(size_t)(k0 + kk) * 6144 + col];
#pragma unroll
                for (int b = 0; b < 8; ++b) a[b] += __builtin_bit_cast(float, __builtin_amdgcn_readlane(__builtin_bit_cast(int, ca[b]), kk)) * w; }
            float* mp = (float*)(F.ws + WS_MODP) + (size_t)ks * 8 * 6144;
#pragma unroll
            for (int b = 0; b < 8; ++b) mp[b * 6144 + col] = a[b];
            continue;
        }
        r -= I_MOD;
        if (r < I_IN) { const int g = r >> 4, kb = r & 15; int nv; const int s0 = win_group_src(g, nv); transpose_item(w_in + s0, 3656, nv, kb * 64, WINT + (size_t)g * 32 * 1024, 1024, scr, F.lane); continue; } r -= I_IN;
        if (r < I_OUT) { const int g = r >> 4, kb = r & 15; transpose_item(w_out + g * 32, 1024, 32, kb * 64, WOUTT + (size_t)g * 32 * 1024, 1024, scr, F.lane); continue; } r -= I_OUT;
        if (r < I_GU) { const int e = r >> 8, g = (r >> 4) & 15, kb = r & 15; const int p = g * 32, t2 = p >> 8, bj = (p >> 7) & 1, wc = (p >> 5) & 3; const int f = 128 * t2 + 32 * wc;
            transpose_item((bj == 0 ? w_gate : w_up) + (size_t)e * 1024 * 256 + f, 256, 32, kb * 64, WGUT + ((size_t)e * 512 + p) * 1024, 1024, scr, F.lane); continue; } r -= I_GU;
        { const int e = r >> 7, g = (r >> 2) & 31, kb = r & 3; transpose_item(w_down + (size_t)e * 256 * 1024 + g * 32, 1024, 32, kb * 64, WDT + ((size_t)e * 1024 + g * 32) * 256, 256, scr, F.lane); }
    }
    { const float* wgr = F.in[14]; const float* wer = F.in[16]; h16* WRL = (h16*)(F.ws + WS_WRL);
      for (int idx = F.vcu * NTHR + F.tid; idx < 36 * 1024; idx += F.G * NTHR) { const int o = idx >> 10, rem = idx & 1023, ln = rem >> 4, ji = rem & 15, col = 4 * ln + 256 * (ji >> 2) + (ji & 3);
          WRL[idx] = (h16)(o < 4 ? wgr[col * 4 + o] : wer[col * 32 + (o - 4)]); } }
}

__device__ __forceinline__ void p1_norm1(Frame& F) {
    const float* modp = (const float*)(F.ws + WS_MODP); float* mod = (float*)(F.ws + WS_MOD); const float* b_ada = F.in[4];
    LAS float* sh = (LAS float*)F.lds; LAS float* sc = sh + 1024;
    const int b = F.vcu >> 5;
    for (int i = F.tid; i < 2048; i += NTHR) { float s = b_ada[i];
#pragma unroll
        for (int ks = 0; ks < 16; ++ks) s += modp[((size_t)ks * 8 + b) * 6144 + i];
        sh[i] = s; }
    if (F.tid < 192) { const int idx = F.vcu * 192 + F.tid; const int bb = idx / 6144, cc = idx % 6144; float s = b_ada[cc];
#pragma unroll
        for (int ks = 0; ks < 16; ++ks) s += modp[((size_t)ks * 8 + bb) * 6144 + cc];
        mod[idx] = s; }
    __syncthreads();
    const float* x = F.in[0]; const float* g1 = F.in[5]; h16* H = (h16*)(F.ws + WS_H);
    f32x4 gg[4], s1[4], h1[4];
#pragma unroll
    for (int j = 0; j < 4; ++j) { const int col = 4 * F.lane + 256 * j; gg[j] = *(const f32x4*)(g1 + col); h1[j] = *(const LAS f32x4*)(sh + col); s1[j] = *(const LAS f32x4*)(sc + col);
        gg[j] = gg[j] * (s1[j] + 1.f); }
    f32x4 vn[4];
    { const size_t row = (size_t)F.vcu * 128 + F.wave * 16;
#pragma unroll
      for (int j = 0; j < 4; ++j) vn[j] = *(const f32x4*)(x + row * 1024 + 4 * F.lane + 256 * j); }
    for (int rr = 0; rr < 16; ++rr) {
        const size_t row = (size_t)F.vcu * 128 + F.wave * 16 + rr; const size_t rown = row + (rr < 15 ? 1 : 0);
        f32x4 v[4]; float ss = 0.f;
#pragma unroll
        for (int j = 0; j < 4; ++j) { v[j] = vn[j]; vn[j] = *(const f32x4*)(x + rown * 1024 + 4 * F.lane + 256 * j); ss += (v[j][0] * v[j][0] + v[j][1] * v[j][1]) + (v[j][2] * v[j][2] + v[j][3] * v[j][3]); }
        const float rstd = rsqrtf(dpp_sum_f32(ss) * (1.f / 1024.f) + EPS);
#pragma unroll
        for (int j = 0; j < 4; ++j) { const f32x4 o = v[j] * rstd * gg[j] + h1[j]; u32x2 w; w.x = pk2h(o[0], o[1]); w.y = pk2h(o[2], o[3]); *(u32x2*)(H + row * 1024 + 4 * F.lane + 256 * j) = w; }
    }
}

__device__ __forceinline__ void p3_conv(Frame& F) {
    const h16* Z = (const h16*)(F.ws + WS_Z); const h16* GB = (const h16*)(F.ws + WS_GB); h16* MG = (h16*)(F.ws + WS_MERGED);
    const float* cw = F.in[9]; const float* cn = F.in[11];
    const int gw = F.vcu * NWAVES + F.wave, NGW = F.G * NWAVES; const int ch = 8 * F.lane;
    float w0[8], w1[8], w2[8], gn[8];
#pragma unroll
    for (int i = 0; i < 8; ++i) { w0[i] = cw[ch + i]; w1[i] = cw[512 + ch + i]; w2[i] = cw[1024 + ch + i]; gn[i] = cn[ch + i]; }
    for (int it = gw; it < M / 32; it += NGW) {
        const int t0 = it * 32; const bool first = (t0 & (SEQ - 1)) == 0;
        f16x8 zm2 = {}, zm1 = {};
        if (!first) { zm2 = *(const f16x8*)(Z + (size_t)(t0 - 2) * 512 + ch); zm1 = *(const f16x8*)(Z + (size_t)(t0 - 1) * 512 + ch); }
        for (int tt = 0; tt < 32; ++tt) {
            const size_t t = (size_t)t0 + tt;
            const f16x8 z0 = *(const f16x8*)(Z + t * 512 + ch); const f16x8 gb = *(const f16x8*)(GB + t * 512 + ch);
            float y[8]; float ss = 0.f;
#pragma unroll
            for (int i = 0; i < 8; ++i) { y[i] = (float)gb[i] * (w0[i] * (float)zm2[i] + w1[i] * (float)zm1[i] + w2[i] * (float)z0[i]); ss += y[i] * y[i]; }
            ss += __shfl_xor(ss, 1); ss += __shfl_xor(ss, 2); ss += __shfl_xor(ss, 4);
            const float rstd = rsqrtf(ss * (1.f / 64.f) + EPS);
            u32x4 o; o.x = pk2h(y[0] * rstd * gn[0], y[1] * rstd * gn[1]); o.y = pk2h(y[2] * rstd * gn[2], y[3] * rstd * gn[3]); o.z = pk2h(y[4] * rstd * gn[4], y[5] * rstd * gn[5]); o.w = pk2h(y[6] * rstd * gn[6], y[7] * rstd * gn[7]);
            *(u32x4*)(MG + t * 1024 + 512 + ch) = o;
            zm2 = zm1; zm1 = z0;
        }
    }
}

constexpr int IX_ROW = 4352, IX_NEG = 8 * IX_ROW * 4, IX_BM = IX_NEG + 256, IX_ST = IX_BM + 4096;
__device__ __forceinline__ unsigned fkey(float f) { const unsigned u = __builtin_bit_cast(unsigned, f); return u ^ ((u >> 31) ? 0xFFFFFFFFu : 0x80000000u); }
__device__ __forceinline__ float fkey_inv(unsigned k) { const unsigned u = (k >> 31) ? (k ^ 0x80000000u) : ~k; return __builtin_bit_cast(float, u); }
__device__ __forceinline__ float probit_lo(float p) {
    if (p < 0.02425f) { const float q = sqrtf(-2.f * __logf(p));
        return (((((-7.784894002430293e-03f * q - 3.223964580411365e-01f) * q - 2.400758277161838e+00f) * q - 2.549732539343734e+00f) * q + 4.374664141464968e+00f) * q + 2.938163982698783e+00f) /
               ((((7.784695709041462e-03f * q + 3.224671290700398e-01f) * q + 2.445134137142996e+00f) * q + 3.754408661907416e+00f) * q + 1.f); }
    const float q = p - 0.5f, r = q * q;
    return (((((-3.969683028665376e+01f * r + 2.209460984245205e+02f) * r - 2.759285104469687e+02f) * r + 1.383577518672690e+02f) * r - 3.066479806614716e+01f) * r + 2.506628277459239e+00f) * q /
           (((((-5.447609879822406e+01f * r + 1.615858368580409e+02f) * r - 1.556989798598866e+02f) * r + 6.680131188771972e+01f) * r - 1.328068155288572e+01f) * r + 1.f);
}
__device__ __forceinline__ void row_sum2(float v, float& h0, float& h1) {
    v += __builtin_bit_cast(float, __builtin_amdgcn_update_dpp(0, __builtin_bit_cast(int, v), 0xB1, 0xf, 0xf, false));
    v += __builtin_bit_cast(float, __builtin_amdgcn_update_dpp(0, __builtin_bit_cast(int, v), 0x4E, 0xf, 0xf, false));
    v += __builtin_bit_cast(float, __builtin_amdgcn_update_dpp(0, __builtin_bit_cast(int, v), 0x141, 0xf, 0xf, false));
    v += __builtin_bit_cast(float, __builtin_amdgcn_update_dpp(0, __builtin_bit_cast(int, v), 0x140, 0xf, 0xf, false));
    h0 = __builtin_bit_cast(float, __builtin_amdgcn_readlane(__builtin_bit_cast(int, v), 0)) + __builtin_bit_cast(float, __builtin_amdgcn_readlane(__builtin_bit_cast(int, v), 16));
    h1 = __builtin_bit_cast(float, __builtin_amdgcn_readlane(__builtin_bit_cast(int, v), 32)) + __builtin_bit_cast(float, __builtin_amdgcn_readlane(__builtin_bit_cast(int, v), 48));
}
__device__ __forceinline__ unsigned eval_mask(const float (&v)[64], float x, unsigned& a, unsigned& b) {
    unsigned ma = 0u, mb = 0u;
#pragma unroll
    for (int i = 31; i >= 0; --i) { ma = __builtin_amdgcn_alignbit(ma, __builtin_bit_cast(unsigned, v[i] - x), 31); mb = __builtin_amdgcn_alignbit(mb, __builtin_bit_cast(unsigned, v[32 + i] - x), 31); }
    a = ma; b = mb;
    return dpp_sum_u32(64u - (unsigned)__builtin_popcount(ma) - (unsigned)__builtin_popcount(mb));
}
__device__ __forceinline__ float probit(float p) { return p > 0.5f ? -probit_lo(1.f - p) : probit_lo(p); }
__device__ __forceinline__ unsigned count_ge(const float (&v)[64], float x) {
    unsigned c = 0;
#pragma unroll
    for (int i = 0; i < 64; ++i) c += (v[i] >= x) ? 1u : 0u;
    return dpp_sum_u32(c);
}
__device__ __forceinline__ float relu_i(float x) { const int i = __builtin_bit_cast(int, x); return __builtin_bit_cast(float, i > 0 ? i : 0); }
constexpr int IX_CTR = IX_ST + 512;
__device__ __forceinline__ void p3_indexer(Frame& F) {
    const h16* QI = (const h16*)(F.ws + WS_QI); const h16* KI = (const h16*)(F.ws + WS_KI); const float* WI = (const float*)(F.ws + WS_WI); u64* BM = (u64*)(F.ws + WS_BM);
    LAS float* sc = (LAS float*)F.lds;
    LAS float* st = (LAS float*)(F.lds + IX_ST);
    LAS unsigned* ctr = (LAS unsigned*)(F.lds + IX_CTR);
    const int lane = F.lane, wid = F.wave, r32 = lane & 31, hi = lane >> 5;
    if (F.tid < 64) ((LAS float*)(F.lds + IX_NEG))[F.tid] = -__builtin_inff();
    if (F.tid < 2) ctr[F.tid] = 0u;
    __syncthreads();
    const int hq = (r32 >> 2) & 1, rr = (r32 & 3) + 4 * (r32 >> 3), jq = 2 * hq + (rr >> 3), hh = rr & 7;
    f16x8 af[2][4]; f32x4 wraw[2][2][2];
#define IX_QLOAD(u_) do { const int idx_ = (u_) * 256 + (((u_) & 1) ? (255 - F.vcu) : F.vcu); const size_t rb_ = (size_t)(idx_ & 7) * SEQ + (size_t)(idx_ >> 3) * 8; \
        _Pragma("unroll") for (int rb = 0; rb < 2; ++rb) { const h16* qp = QI + (rb_ + 4 * rb + jq) * 512 + hh * 64 + hi * 8; \
            _Pragma("unroll") for (int ks = 0; ks < 4; ++ks) af[rb][ks] = *(const f16x8*)(qp + ks * 16); \
            _Pragma("unroll") for (int j2 = 0; j2 < 2; ++j2) { const float* wp = WI + (rb_ + 4 * rb + 2 * hi + j2) * 8; wraw[rb][j2][0] = *(const f32x4*)wp; wraw[rb][j2][1] = *(const f32x4*)(wp + 4); } } } while (0)
    IX_QLOAD(0);
    for (int u = 0; u < 16; ++u) {
        const int idx = u * 256 + ((u & 1) ? (255 - F.vcu) : F.vcu);
        const int b = idx & 7, t0 = (idx >> 3) * 8;
        const size_t rowb = (size_t)b * SEQ;
        const int nj = (t0 + 8 + 63) >> 6;
        {
            float wv[2][16];
#pragma unroll
            for (int rb = 0; rb < 2; ++rb)
#pragma unroll
                for (int j2 = 0; j2 < 2; ++j2)
#pragma unroll
                    for (int i = 0; i < 4; ++i) { wv[rb][8 * j2 + i] = wraw[rb][j2][0][i] * IDX_SCALE; wv[rb][8 * j2 + 4 + i] = wraw[rb][j2][1][i] * IDX_SCALE; }
            float ssum[2][2] = {{0.f, 0.f}, {0.f, 0.f}}, ssq[2][2] = {{0.f, 0.f}, {0.f, 0.f}};
            const h16* kbase = KI + (size_t)b * (128 * 2048) + lane * 8;
#define IX_GRAB(g_) do { unsigned t_ = 0; if (lane == 0) t_ = __hip_atomic_fetch_add(ctr + (u & 1), 1u, __ATOMIC_RELAXED, __HIP_MEMORY_SCOPE_WORKGROUP); g_ = (int)__builtin_amdgcn_readfirstlane(t_); } while (0)
#define IX_LOAD(dst, g_) do { const int gg_ = (g_) < nj ? (g_) : nj - 1; _Pragma("unroll") for (int q = 0; q < 2; ++q) { const h16* kp = kbase + (size_t)(2 * gg_ + q) * 2048; \
                _Pragma("unroll") for (int ks = 0; ks < 4; ++ks) dst[q][ks] = *(const f16x8*)(kp + ks * 512); } } while (0)
#define IX_COMP(kf, g_) do { _Pragma("unroll") for (int q = 0; q < 2; ++q) { const int tile = 2 * (g_) + q; \
                const int key = tile * 32 + r32; const int pos = key + 4 * (key >> 6); const bool diag = (tile * 32 + 31 > t0); \
                f32x16 a0 = {}, a1 = {}; \
                _Pragma("unroll") for (int ks = 0; ks < 4; ++ks) a0 = __builtin_amdgcn_mfma_f32_32x32x16_f16(af[0][ks], kf[q][ks], a0, 0, 0, 0); \
                _Pragma("unroll") for (int ks = 0; ks < 4; ++ks) a1 = __builtin_amdgcn_mfma_f32_32x32x16_f16(af[1][ks], kf[q][ks], a1, 0, 0, 0); \
                _Pragma("unroll") for (int rb = 0; rb < 2; ++rb) { float s0 = 0.f, s1 = 0.f; \
                    _Pragma("unroll") for (int r = 0; r < 8; ++r) { const float d0 = rb ? a1[r] : a0[r], d1 = rb ? a1[8 + r] : a0[8 + r]; \
                        s0 = __builtin_fmaf(relu_i(d0), wv[rb][r], s0); s1 = __builtin_fmaf(relu_i(d1), wv[rb][8 + r], s1); } \
                    float z0 = s0, z1 = s1; \
                    if (diag) { const int tq = t0 + 4 * rb + 2 * hi; const bool v0 = key <= tq, v1 = key <= tq + 1; z0 = v0 ? s0 : 0.f; z1 = v1 ? s1 : 0.f; s0 = v0 ? s0 : -__builtin_inff(); s1 = v1 ? s1 : -__builtin_inff(); } \
                    ssum[rb][0] += z0; ssq[rb][0] = __builtin_fmaf(z0, z0, ssq[rb][0]); ssum[rb][1] += z1; ssq[rb][1] = __builtin_fmaf(z1, z1, ssq[rb][1]); \
                    sc[(4 * rb + 2 * hi) * IX_ROW + pos] = s0; sc[(4 * rb + 2 * hi + 1) * IX_ROW + pos] = s1; } } } while (0)
            int gc, gn;
            IX_GRAB(gc);
            if (gc < nj) {
                f16x8 kA[2][4], kB[2][4];
                IX_LOAD(kA, gc);
                for (;;) {
                    IX_GRAB(gn); IX_LOAD(kB, gn); IX_COMP(kA, gc);
                    if (gn >= nj) break;
                    gc = gn;
                    IX_GRAB(gn); IX_LOAD(kA, gn); IX_COMP(kB, gc);
                    if (gn >= nj) break;
                    gc = gn;
                }
            }
#undef IX_GRAB
#undef IX_LOAD
#undef IX_COMP
#pragma unroll
            for (int rb = 0; rb < 2; ++rb)
#pragma unroll
                for (int j2 = 0; j2 < 2; ++j2) { float s0_, s1_, q0_, q1_; row_sum2(ssum[rb][j2], s0_, s1_); row_sum2(ssq[rb][j2], q0_, q1_);
                    if (lane == 0) { LAS float* sp = st + wid * 16 + (4 * rb + j2) * 2; sp[0] = s0_; sp[1] = q0_; sp[4] = s1_; sp[5] = q1_; } }
            IX_QLOAD(u < 15 ? u + 1 : 15);
        }
        __syncthreads();
        if (F.tid == 0) ctr[(u + 1) & 1] = 0u;
        const int t = t0 + wid, n = t + 1;
        float v[64]; float ssum_ = 0.f, ssq_ = 0.f;
        if (n > 256) {
            const LAS float* cp = (lane < nj) ? (sc + wid * IX_ROW + lane * 68) : (const LAS float*)(F.lds + IX_NEG);
#pragma unroll
            for (int i = 0; i < 16; ++i) { const f32x4 x = *(const LAS f32x4*)(cp + 4 * i); v[4 * i] = x[0]; v[4 * i + 1] = x[1]; v[4 * i + 2] = x[2]; v[4 * i + 3] = x[3]; }
#pragma unroll
            for (int w = 0; w < NWAVES; ++w) { ssum_ += st[w * 16 + wid * 2]; ssq_ += st[w * 16 + wid * 2 + 1]; }
        } else {
#pragma unroll
            for (int i = 0; i < 64; ++i) v[i] = 0.f;
        }
        __syncthreads();
        unsigned mlo = 0u, mhi = 0u;
        if (n <= 256) {
            const int rem = n - 64 * lane;
            if (rem > 0) { mlo = rem >= 32 ? 0xFFFFFFFFu : ((1u << rem) - 1u); mhi = rem >= 64 ? 0xFFFFFFFFu : (rem > 32 ? ((1u << (rem - 32)) - 1u) : 0u); }
        } else {
            const float fn = (float)n, mean = ssum_ / fn; const float var = fmaxf(ssq_ / fn - mean * mean, 1e-20f), sd = sqrtf(var);
            const float zq = -probit(256.f / fn);
            const float dens = fmaxf(fn * 0.3989423f * __expf(-0.5f * zq * zq) / sd, 1e-3f);
            float xl = -3.0e38f, xh = __builtin_inff(), cl = fn, ch = 0.f; bool hasL = false, hasH = false; int side = 0, zst = 0;
            float x = mean + fminf(fmaxf(zq, -6.f), 6.f) * sd, step = 0.f; unsigned na = 0u, nb = 0u;
            float tie_v = 0.f; int tie_need = 0;
            const float DMIN = __builtin_bit_cast(float, 1u);
            int it = 0;
            for (;;) {
                ++it;
                unsigned kx = fkey(x); const unsigned kl = fkey(xl), kh = fkey(xh);
                if (!(kx > kl && kx < kh)) kx = kl + ((kh - kl) >> 1);
                x = fkey_inv(kx);
                const unsigned c = eval_mask(v, x, na, nb);
                if (c == 256u) break;
                if (c > 256u) { xl = x; cl = (float)c; hasL = true; if (side == 1) ch = 256.f + 0.5f * (ch - 256.f); side = 1; }
                else          { xh = x; ch = (float)c; hasH = true; if (side == 2) cl = 256.f + 0.5f * (cl - 256.f); side = 2; }
                const unsigned kl2 = fkey(xl), kh2 = fkey(xh);
                if (kh2 - kl2 <= 1u) {
                    const unsigned chx = eval_mask(v, xh, na, nb); tie_v = xl; tie_need = 256 - (int)chx; break; }
                if (!(hasL && hasH)) { step = (step == 0.f) ? fminf(fabsf((float)c - 256.5f) / dens * 1.25f + 0.02f * sd, 2.f * sd) : 2.f * step; x = (c > 256u) ? x + step : x - step; }
                else if (zst == 0 && it >= 2 && xl <= 0.f && xh > DMIN) { zst = 1; x = DMIN; }
                else if (zst == 1 && xh == DMIN && xl < 0.f) { zst = 2; x = 0.f; }
                else if (it >= 8 && (it & 1)) x = fkey_inv(kl2 + ((kh2 - kl2) >> 1));
                else x = xl + (xh - xl) * ((cl - 256.5f) / (cl - ch));
            }
            mlo = ~na; mhi = ~nb;
            if (tie_need > 0) {
                unsigned ce = 0;
#pragma unroll
                for (int i = 0; i < 64; ++i) ce += (v[i] == tie_v) ? 1u : 0u;
                unsigned pre = ce;
#pragma unroll
                for (int o = 1; o < 64; o <<= 1) { const unsigned y = __shfl_up(pre, o); pre += (lane >= o) ? y : 0u; }
                int allow = tie_need - (int)(pre - ce); allow = allow < 0 ? 0 : allow;
#pragma unroll
                for (int i = 0; i < 64; ++i) { if (v[i] == tie_v && allow > 0) { if (i < 32) mlo |= 1u << i; else mhi |= 1u << (i - 32); --allow; } }
            }
        }
        if (lane <= 4 * (t0 >> 8) + 3) BM[((size_t)b * 64 + lane) * 4096 + t] = ((u64)mhi << 32) | mlo;
    }
    __syncthreads();
}

constexpr int AL_K = 0, AL_V = 16384, AL_M = 32768, AL_LUT = 36864, AL_WS = 37888, AL_OST = 40960;
constexpr int OST_STRIDE = 68;
__device__ __forceinline__ float sel_bfi(unsigned m, unsigned a, unsigned b) { unsigned d; asm("v_bfi_b32 %0, %1, %2, %3" : "=v"(d) : "v"(m), "v"(a), "s"(b)); return __builtin_bit_cast(float, d); }
__device__ __forceinline__ int crow(int r, int hi) { return (r & 3) + 8 * (r >> 2) + 4 * hi; }
__device__ __forceinline__ void attn_unit(Frame& F, int b, int h, int qb) {
    const h16* Q = (const h16*)(F.ws + WS_Q); const h16* Kg = (const h16*)(F.ws + WS_K); const h16* Vg = (const h16*)(F.ws + WS_V); const u64* BM = (const u64*)(F.ws + WS_BM);
    h16* MG = (h16*)(F.ws + WS_MERGED);
    const int tid = F.tid, lane = F.lane, wid = F.wave, r32 = lane & 31, hi = lane >> 5, grp = wid >> 2;
    const size_t rowb = (size_t)b * SEQ; const int q0 = qb * 256;
    LAS unsigned char* L = F.lds;
    LAS float* lut = (LAS float*)(L + AL_LUT); LAS float* wsf = (LAS float*)(L + AL_WS) + wid * 64; LAS float* ost = (LAS float*)(L + AL_OST) + wid * (32 * OST_STRIDE);
    if (tid < 129) lut[tid] = F.in[2][T5_BKT[tid] * 8 + h] * LOG2E;
    const float cfar = F.in[2][31 * 8 + h] * LOG2E;
    const int NT = (q0 + 256) / 64;
    const h16* ksrc = Kg + (size_t)(b * 8 + h) * 64 * 4096 + wid * 512 + lane * 8;
    const h16* vsrc = Vg + (size_t)(b * 8 + h) * 64 * 4096 + wid * 512 + lane * 8;
    const u64* msrc = BM + (size_t)b * 64 * 4096 + q0 + wid * 32 + r32;
    u32x4 kreg, vreg;
#define A_LOAD(t) do { kreg = *(const u32x4*)(ksrc + (size_t)(t) * 4096); vreg = *(const u32x4*)(vsrc + (size_t)(t) * 4096); } while (0)
#define A_STORE(buf) do { *(LAS u32x4*)(L + AL_K + (buf) * 8192 + wid * 1024 + lane * 16) = kreg; *(LAS u32x4*)(L + AL_V + (buf) * 8192 + wid * 1024 + lane * 16) = vreg; } while (0)
#define A_BAR() asm volatile("s_barrier" ::: "memory")
    const int qpos = q0 + wid * 32 + r32;
    const int qmin = q0 + wid * 32;
    const unsigned NEGINF = 0xFF800000u;
    float mref = 0.f, lrun = 0.f; bool hasmass = false; f32x16 o[2]; o[0] = f32x16{}; o[1] = f32x16{};
    f32x16 p0, p1;
#define A_COP(t_, mw_) do { const unsigned wl = (unsigned)(mw_) >> (4 * hi), wh = (unsigned)((mw_) >> 32) >> (4 * hi); \
        if ((qmin - (64 * (t_) + 63)) >= 128) { const unsigned cb = __builtin_bit_cast(unsigned, cfar - mref); \
            _Pragma("unroll") for (int r = 0; r < 16; ++r) { const int c = (r & 3) + 8 * (r >> 2); const unsigned s0 = (unsigned)__builtin_amdgcn_sbfe((int)wl, c, 1), s1 = (unsigned)__builtin_amdgcn_sbfe((int)wh, c, 1); \
                p0[r] = sel_bfi(s0, cb, NEGINF); p1[r] = sel_bfi(s1, cb, NEGINF); } \
        } else { const int base = qpos - 64 * (t_) - 4 * hi; \
            _Pragma("unroll") for (int r = 0; r < 16; ++r) { const int c = (r & 3) + 8 * (r >> 2); int i0 = base - c, i1 = base - c - 32; i0 = i0 < 0 ? 0 : (i0 > 128 ? 128 : i0); i1 = i1 < 0 ? 0 : (i1 > 128 ? 128 : i1); \
                const unsigned s0 = (unsigned)__builtin_amdgcn_sbfe((int)wl, c, 1), s1 = (unsigned)__builtin_amdgcn_sbfe((int)wh, c, 1); \
                const unsigned c0 = __builtin_bit_cast(unsigned, lut[i0] - mref), c1 = __builtin_bit_cast(unsigned, lut[i1] - mref); \
                p0[r] = sel_bfi(s0, c0, NEGINF); p1[r] = sel_bfi(s1, c1, NEGINF); } } } while (0)
    u64 mw, mwn;
    { const u32x4 k0r = *(const u32x4*)ksrc, v0r = *(const u32x4*)vsrc;
      A_LOAD(1); mw = msrc[0]; mwn = msrc[4096];
      *(LAS u32x4*)(L + AL_K + wid * 1024 + lane * 16) = k0r; *(LAS u32x4*)(L + AL_V + wid * 1024 + lane * 16) = v0r; }
    f16x8 qr[4];
    { const h16* qp = Q + (rowb + q0 + wid * 32 + r32) * 512 + h * 64 + hi * 8;
#pragma unroll
      for (int d0 = 0; d0 < 4; ++d0) qr[d0] = *(const f16x8*)(qp + d0 * 16); }
    __syncthreads();
    if (grp == 1) A_BAR();
    A_COP(0, mw); mw = mwn;
    const int vboff = ((lane >> 4) & 1) * 32 + (lane & 3) * 8 + (4 * hi + ((lane & 15) >> 2)) * 64;
    for (int t = 0; t < NT; ++t) {
        const int cur = t & 1;
        f16x8 kfr[8];
        { const LAS unsigned char* kb = L + AL_K + cur * 8192 + hi * 1024 + r32 * 16;
#pragma unroll
          for (int d0 = 0; d0 < 4; ++d0) { kfr[2 * d0] = *(const LAS f16x8*)(kb + d0 * 2048); kfr[2 * d0 + 1] = *(const LAS f16x8*)(kb + d0 * 2048 + 512); } }
        A_STORE(cur ^ 1);
        { const int tl = (t + 2 < NT) ? t + 2 : NT - 1; A_LOAD(tl); mwn = msrc[(size_t)tl * 4096]; }
        s16x4 vlo[8], vhi[8];
        { LAS unsigned char* vb = L + AL_V + cur * 8192 + vboff;
#pragma unroll
          for (int i = 0; i < 8; ++i) { vlo[i] = __builtin_amdgcn_ds_read_tr16_b64_v4i16((LAS s16x4*)(vb + (i >> 2) * 4096 + (i & 3) * 1024)); vhi[i] = __builtin_amdgcn_ds_read_tr16_b64_v4i16((LAS s16x4*)(vb + (i >> 2) * 4096 + (i & 3) * 1024 + 512)); } }
        __builtin_amdgcn_sched_barrier(0);
#pragma unroll
        for (int d0 = 0; d0 < 4; ++d0) { p0 = __builtin_amdgcn_mfma_f32_32x32x16_f16(kfr[2 * d0], qr[d0], p0, 0, 0, 0); p1 = __builtin_amdgcn_mfma_f32_32x32x16_f16(kfr[2 * d0 + 1], qr[d0], p1, 0, 0, 0); }
        __builtin_amdgcn_sched_barrier(0);
        asm volatile("s_waitcnt lgkmcnt(0)\n\ts_barrier" ::: "memory");
        __builtin_amdgcn_sched_barrier(0);
        float rs = 0.f;
#pragma unroll
        for (int r = 0; r < 16; ++r) { p0[r] = __builtin_amdgcn_exp2f(p0[r]); p1[r] = __builtin_amdgcn_exp2f(p1[r]); rs += p0[r] + p1[r]; }
        const float pm = rs + __shfl_xor(rs, 32);
        const bool need = (pm > 256.f) || (!hasmass && pm > 0.f);
        if (__any(need)) {
            const float f = need ? 1.f / pm : 1.f;
            mref += need ? __builtin_amdgcn_logf(pm) : 0.f;
            rs *= f; lrun *= f;
#pragma unroll
            for (int r = 0; r < 16; ++r) { float a_ = p0[r], b_ = p1[r]; asm("v_mul_f32 %0, %0, %1" : "+v"(a_) : "v"(f)); asm("v_mul_f32 %0, %0, %1" : "+v"(b_) : "v"(f)); p0[r] = a_; p1[r] = b_; }
            if (hi == 0) wsf[r32] = f;
            LDS_WAIT();
#pragma unroll
            for (int r = 0; r < 16; ++r) { const float a = wsf[crow(r, hi)]; o[0][r] *= a; o[1][r] *= a; }
        }
        hasmass = hasmass || (pm > 0.f);
        lrun += rs;
        u32x4 pw[4];
        pw[0] = (u32x4){pk2h(p0[0], p0[1]), pk2h(p0[2], p0[3]), pk2h(p0[4], p0[5]), pk2h(p0[6], p0[7])};
        pw[1] = (u32x4){pk2h(p0[8], p0[9]), pk2h(p0[10], p0[11]), pk2h(p0[12], p0[13]), pk2h(p0[14], p0[15])};
        pw[2] = (u32x4){pk2h(p1[0], p1[1]), pk2h(p1[2], p1[3]), pk2h(p1[4], p1[5]), pk2h(p1[6], p1[7])};
        pw[3] = (u32x4){pk2h(p1[8], p1[9]), pk2h(p1[10], p1[11]), pk2h(p1[12], p1[13]), pk2h(p1[14], p1[15])};
        __builtin_amdgcn_sched_barrier(0);
#pragma unroll
        for (int d0 = 0; d0 < 2; ++d0)
#pragma unroll
            for (int ks = 0; ks < 4; ++ks) { const int i = d0 * 4 + ks;
                typedef short s16x8 __attribute__((ext_vector_type(8)));
                const s16x8 vv = {vlo[i][0], vlo[i][1], vlo[i][2], vlo[i][3], vhi[i][0], vhi[i][1], vhi[i][2], vhi[i][3]};
                o[d0] = __builtin_amdgcn_mfma_f32_32x32x16_f16(__builtin_bit_cast(f16x8, pw[ks]), __builtin_bit_cast(f16x8, vv), o[d0], 0, 0, 0); }
        A_COP(t + 1, mw); mw = mwn;
        A_BAR();
    }
    if (grp == 0) A_BAR();
#undef A_LOAD
#undef A_STORE
#undef A_BAR
#undef A_COP
    lrun += __shfl_xor(lrun, 32);
    if (hi == 0) wsf[r32] = 1.f / lrun;
    LDS_WAIT();
#pragma unroll
    for (int r = 0; r < 16; ++r) { const float rl = wsf[crow(r, hi)]; const int qrow = crow(r, hi);
        ost[qrow * OST_STRIDE + r32] = o[0][r] * rl; ost[qrow * OST_STRIDE + 32 + r32] = o[1][r] * rl; }
    LDS_WAIT();
    { const int row = lane >> 1, hf = lane & 1; const LAS float* rp = ost + row * OST_STRIDE + hf * 32;
      f32x4 xv[8]; float ss = 0.f;
#pragma unroll
      for (int i = 0; i < 8; ++i) { xv[i] = *(const LAS f32x4*)(rp + 4 * i); ss += (xv[i][0] * xv[i][0] + xv[i][1] * xv[i][1]) + (xv[i][2] * xv[i][2] + xv[i][3] * xv[i][3]); }
      ss += __shfl_xor(ss, 1);
      const float rstd = rsqrtf(ss * (1.f / 64.f) + EPS);
      const float* gn = F.in[10] + h * 64 + hf * 32;
      h16* op = MG + (rowb + q0 + wid * 32 + row) * 1024 + h * 64 + hf * 32;
#pragma unroll
      for (int i = 0; i < 4; ++i) { const f32x4 g0 = *(const f32x4*)(gn + 8 * i), g1 = *(const f32x4*)(gn + 8 * i + 4);
          *(u32x4*)(op + 8 * i) = pk8h(xv[2 * i] * rstd * g0, xv[2 * i + 1] * rstd * g1); } }
    __syncthreads();
}
__device__ __forceinline__ void p4_attention(Frame& F) {
    const int bh = F.vcu >> 2, c = F.vcu & 3;
    for (int i = 0; i < 4; ++i) { const int qb = (i == 0) ? 2 * c : (i == 1) ? 15 - 2 * c : (i == 2) ? 2 * c + 1 : 14 - 2 * c; attn_unit(F, bh >> 3, bh & 7, qb); }
}

__device__ __forceinline__ void p6_norm2_route(Frame& F) {
    const float* mod = (const float*)(F.ws + WS_MOD); const float* g2 = F.in[13]; h16* H2 = (h16*)(F.ws + WS_H); const float* x1 = F.out;
    const h16* WRLg = (const h16*)(F.ws + WS_WRL);
    LAS h16* wrl = (LAS h16*)F.lds;
    LAS unsigned* lcnt = (LAS unsigned*)(F.lds + 73728);
    LAS unsigned* lbase = lcnt + 32;
    LAS unsigned* rinfo = (LAS unsigned*)(F.lds + 73728 + 256);
    for (int i = F.tid; i < 36 * 1024 / 8; i += NTHR) *(LAS u32x4*)(wrl + i * 8) = *(const u32x4*)(WRLg + i * 8);
    if (F.tid < 32) lcnt[F.tid] = 0u;
    __syncthreads();
    const int b = F.vcu >> 5;
    const float* bgr = F.in[15]; const float* ber = F.in[17];
    f32x4 gg[4], hh[4];
#pragma unroll
    for (int j = 0; j < 4; ++j) { const int col = 4 * F.lane + 256 * j; gg[j] = *(const f32x4*)(g2 + col) * (*(const f32x4*)(mod + (size_t)b * 6144 + 4096 + col) + 1.f); hh[j] = *(const f32x4*)(mod + (size_t)b * 6144 + 3072 + col); }
    f32x4 vn[4];
    { const size_t row = (size_t)F.vcu * 128 + F.wave * 16;
#pragma unroll
      for (int j = 0; j < 4; ++j) vn[j] = *(const f32x4*)(x1 + row * 1024 + 4 * F.lane + 256 * j); }
    for (int rr = 0; rr < 16; ++rr) {
        const int lrow = F.wave * 16 + rr; const size_t row = (size_t)F.vcu * 128 + lrow; const size_t rown = row + (rr < 15 ? 1 : 0);
        f32x4 v[4]; float ss = 0.f;
#pragma unroll
        for (int j = 0; j < 4; ++j) { v[j] = vn[j]; vn[j] = *(const f32x4*)(x1 + rown * 1024 + 4 * F.lane + 256 * j); ss += (v[j][0] * v[j][0] + v[j][1] * v[j][1]) + (v[j][2] * v[j][2] + v[j][3] * v[j][3]); }
        const float rstd = rsqrtf(dpp_sum_f32(ss) * (1.f / 1024.f) + EPS);
#pragma unroll
        for (int j = 0; j < 4; ++j) { v[j] = v[j] * rstd * gg[j] + hh[j]; u32x2 w; w.x = pk2h(v[j][0], v[j][1]); w.y = pk2h(v[j][2], v[j][3]); *(u32x2*)(H2 + row * 1024 + 4 * F.lane + 256 * j) = w; }
        float lg[4];
#pragma unroll
        for (int o = 0; o < 4; ++o) { const f16x8 wa = *(const LAS f16x8*)(wrl + (o * 64 + F.lane) * 16), wb = *(const LAS f16x8*)(wrl + (o * 64 + F.lane) * 16 + 8);
            float s = 0.f;
#pragma unroll
            for (int i = 0; i < 4; ++i) { s += v[0][i] * (float)wa[i]; s += v[1][i] * (float)wa[4 + i]; s += v[2][i] * (float)wb[i]; s += v[3][i] * (float)wb[4 + i]; }
            lg[o] = dpp_sum_f32(s) + bgr[o]; }
        int gs = 0; float gm = lg[0];
#pragma unroll
        for (int g = 1; g < 4; ++g) if (lg[g] > gm) { gm = lg[g]; gs = g; }
        float gden = 0.f;
#pragma unroll
        for (int g = 0; g < 4; ++g) gden += __expf(lg[g] - gm);
        const float pg = 1.f / gden;
        gs = __builtin_amdgcn_readfirstlane(gs);
        float el[8];
        { const LAS h16* wsel = wrl + ((4 + 8 * gs) * 64 + F.lane) * 16; const float* bsel = ber + 8 * gs;
#pragma unroll
          for (int e = 0; e < 8; ++e) { const f16x8 wa = *(const LAS f16x8*)(wsel + e * 1024), wb = *(const LAS f16x8*)(wsel + e * 1024 + 8);
            float s = 0.f;
#pragma unroll
            for (int i = 0; i < 4; ++i) { s += v[0][i] * (float)wa[i]; s += v[1][i] * (float)wa[4 + i]; s += v[2][i] * (float)wb[i]; s += v[3][i] * (float)wb[4 + i]; }
            el[e] = dpp_sum_f32(s) + bsel[e]; } }
        int e0 = 0; float m0 = el[0];
#pragma unroll
        for (int e = 1; e < 8; ++e) if (el[e] > m0) { m0 = el[e]; e0 = e; }
        int e1 = -1; float m1 = -__builtin_inff();
#pragma unroll
        for (int e = 0; e < 8; ++e) if (e != e0 && el[e] > m1) { m1 = el[e]; e1 = e; }
        const float p1 = __expf(m1 - m0); const float w0 = pg / (1.f + p1), w1 = pg * p1 / (1.f + p1);
        if (F.lane == 0) {
            const unsigned E0 = (unsigned)(gs * 8 + e0), E1 = (unsigned)(gs * 8 + e1);
            const unsigned r0 = atomicAdd((unsigned*)(lcnt + E0), 1u), r1 = atomicAdd((unsigned*)(lcnt + E1), 1u);
            rinfo[lrow * 8 + 0] = E0; rinfo[lrow * 8 + 1] = r0; rinfo[lrow * 8 + 2] = __builtin_bit_cast(unsigned, w0);
            rinfo[lrow * 8 + 3] = E1; rinfo[lrow * 8 + 4] = r1; rinfo[lrow * 8 + 5] = __builtin_bit_cast(unsigned, w1);
        }
    }
    __syncthreads();
    unsigned* gcnt = (unsigned*)(F.ws + WS_CTL) + CW_GCNT;
    if (F.tid < 32) lbase[F.tid] = atomicAdd(gcnt + F.tid, lcnt[F.tid]);
    __syncthreads();
    if (F.tid < 128) { unsigned* ro = (unsigned*)(F.ws + WS_ROUTE) + ((size_t)F.vcu * 128 + F.tid) * 8;
        const unsigned E0 = rinfo[F.tid * 8 + 0], E1 = rinfo[F.tid * 8 + 3];
        ro[0] = E0; ro[1] = lbase[E0] + rinfo[F.tid * 8 + 1]; ro[2] = rinfo[F.tid * 8 + 2]; ro[3] = E1; ro[4] = lbase[E1] + rinfo[F.tid * 8 + 4]; ro[5] = rinfo[F.tid * 8 + 5]; }
    __syncthreads();
}
__device__ __forceinline__ void expert_offsets(Frame& F, LAS unsigned* off) {
    const unsigned* gcnt = (const unsigned*)(F.ws + WS_CTL) + CW_GCNT;
    if (F.tid == 0) { unsigned a = 0; for (int e = 0; e < 32; ++e) { off[e] = a; a += (__hip_atomic_load(gcnt + e, RLX_AGENT) + 255u) & ~255u; } off[32] = a; }
    __syncthreads();
}
__device__ __forceinline__ void p7_rowmap(Frame& F) {
    LAS unsigned* off = (LAS unsigned*)F.lds;
    expert_offsets(F, off);
    int* rowmap = (int*)(F.ws + WS_ROWMAP); const unsigned* gcnt = (const unsigned*)(F.ws + WS_CTL) + CW_GCNT; int* tile_e = (int*)(F.ws + WS_CTL) + 1024;
    if (F.tid < 128) { const size_t tok = (size_t)F.vcu * 128 + F.tid; const unsigned* ro = (const unsigned*)(F.ws + WS_ROUTE) + tok * 8;
        rowmap[off[ro[0]] + ro[1]] = (int)tok; rowmap[off[ro[3]] + ro[4]] = (int)tok; }
    if (F.vcu < 32) { const int e = F.vcu; const unsigned c = __hip_atomic_load(gcnt + e, RLX_AGENT); for (unsigned r = off[e] + c + F.tid; r < off[e + 1]; r += NTHR) rowmap[r] = -1;
        for (unsigned t = off[e] / 256 + F.tid; t < off[e + 1] / 256; t += NTHR) tile_e[t] = e; }
    __syncthreads();
}
__device__ __forceinline__ void p10_combine(Frame& F) {
    LAS unsigned* off = (LAS unsigned*)F.lds;
    expert_offsets(F, off);
    const float* mod = (const float*)(F.ws + WS_MOD); const h16* Y = (const h16*)(F.ws + WS_Y); float* out = F.out;
    const int b = F.vcu >> 5;
    f32x4 g2[4];
#pragma unroll
    for (int j = 0; j < 4; ++j) g2[j] = *(const f32x4*)(mod + (size_t)b * 6144 + 5120 + 4 * F.lane + 256 * j);
    const size_t rowbase = (size_t)F.vcu * 128 + F.wave * 16;
    unsigned P0l = 0u, P1l = 0u; float C0l = 0.f, C1l = 0.f;
    if (F.lane < 16) { const unsigned* ro = (const unsigned*)(F.ws + WS_ROUTE) + (rowbase + F.lane) * 8; P0l = off[ro[0]] + ro[1]; P1l = off[ro[3]] + ro[4]; C0l = __builtin_bit_cast(float, ro[2]); C1l = __builtin_bit_cast(float, ro[5]); }
    f16x4 y0n[4], y1n[4]; f32x4 xn[4];
    { const size_t p0 = (unsigned)__shfl((int)P0l, 0), p1 = (unsigned)__shfl((int)P1l, 0);
#pragma unroll
      for (int j = 0; j < 4; ++j) { const int col = 4 * F.lane + 256 * j; y0n[j] = *(const f16x4*)(Y + p0 * 1024 + col); y1n[j] = *(const f16x4*)(Y + p1 * 1024 + col); xn[j] = *(const f32x4*)(out + rowbase * 1024 + col); } }
    for (int rr = 0; rr < 16; ++rr) {
        const size_t row = rowbase + rr; const int rn = rr < 15 ? rr + 1 : rr;
        const float c0 = __shfl(C0l, rr), c1 = __shfl(C1l, rr);
        const size_t p0n = (unsigned)__shfl((int)P0l, rn), p1n = (unsigned)__shfl((int)P1l, rn);
#pragma unroll
        for (int j = 0; j < 4; ++j) { const int col = 4 * F.lane + 256 * j;
            const f16x4 y0 = y0n[j], y1 = y1n[j]; f32x4 xv = xn[j];
            y0n[j] = *(const f16x4*)(Y + p0n * 1024 + col); y1n[j] = *(const f16x4*)(Y + p1n * 1024 + col); xn[j] = *(const f32x4*)(out + (rowbase + rn) * 1024 + col);
#pragma unroll
            for (int i = 0; i < 4; ++i) xv[i] += g2[j][i] * (c0 * (float)y0[i] + c1 * (float)y1[i]);
            *(f32x4*)(out + row * 1024 + col) = xv; }
    }
}
constexpr int N_PHASES = 11;
__global__ void __launch_bounds__(NTHR, 2) mega_fwd(Args args) {
    extern __shared__ __attribute__((aligned(16))) unsigned char lds_raw[];
    Frame F;
    F.lds = (LAS unsigned char*)lds_raw; F.ldsg = lds_raw;
    F.tid = threadIdx.x; F.lane = F.tid & 63; F.wave = __builtin_amdgcn_readfirstlane(F.tid >> 6);
    F.G = gridDim.x; { const int bx = blockIdx.x; F.vcu = (F.G % 8 == 0) ? (bx % 8) * (F.G / 8) + bx / 8 : bx; }
    F.in = (const float* const __attribute__((address_space(4)))*)__builtin_amdgcn_kernarg_segment_ptr();
    F.out = args.out; F.ws = args.ws;
    volatile LAS unsigned* MISC = (volatile LAS unsigned*)(F.lds + MISC_OFF);
    if (F.tid < 16) MISC[F.tid] = 0u;
    __syncthreads();
    const int lo = args.ph_lo, hi = args.ph_hi;
    XcdBarrier bar; bar.bar = (unsigned*)(F.ws + WS_CTL) + CW_BAR; bar.x = 0; bar.st = nullptr;
    if (hi - lo > 1) bar = xcd_barrier_post((unsigned*)(F.ws + WS_CTL) + CW_BAR, MISC + 8);
#define IN(k) (lo <= (k) && (k) < hi)
#define STAMP(k) do {} while (0)
#define SEAM(k) do { if (IN(k) && IN((k) + 1)) xcd_barrier(bar); STAMP((k) + 1); } while (0)
    STAMP(0);
    if (IN(0)) { p0_prologue(F); }
    if (lo < 0) { cg::this_grid().sync(); }
    SEAM(0);
    if (IN(1)) { p1_norm1(F); }
    SEAM(1);
    if (IN(2)) {
        pg8::Gemm g{(const h16*)(F.ws + WS_H), (const h16*)(F.ws + WS_WINT), M, NINP, DM, 0, nullptr}; pg8::StaticOrder S; S.init(M, NINP, F.G, (int)blockIdx.x);
        EpiInProj E{(h16*)(F.ws + WS_Q), (h16*)(F.ws + WS_K), (h16*)(F.ws + WS_V), (h16*)(F.ws + WS_QI), (h16*)(F.ws + WS_KI), (h16*)(F.ws + WS_GB), (h16*)(F.ws + WS_Z), (float*)(F.ws + WS_WI), F.in[7], F.in[8]};
        pg8::gemm_phase<EpiInProj, pg8::StaticOrder, false>(F.lds, g, S, E);
    }
    SEAM(2);
    if (IN(3)) { p3_conv(F); p3_indexer(F); }
    SEAM(3);
    if (IN(4)) { p4_attention(F); }
    SEAM(4);
    if (IN(5)) {
        pg8::Gemm g{(const h16*)(F.ws + WS_MERGED), (const h16*)(F.ws + WS_WOUTT), M, DM, DM, 0, nullptr}; pg8::StaticOrder S; S.init(M, DM, F.G, (int)blockIdx.x);
        EpiOutProj E{F.in[0], F.out, (const float*)(F.ws + WS_MOD)};
        pg8::gemm_phase<EpiOutProj, pg8::StaticOrder, false>(F.lds, g, S, E);
    }
    SEAM(5);
    if (IN(6)) { p6_norm2_route(F); }
    SEAM(6);
    if (IN(7)) { p7_rowmap(F); }
    SEAM(7);
    if (IN(8)) {
        LAS unsigned* off = (LAS unsigned*)(F.lds + RING_BYTES); expert_offsets(F, off); const int ntiles = (int)(off[32] / 256u); __syncthreads();
        pg8::Gemm g{(const h16*)(F.ws + WS_H), (const h16*)(F.ws + WS_WGUT), 0, 512, DM, (size_t)512 * 1024 * 2, (const int*)(F.ws + WS_ROWMAP)};
        pg8::GroupedOrder S{(const int*)(F.ws + WS_CTL) + 1024, ntiles, 2, F.G, F.vcu};
        EpiMoeUp E{(h16*)(F.ws + WS_HID)};
        pg8::gemm_phase<EpiMoeUp, pg8::GroupedOrder, true>(F.lds, g, S, E);
    }
    SEAM(8);
    if (IN(9)) {
        LAS unsigned* off = (LAS unsigned*)(F.lds + RING_BYTES); expert_offsets(F, off); const int ntiles = (int)(off[32] / 256u); __syncthreads();
        pg8::Gemm g{(const h16*)(F.ws + WS_HID), (const h16*)(F.ws + WS_WDT), 0, 1024, EFF, (size_t)1024 * 256 * 2, nullptr};
        pg8::GroupedOrder S{(const int*)(F.ws + WS_CTL) + 1024, ntiles, 4, F.G, F.vcu};
        EpiMoeDown E{(h16*)(F.ws + WS_Y)};
        pg8::gemm_phase<EpiMoeDown, pg8::GroupedOrder, false>(F.lds, g, S, E);
    }
    SEAM(9);
    if (IN(10)) { p10_combine(F); }

#undef IN
#undef SEAM
}

extern "C" void kernel_launch(void* const* d_in, const int* in_sizes, int n_in, void* d_out, int out_size, void* d_ws, size_t ws_size, hipStream_t stream) {
    static int grid = 0;
    if (grid == 0) {
        if (n_in != 21 || out_size != M * DM || ws_size < WS_END) { fprintf(stderr, "kernel_launch: unexpected shapes (n_in %d out %d ws %zu)\n", n_in, out_size, ws_size); grid = -1; return; }
        int dev = 0, cus = 0, per_cu = 0;
        (void)hipGetDevice(&dev); (void)hipDeviceGetAttribute(&cus, hipDeviceAttributeMultiprocessorCount, dev);
        if (hipFuncSetAttribute((const void*)mega_fwd, hipFuncAttributeMaxDynamicSharedMemorySize, LDS_BYTES) != hipSuccess) { fprintf(stderr, "kernel_launch: hipFuncSetAttribute failed\n"); grid = -1; return; }
        if (hipOccupancyMaxActiveBlocksPerMultiprocessor(&per_cu, (const void*)mega_fwd, NTHR, LDS_BYTES) != hipSuccess || per_cu < 1) { fprintf(stderr, "kernel_launch: occupancy query says %d\n", per_cu); per_cu = 1; }
        (void)hipGetLastError();
        grid = cus;
        if (grid != 256) { fprintf(stderr, "kernel_launch: built for 256 CUs, got %d\n", grid); }
    }
    if (grid < 0) return;
    (void)hipMemsetAsync((char*)d_ws + WS_CTL, 0, CTL_ZERO_BYTES, stream);
    Args a{};
    for (int i = 0; i < 21; ++i) a.in[i] = (const float*)d_in[i];
    a.out = (float*)d_out; a.ws = (unsigned char*)d_ws;
#if MK_N_LAUNCHES == 1
    a.ph_lo = 0; a.ph_hi = N_PHASES;
    void* kargs[] = {&a};
    hipError_t e = hipLaunchCooperativeKernel((const void*)mega_fwd, dim3(grid), dim3(NTHR), kargs, LDS_BYTES, stream);
    if (e != hipSuccess) fprintf(stderr, "cooperative launch failed: %s\n", hipGetErrorString(e));
#else
    for (int p = 0; p < N_PHASES; ++p) { a.ph_lo = p; a.ph_hi = p + 1; hipLaunchKernelGGL(mega_fwd, dim3(grid), dim3(NTHR), LDS_BYTES, stream, a); }
#endif
}
```

```cpp
#include <hip/hip_runtime.h>
#include <hip/hip_cooperative_groups.h>
#include <cstdio>
#include <cstdint>
namespace cg = cooperative_groups;

#ifndef MK_N_LAUNCHES

#define MK_N_LAUNCHES 1
#endif

#define LAS __attribute__((address_space(3)))
#define GAS __attribute__((address_space(1)))
typedef _Float16 h16;
typedef _Float16 f16x8 __attribute__((ext_vector_type(8)));
typedef _Float16 f16x4 __attribute__((ext_vector_type(4)));
typedef _Float16 f16x2 __attribute__((ext_vector_type(2)));
typedef short s16x4 __attribute__((ext_vector_type(4)));
typedef float f32x2 __attribute__((ext_vector_type(2)));
typedef float f32x4 __attribute__((ext_vector_type(4)));
typedef float f32x16 __attribute__((ext_vector_type(16)));
typedef unsigned u32x2 __attribute__((ext_vector_type(2)));
typedef unsigned u32x4 __attribute__((ext_vector_type(4)));
typedef unsigned long long u64;

constexpr int BATCH = 8, SEQ = 4096, DM = 1024, M = BATCH * SEQ;
constexpr int NINP = 3840;
constexpr int NEXP = 32, EFF = 256;
constexpr int MAXROWS = 2 * M + NEXP * 256;
constexpr float EPS = 1e-6f;
constexpr float LOG2E = 1.4426950408889634f;
constexpr float QSCALE = 0.125f * LOG2E;
constexpr float IDX_SCALE = 0.125f * 0.35355339059327373f;
constexpr int NWAVES = 8, NTHR = 512;

constexpr size_t MiB = 1u << 20;
constexpr size_t WS_CTL = 0, CTL_ZERO_BYTES = 64 * 1024;
constexpr size_t WS_MODP = 1 * MiB;
constexpr size_t WS_MOD = 4 * MiB;
constexpr size_t WS_ROUTE = 5 * MiB;
constexpr size_t WS_ROWMAP = 6 * MiB + 512 * 1024;
constexpr size_t WS_WINT = 8 * MiB;
constexpr size_t WS_WOUTT = 16 * MiB;
constexpr size_t WS_WRL = 18 * MiB;
constexpr size_t WS_WGUT = 20 * MiB;
constexpr size_t WS_WDT = 52 * MiB;
constexpr size_t WS_H = 72 * MiB;
constexpr size_t WS_Q = 136 * MiB, WS_K = 168 * MiB, WS_V = 200 * MiB, WS_QI = 232 * MiB;
constexpr size_t WS_KI = 264 * MiB;
constexpr size_t WS_WI = 268 * MiB;
constexpr size_t WS_GB = 270 * MiB, WS_Z = 302 * MiB;
constexpr size_t WS_BM = 334 * MiB;
constexpr size_t WS_MERGED = 350 * MiB;
constexpr size_t WS_HID = 416 * MiB;
constexpr size_t WS_Y = 136 * MiB;
constexpr size_t WS_END = 456 * MiB;
static_assert(WS_Y + (size_t)MAXROWS * 1024 * 2 <= WS_Z + 32 * MiB, "Y overlay");
static_assert(WS_HID + (size_t)MAXROWS * 256 * 2 <= WS_END, "HID");
constexpr int CW_GCNT = 64;
constexpr int CW_BAR = 4096;

constexpr int LDS_BYTES = 147456;
constexpr int RING_BYTES = 131072;
constexpr int MISC_OFF = 147456 - 256;

__device__ const unsigned char T5_BKT[129] = {0, 1, 2, 3, 4, 5, 6, 7, 8, 9, 10, 11, 12, 13, 14, 15, 16, 16, 16, 17, 17, 18, 18, 18, 19, 19, 19, 20, 20, 20, 20, 21, 21, 21, 21, 22, 22, 22, 22, 22, 23, 23, 23, 23, 23, 23, 24, 24, 24, 24, 24, 24, 25, 25, 25, 25, 25, 25, 25, 26, 26, 26, 26, 26, 26, 26, 26, 27, 27, 27, 27, 27, 27, 27, 27, 27, 27, 28, 28, 28, 28, 28, 28, 28, 28, 28, 28, 29, 29, 29, 29, 29, 29, 29, 29, 29, 29, 29, 29, 30, 30, 30, 30, 30, 30, 30, 30, 30, 30, 30, 30, 30, 30, 31, 31, 31, 31, 31, 31, 31, 31, 31, 31, 31, 31, 31, 31, 31, 31};

#define LDS_WAIT() asm volatile("s_waitcnt lgkmcnt(0)" ::: "memory")
#define VM_WAIT() asm volatile("s_waitcnt vmcnt(0)" ::: "memory")
#define RLX_AGENT __ATOMIC_RELAXED, __HIP_MEMORY_SCOPE_AGENT
__device__ __forceinline__ unsigned pk2h(float lo, float hi) { f32x2 v = {lo, hi}; f16x2 h = __builtin_convertvector(v, f16x2); return __builtin_bit_cast(unsigned, h); }
__device__ __forceinline__ u32x4 pk8h(f32x4 a, f32x4 b) { u32x4 w; w.x = pk2h(a[0], a[1]); w.y = pk2h(a[2], a[3]); w.z = pk2h(b[0], b[1]); w.w = pk2h(b[2], b[3]); return w; }
__device__ __forceinline__ float wave_sum(float v) {
#pragma unroll
    for (int o = 1; o < 64; o <<= 1) v += __shfl_xor(v, o);
    return v;
}
__device__ __forceinline__ unsigned dpp_sum_u32(unsigned v) {
    v += (unsigned)__builtin_amdgcn_update_dpp(0, (int)v, 0xB1, 0xf, 0xf, false);
    v += (unsigned)__builtin_amdgcn_update_dpp(0, (int)v, 0x4E, 0xf, 0xf, false);
    v += (unsigned)__builtin_amdgcn_update_dpp(0, (int)v, 0x141, 0xf, 0xf, false);
    v += (unsigned)__builtin_amdgcn_update_dpp(0, (int)v, 0x140, 0xf, 0xf, false);
    return __builtin_amdgcn_readlane(v, 0) + __builtin_amdgcn_readlane(v, 16) + __builtin_amdgcn_readlane(v, 32) + __builtin_amdgcn_readlane(v, 48);
}
__device__ __forceinline__ float dpp_sum_f32(float v) {
    v += __builtin_bit_cast(float, __builtin_amdgcn_update_dpp(0, __builtin_bit_cast(int, v), 0xB1, 0xf, 0xf, false));
    v += __builtin_bit_cast(float, __builtin_amdgcn_update_dpp(0, __builtin_bit_cast(int, v), 0x4E, 0xf, 0xf, false));
    v += __builtin_bit_cast(float, __builtin_amdgcn_update_dpp(0, __builtin_bit_cast(int, v), 0x141, 0xf, 0xf, false));
    v += __builtin_bit_cast(float, __builtin_amdgcn_update_dpp(0, __builtin_bit_cast(int, v), 0x140, 0xf, 0xf, false));
    return __builtin_bit_cast(float, __builtin_amdgcn_readlane(__builtin_bit_cast(int, v), 0)) + __builtin_bit_cast(float, __builtin_amdgcn_readlane(__builtin_bit_cast(int, v), 16)) +
           __builtin_bit_cast(float, __builtin_amdgcn_readlane(__builtin_bit_cast(int, v), 32)) + __builtin_bit_cast(float, __builtin_amdgcn_readlane(__builtin_bit_cast(int, v), 48));
}
__device__ __forceinline__ float dpp_max_f32(float v) {
    v = fmaxf(v, __builtin_bit_cast(float, __builtin_amdgcn_update_dpp(__builtin_bit_cast(int, v), __builtin_bit_cast(int, v), 0xB1, 0xf, 0xf, false)));
    v = fmaxf(v, __builtin_bit_cast(float, __builtin_amdgcn_update_dpp(__builtin_bit_cast(int, v), __builtin_bit_cast(int, v), 0x4E, 0xf, 0xf, false)));
    v = fmaxf(v, __builtin_bit_cast(float, __builtin_amdgcn_update_dpp(__builtin_bit_cast(int, v), __builtin_bit_cast(int, v), 0x141, 0xf, 0xf, false)));
    v = fmaxf(v, __builtin_bit_cast(float, __builtin_amdgcn_update_dpp(__builtin_bit_cast(int, v), __builtin_bit_cast(int, v), 0x140, 0xf, 0xf, false)));
    float a = __builtin_bit_cast(float, __builtin_amdgcn_readlane(__builtin_bit_cast(int, v), 0)), b = __builtin_bit_cast(float, __builtin_amdgcn_readlane(__builtin_bit_cast(int, v), 16));
    float c = __builtin_bit_cast(float, __builtin_amdgcn_readlane(__builtin_bit_cast(int, v), 32)), d = __builtin_bit_cast(float, __builtin_amdgcn_readlane(__builtin_bit_cast(int, v), 48));
    return fmaxf(fmaxf(a, b), fmaxf(c, d));
}
__device__ __forceinline__ float dpp_min_f32(float v) { return -dpp_max_f32(-v); }
__device__ __forceinline__ float silu_f(float v) { return v / (1.f + __expf(-v)); }

namespace pg8 {
#define PG8_LAS __attribute__((address_space(3)))
constexpr int BM = 256, BK = 64, HALF = 128, HTB = HALF * BK * 2, STAGE_BYTES = 8 * HTB, NXCD = 8, WGM = 8;
__host__ __device__ __forceinline__ int lds_byte(int r, int c) { const int st = (r >> 4) * 2 + (c >> 5), rr = r & 15, cc = c & 31, ob = rr * 64 + cc * 2; return st * 1024 + (ob ^ (((ob >> 9) & 1) << 5)); }
__host__ __device__ __forceinline__ void stage_rc(int b, int& R, int& C) { const int st = b / 1024, sb = b % 1024, swz = sb ^ (((sb >> 9) & 1) << 5); R = (st >> 1) * 16 + swz / 64; C = (st & 1) * 32 + (swz % 64) / 2; }
__host__ __device__ __forceinline__ int perm32(int rho) { const int n = rho >> 4, i = rho & 15; return 8 * (i >> 2) + 4 * n + (i & 3); }

struct Unit { int pm, pn, eb; };
struct Gemm { const h16* A; const h16* Bt; int M, N, K; size_t bstride; const int* rowmap; };

struct StaticOrder {
    int nM, nN, nwg, G, c;
    __device__ void init(int M_, int N_, int G_, int c_) { nM = M_ / BM; nN = N_ / BM; nwg = nM * nN; G = G_; c = c_; }
    __device__ bool next(int i, Unit& u) const {
        const long L = (long)i * G + c; if (L >= nwg) return false;
        int wgid = (int)L; { const int q = nwg / NXCD, r = nwg % NXCD, xcd = wgid % NXCD, off = wgid / NXCD; wgid = (xcd < r ? xcd * (q + 1) : r * (q + 1) + (xcd - r) * q) + off; }
        const int nig = WGM * nN, gid = wgid / nig, fm = gid * WGM, gsz = (nM - fm) < WGM ? (nM - fm) : WGM;
        u.pm = fm + ((wgid % nig) % gsz); u.pn = (wgid % nig) / gsz; u.eb = 0; return true;
    }
};
struct GroupedOrder {
    const int* tile_e; int ntiles, nN, G, v;
    __device__ bool next(int i, Unit& u) const {
        const long L = (long)i * G + v; if (L >= (long)ntiles * nN) return false;
        u.pm = (int)(L / nN); u.pn = (int)(L % nN); u.eb = tile_e[u.pm]; return true;
    }
};

template <class Epi, class Sched, bool GATHER>
__device__ __forceinline__ void gemm_phase(PG8_LAS unsigned char* lds, const Gemm g, const Sched& S, const Epi& E) {
    const int tid = threadIdx.x, wid = __builtin_amdgcn_readfirstlane(tid >> 6), lane = tid & 63, wr = wid >> 2, wc = wid & 3, fr = lane & 15, fq = lane >> 4;
    int K_ = g.K; asm volatile("" : "+s"(K_));
    const int K = K_, nt = K / BK;
    unsigned voffB[2]; unsigned cC[2]; int cR[2];
    unsigned vA0[2], vA1[2];
#pragma unroll
    for (int i = 0; i < 2; ++i) { int R, C; stage_rc(tid * 16 + i * 8192, R, C); const int Rb = Epi::PERM ? ((R & ~31) + perm32(R & 31)) : R;
        cR[i] = R; cC[i] = (unsigned)C * 2u; voffB[i] = (unsigned)(Rb * K + C) * 2u; vA0[i] = (unsigned)(R * K + C) * 2u; vA1[i] = vA0[i]; }
    const size_t kstep = (size_t)(BK * 2);
    const size_t hstep = (size_t)HALF * K * 2;
    const size_t tstep = 2 * hstep;
    const unsigned ldsw = (unsigned)wid * 1024u;
    const int aoff = lds_byte(wr * 64 + fr, fq * 8), boff = lds_byte(wc * 32 + fr, fq * 8);
#define PG8_SA(b, h) (((b) * 2 + (h)) * HTB)
#define PG8_SB(b, h) ((4 + (b) * 2 + (h)) * HTB)
#define PG8_STAGE(bufoff, gbase, voff) do { _Pragma("unroll") for (int _i = 0; _i < 2; ++_i) \
        __builtin_amdgcn_global_load_lds((const unsigned*)((const char*)(gbase) + (voff)[_i]), (PG8_LAS unsigned*)(lds + (bufoff) + ldsw + _i * 8192), 16, 0, 0); } while (0)
#define PG8_LDA(dst, b, h) do { _Pragma("unroll") for (int m = 0; m < 4; ++m) _Pragma("unroll") for (int k = 0; k < 2; ++k) dst[m][k] = *(const PG8_LAS f16x8*)(lds + PG8_SA(b, h) + aoff + m * 2048 + k * 1024); } while (0)
#define PG8_LDB(dst, b, h) do { _Pragma("unroll") for (int n = 0; n < 2; ++n) _Pragma("unroll") for (int k = 0; k < 2; ++k) dst[n][k] = *(const PG8_LAS f16x8*)(lds + PG8_SB(b, h) + boff + n * 2048 + k * 1024); } while (0)
#define PG8_MMA(ai, bj, At, Bt) do { __builtin_amdgcn_s_setprio(1); _Pragma("unroll") for (int m = 0; m < 4; ++m) _Pragma("unroll") for (int n = 0; n < 2; ++n) _Pragma("unroll") for (int k = 0; k < 2; ++k) \
        acc[ai][bj][m][n] = __builtin_amdgcn_mfma_f32_16x16x32_f16(Bt[n][k], At[m][k], acc[ai][bj][m][n], 0, 0, 0); __builtin_amdgcn_s_setprio(0); } while (0)
#define PG8_WAIT_V(n) asm volatile("s_waitcnt vmcnt(" #n ")" ::: "memory")
#define PG8_WAIT_L(n) asm volatile("s_waitcnt lgkmcnt(" #n ")" ::: "memory")
#define PG8_BAR __builtin_amdgcn_s_barrier()
#define PG8_SCHED __builtin_amdgcn_sched_barrier(0)
#define PG8_ABASE(u_) (GATHER ? (const char*)g.A : (const char*)g.A + (size_t)(u_).pm * tstep)
#define PG8_AH1 (GATHER ? (size_t)0 : hstep)
#define PG8_GATHER_OFF(u_, d0, d1) do { if (GATHER) { _Pragma("unroll") for (int _i = 0; _i < 2; ++_i) { \
        int r0_ = g.rowmap[(u_).pm * BM + cR[_i]], r1_ = g.rowmap[(u_).pm * BM + HALF + cR[_i]]; r0_ = r0_ < 0 ? 0 : r0_; r1_ = r1_ < 0 ? 0 : r1_; \
        d0[_i] = (unsigned)r0_ * (unsigned)(K * 2) + cC[_i]; d1[_i] = (unsigned)r1_ * (unsigned)(K * 2) + cC[_i]; } } } while (0)
    Unit cur, nxt; int ui = 0;
    if (!S.next(0, cur)) return;
    f32x4 acc[2][2][4][2];
#pragma unroll
    for (int a = 0; a < 2; ++a)
#pragma unroll
        for (int b = 0; b < 2; ++b)
#pragma unroll
            for (int m = 0; m < 4; ++m)
#pragma unroll
                for (int n = 0; n < 2; ++n) acc[a][b][m][n] = (f32x4){0.f, 0.f, 0.f, 0.f};
    f16x8 At[4][2], B0[2][2], B1[2][2];
    PG8_GATHER_OFF(cur, vA0, vA1);
    const char* cA = PG8_ABASE(cur); const char* cB = (const char*)g.Bt + (size_t)cur.eb * g.bstride + (size_t)cur.pn * tstep;
    PG8_STAGE(PG8_SB(0, 0), cB, voffB); PG8_STAGE(PG8_SB(0, 1), cB + hstep, voffB); PG8_STAGE(PG8_SA(0, 0), cA, vA0); PG8_STAGE(PG8_SA(0, 1), cA + PG8_AH1, vA1);
    if (wr == 1) PG8_BAR;
    PG8_WAIT_V(2); PG8_BAR;
    PG8_STAGE(PG8_SB(1, 0), cB + kstep, voffB); PG8_STAGE(PG8_SA(1, 0), cA + kstep, vA0); PG8_STAGE(PG8_SB(1, 1), cB + hstep + kstep, voffB);
    PG8_WAIT_V(6); PG8_BAR;
    for (;;) {
        const bool has_next = S.next(ui + 1, nxt);
        unsigned nA0[2] = {vA0[0], vA0[1]}, nA1[2] = {vA1[0], vA1[1]};
        if (has_next) PG8_GATHER_OFF(nxt, nA0, nA1);
        const char* nA = has_next ? PG8_ABASE(nxt) : cA; const char* nB = has_next ? (const char*)g.Bt + (size_t)nxt.eb * g.bstride + (size_t)nxt.pn * tstep : cB;
        for (int t = 0; t < nt; t += 2) {
            const bool last = (t == nt - 2);
            const char* a1 = cA + (size_t)(t + 1) * kstep;
            const char* a2 = last ? nA : cA + (size_t)(t + 2) * kstep; const char* b2 = last ? nB : cB + (size_t)(t + 2) * kstep;
            const char* a3 = a2 + kstep; const char* b3 = b2 + kstep;
            unsigned w0[2], w1[2];
#pragma unroll
            for (int i = 0; i < 2; ++i) { w0[i] = last ? nA0[i] : vA0[i]; w1[i] = last ? nA1[i] : vA1[i]; }
            PG8_LDB(B0, 0, 0); PG8_LDB(B1, 0, 1); PG8_SCHED; PG8_LDA(At, 0, 0); PG8_STAGE(PG8_SA(1, 1), a1 + PG8_AH1, vA1);
            PG8_WAIT_V(8); PG8_WAIT_L(0); PG8_BAR; PG8_MMA(0, 0, At, B0); PG8_MMA(0, 1, At, B1); PG8_BAR; PG8_SCHED;
            PG8_LDA(At, 0, 1); PG8_STAGE(PG8_SB(0, 0), b2, voffB); PG8_STAGE(PG8_SB(0, 1), b2 + hstep, voffB); PG8_STAGE(PG8_SA(0, 0), a2, w0);
            PG8_WAIT_V(8); PG8_WAIT_L(0); PG8_BAR; PG8_MMA(1, 0, At, B0); PG8_MMA(1, 1, At, B1); PG8_BAR; PG8_SCHED;
            PG8_LDB(B0, 1, 0); PG8_LDB(B1, 1, 1); PG8_SCHED; PG8_LDA(At, 1, 0); PG8_STAGE(PG8_SA(0, 1), a2 + PG8_AH1, w1);
            PG8_WAIT_V(8); PG8_WAIT_L(0); PG8_BAR; PG8_MMA(0, 0, At, B0); PG8_MMA(0, 1, At, B1); PG8_BAR; PG8_SCHED;
            PG8_LDA(At, 1, 1); PG8_STAGE(PG8_SB(1, 0), b3, voffB); PG8_STAGE(PG8_SB(1, 1), b3 + hstep, voffB); PG8_STAGE(PG8_SA(1, 0), a3, w0);
            PG8_WAIT_V(8); PG8_WAIT_L(0); PG8_BAR; PG8_MMA(1, 0, At, B0); PG8_MMA(1, 1, At, B1); PG8_BAR; PG8_SCHED;
        }
        if (wr == 0) PG8_BAR;
        E(acc, cur, wr, wc, fr, fq);
        if (!has_next) break;
#pragma unroll
        for (int a = 0; a < 2; ++a)
#pragma unroll
            for (int b = 0; b < 2; ++b)
#pragma unroll
                for (int m = 0; m < 4; ++m)
#pragma unroll
                    for (int n = 0; n < 2; ++n) acc[a][b][m][n] = (f32x4){0.f, 0.f, 0.f, 0.f};
        cur = nxt; cA = nA; cB = nB; ++ui;
#pragma unroll
        for (int i = 0; i < 2; ++i) { vA0[i] = nA0[i]; vA1[i] = nA1[i]; }
        if (wr == 1) PG8_BAR;
    }
    PG8_WAIT_V(0);
    PG8_BAR;
#undef PG8_SA
#undef PG8_SB
#undef PG8_STAGE
#undef PG8_LDA
#undef PG8_LDB
#undef PG8_MMA
#undef PG8_WAIT_V
#undef PG8_WAIT_L
#undef PG8_BAR
#undef PG8_SCHED
#undef PG8_ABASE
#undef PG8_AH1
#undef PG8_GATHER_OFF
}
}

struct EpiInProj {
    static constexpr bool PERM = true;
    h16 *Q, *K, *V, *QI, *KI, *GB, *Z; float* WI; const float *qn, *kn;
    __device__ __forceinline__ void operator()(const f32x4 (&acc)[2][2][4][2], const pg8::Unit& u, int wr, int wc, int fr, int fq) const {
        const int row0 = u.pm * 256 + wr * 64 + fr; const int pn = u.pn;
        if (pn < 4) {
            const bool isq = pn < 2; const float* g = isq ? qn : kn; h16* O = isq ? Q : K; const int head = 4 * (pn & 1) + wc; const float sc = isq ? QSCALE : 1.f;
            f32x4 gv[2][2];
#pragma unroll
            for (int bj = 0; bj < 2; ++bj)
#pragma unroll
                for (int n = 0; n < 2; ++n) gv[bj][n] = *(const f32x4*)(g + 32 * bj + 8 * fq + 4 * n) * sc;
#pragma unroll
            for (int ai = 0; ai < 2; ++ai)
#pragma unroll
                for (int m = 0; m < 4; ++m) {
                    float ss = 0.f;
#pragma unroll
                    for (int bj = 0; bj < 2; ++bj)
#pragma unroll
                        for (int n = 0; n < 2; ++n) { const f32x4 v = acc[ai][bj][m][n]; ss += (v[0] * v[0] + v[1] * v[1]) + (v[2] * v[2] + v[3] * v[3]); }
                    ss += __shfl_xor(ss, 16); ss += __shfl_xor(ss, 32);
                    const float rstd = rsqrtf(ss * (1.f / 64.f) + EPS);
                    const int R = row0 + ai * 128 + m * 16;
                    if (isq) { h16* rowp = O + (size_t)R * 512 + head * 64 + 8 * fq;
#pragma unroll
                        for (int bj = 0; bj < 2; ++bj) *(u32x4*)(rowp + 32 * bj) = pk8h(acc[ai][bj][m][0] * rstd * gv[bj][0], acc[ai][bj][m][1] * rstd * gv[bj][1]); }
                    else {
                        h16* tp = O + ((size_t)((R >> 12) * 8 + head) * 64 + ((R & 4095) >> 6)) * 4096 + (R & 63) * 8;
#pragma unroll
                        for (int bj = 0; bj < 2; ++bj) *(u32x4*)(tp + (4 * bj + fq) * 512) = pk8h(acc[ai][bj][m][0] * rstd * gv[bj][0], acc[ai][bj][m][1] * rstd * gv[bj][1]); }
                }
        } else if (pn < 8) {
            h16* O = pn < 6 ? V : QI; const int head = 4 * (pn & 1) + wc;
#pragma unroll
            for (int ai = 0; ai < 2; ++ai)
#pragma unroll
                for (int m = 0; m < 4; ++m) { const int R = row0 + ai * 128 + m * 16;
                    if (pn >= 6) { h16* rowp = O + (size_t)R * 512 + head * 64 + 8 * fq;
#pragma unroll
                        for (int bj = 0; bj < 2; ++bj) *(u32x4*)(rowp + 32 * bj) = pk8h(acc[ai][bj][m][0], acc[ai][bj][m][1]); }
                    else {
                        const int kv = R & 63; h16* tp = O + ((size_t)((R >> 12) * 8 + head) * 64 + ((R & 4095) >> 6)) * 4096 + ((kv >> 4) * 64 + (kv & 15) * 4 + fq) * 8;
#pragma unroll
                        for (int bj = 0; bj < 2; ++bj) *(u32x4*)(tp + bj * 2048) = pk8h(acc[ai][bj][m][0], acc[ai][bj][m][1]); } }
        } else if (pn == 8) {
#pragma unroll
            for (int ai = 0; ai < 2; ++ai)
#pragma unroll
                for (int m = 0; m < 4; ++m) { const size_t row = (size_t)(row0 + ai * 128 + m * 16);
                    if (wc < 2) { const int R = (int)row, c8 = 4 * wc + fq;
                        *(u32x4*)(KI + ((((size_t)(R >> 12) * 128 + ((R & 4095) >> 5)) * 4 + (c8 >> 1)) * 64 + (R & 31) + 32 * (c8 & 1)) * 8) = pk8h(acc[ai][0][m][0], acc[ai][0][m][1]); }
                    else if (wc == 2 && fq == 0) { *(f32x4*)(WI + row * 8) = acc[ai][0][m][0]; *(f32x4*)(WI + row * 8 + 4) = acc[ai][0][m][1]; } }
        } else if (pn < 11) {
            const int colb = 256 * (pn - 9) + 32 * wc + 8 * fq;
#pragma unroll
            for (int ai = 0; ai < 2; ++ai)
#pragma unroll
                for (int m = 0; m < 4; ++m) { h16* rowp = GB + (size_t)(row0 + ai * 128 + m * 16) * 512 + colb;
#pragma unroll
                    for (int bj = 0; bj < 2; ++bj) *(u32x4*)(rowp + 128 * bj) = pk8h(acc[ai][bj][m][0], acc[ai][bj][m][1]); }
        } else {
            const int ch = 128 * (pn - 11) + 32 * wc + 8 * fq;
#pragma unroll
            for (int ai = 0; ai < 2; ++ai)
#pragma unroll
                for (int m = 0; m < 4; ++m) *(u32x4*)(Z + (size_t)(row0 + ai * 128 + m * 16) * 512 + ch) = pk8h(acc[ai][0][m][0] * acc[ai][1][m][0], acc[ai][0][m][1] * acc[ai][1][m][1]);
        }
    }
};
struct EpiOutProj {
    static constexpr bool PERM = false;
    const float* x; float* out; const float* mod;
    __device__ __forceinline__ void operator()(const f32x4 (&acc)[2][2][4][2], const pg8::Unit& u, int wr, int wc, int fr, int fq) const {
        const int row0 = u.pm * 256 + wr * 64 + fr; const int b = (u.pm * 256) >> 12; const int col0 = u.pn * 256 + wc * 32 + 4 * fq;
        f32x4 gv[2][2];
#pragma unroll
        for (int bj = 0; bj < 2; ++bj)
#pragma unroll
            for (int n = 0; n < 2; ++n) gv[bj][n] = *(const f32x4*)(mod + (size_t)b * 6144 + 2048 + col0 + bj * 128 + n * 16);
#pragma unroll
        for (int ai = 0; ai < 2; ++ai)
#pragma unroll
            for (int m = 0; m < 4; ++m) { const size_t off = (size_t)(row0 + ai * 128 + m * 16) * 1024 + col0;
#pragma unroll
                for (int bj = 0; bj < 2; ++bj)
#pragma unroll
                    for (int n = 0; n < 2; ++n) { const f32x4 xv = *(const f32x4*)(x + off + bj * 128 + n * 16); *(f32x4*)(out + off + bj * 128 + n * 16) = xv + gv[bj][n] * acc[ai][bj][m][n]; } }
    }
};
struct EpiMoeUp {
    static constexpr bool PERM = true;
    h16* HID;
    __device__ __forceinline__ void operator()(const f32x4 (&acc)[2][2][4][2], const pg8::Unit& u, int wr, int wc, int fr, int fq) const {
        const int row0 = u.pm * 256 + wr * 64 + fr; const int f0 = 128 * u.pn + 32 * wc + 8 * fq;
#pragma unroll
        for (int ai = 0; ai < 2; ++ai)
#pragma unroll
            for (int m = 0; m < 4; ++m) { f32x4 hv[2];
#pragma unroll
                for (int n = 0; n < 2; ++n) { const f32x4 a = acc[ai][0][m][n], bb = acc[ai][1][m][n];
#pragma unroll
                    for (int i = 0; i < 4; ++i) hv[n][i] = silu_f(a[i]) * bb[i]; }
                *(u32x4*)(HID + (size_t)(row0 + ai * 128 + m * 16) * 256 + f0) = pk8h(hv[0], hv[1]); }
    }
};
struct EpiMoeDown {
    static constexpr bool PERM = true;
    h16* Y;
    __device__ __forceinline__ void operator()(const f32x4 (&acc)[2][2][4][2], const pg8::Unit& u, int wr, int wc, int fr, int fq) const {
        const int row0 = u.pm * 256 + wr * 64 + fr; const int c0 = 256 * u.pn + 32 * wc + 8 * fq;
#pragma unroll
        for (int ai = 0; ai < 2; ++ai)
#pragma unroll
            for (int m = 0; m < 4; ++m) { h16* rowp = Y + (size_t)(row0 + ai * 128 + m * 16) * 1024 + c0;
#pragma unroll
                for (int bj = 0; bj < 2; ++bj) *(u32x4*)(rowp + 128 * bj) = pk8h(acc[ai][bj][m][0], acc[ai][bj][m][1]); }
    }
};

struct Args { const float* in[21]; float* out; unsigned char* ws; int ph_lo, ph_hi; };
struct Frame {
    LAS unsigned char* lds; unsigned char* ldsg;
    int tid, lane, wave, vcu, G;
    const float* const __attribute__((address_space(4)))* in; float* out; unsigned char* ws;
};

#define XB_TMO      128
#define XB_XCNT(j)  (256  + 64 * (j))
#define XB_XSUB(j)  (1280 + 64 * (j))
#define XB_XGEN(j)  (2304 + 64 * (j))
#define XB_TOP      3328
#define XB_TOPGEN   3392
#define XCD_BAR_WORDS 3456
#define XB_SPIN_CAP (1u << 20)
__device__ __forceinline__ unsigned xb_ld(unsigned* p)              { return __hip_atomic_load(p, __ATOMIC_RELAXED, __HIP_MEMORY_SCOPE_AGENT); }
__device__ __forceinline__ unsigned xb_add(unsigned* p, unsigned v) { return __hip_atomic_fetch_add(p, v, __ATOMIC_RELAXED, __HIP_MEMORY_SCOPE_AGENT); }
__device__ __forceinline__ unsigned xb_xcc_id() { return (unsigned)__builtin_amdgcn_s_getreg((3 << 11) | 20) & 0xFu; }
#define XB_SPIN(cond, bar) do { unsigned _sp = 0; while (cond) { __builtin_amdgcn_s_sleep(1); \
    if ((++_sp & 255u) == 0u) { if (xb_ld(&(bar)[XB_TMO])) break; if (_sp > XB_SPIN_CAP) { atomicAdd(&(bar)[XB_TMO], 1u); break; } } } } while (0)
struct XcdBarrier { unsigned* bar; unsigned x; volatile LAS unsigned* st; };
__device__ __forceinline__ XcdBarrier xcd_barrier_post(unsigned* bar, volatile LAS unsigned* st) {
    XcdBarrier b; b.bar = bar; b.x = xb_xcc_id(); b.st = st;
    if (threadIdx.x == 0) (void)xb_add(&bar[XB_XCNT(b.x)], 1u);
    return b;
}
__device__ __forceinline__ void xcd_barrier_complete(unsigned* bar, unsigned x, unsigned& nloc, unsigned& nx) {
    const unsigned G = gridDim.x * gridDim.y * gridDim.z;
    unsigned sum, cnt, mine, sp = 0u;
    for (;;) {
        sum = 0u; cnt = 0u; mine = 0u;
#pragma unroll
        for (unsigned j = 0; j < 16; ++j) { const unsigned c = xb_ld(&bar[XB_XCNT(j)]); sum += c; cnt += (c > 0u) ? 1u : 0u; mine = (j == x) ? c : mine; }
        if (sum == G) break;
        __builtin_amdgcn_s_sleep(1);
        if ((++sp & 255u) == 0u) { if (xb_ld(&bar[XB_TMO])) break; if (sp > XB_SPIN_CAP) { atomicAdd(&bar[XB_TMO], 1u); break; } }
    }
    nloc = mine > 0u ? mine : 1u; nx = cnt > 0u ? cnt : 1u;
}
__device__ __forceinline__ void xcd_barrier(const XcdBarrier& b) {
    asm volatile("s_waitcnt vmcnt(0)" ::: "memory");
    __syncthreads();
    if (threadIdx.x == 0) {
        unsigned* bar = b.bar;
        __builtin_amdgcn_s_waitcnt(0);
        unsigned nloc = b.st[0], nx = b.st[1];
        if (nloc == 0u) { xcd_barrier_complete(bar, b.x, nloc, nx); b.st[0] = nloc; b.st[1] = nx; }
        const unsigned old = xb_add(&bar[XB_XSUB(b.x)], 1u);
        const unsigned gen = old / nloc;
        if (old + 1u == (gen + 1u) * nloc) {
            __builtin_amdgcn_fence(__ATOMIC_RELEASE, "agent");
            asm volatile("s_waitcnt vmcnt(0)" ::: "memory");
            const unsigned og = xb_add(&bar[XB_TOP], 1u);
            const unsigned tg = og / nx;
            if (og + 1u == (tg + 1u) * nx) xb_add(&bar[XB_TOPGEN], 1u);
            else XB_SPIN(xb_ld(&bar[XB_TOPGEN]) == tg, bar);
            __builtin_amdgcn_fence(__ATOMIC_ACQUIRE, "agent");
            xb_add(&bar[XB_XGEN(b.x)], 1u);
            asm volatile("s_waitcnt vmcnt(0)" ::: "memory");
        } else {
            XB_SPIN(xb_ld(&bar[XB_XGEN(b.x)]) == gen, bar);
            __builtin_amdgcn_fence(__ATOMIC_ACQUIRE, "agent");
            asm volatile("s_waitcnt vmcnt(0)" ::: "memory");
        }
    }
    __syncthreads();
}

__device__ __forceinline__ void transpose_item(const float* src, int ldw, int nvalid, int k0, h16* dst, int K, LAS float* scr, int lane) {
    const int c4 = lane & 7, rsub = lane >> 3;
    f32x4 v[8];
#pragma unroll
    for (int i = 0; i < 8; ++i) v[i] = (4 * c4 < nvalid) ? *(const f32x4*)(src + (size_t)(k0 + 8 * i + rsub) * ldw + 4 * c4) : (f32x4){0.f, 0.f, 0.f, 0.f};
#pragma unroll
    for (int i = 0; i < 8; ++i) { LAS float* p = scr + (8 * i + rsub) * 33 + 4 * c4; p[0] = v[i][0]; p[1] = v[i][1]; p[2] = v[i][2]; p[3] = v[i][3]; }
    LDS_WAIT(); asm volatile("" ::: "memory");
    const int c = lane & 7;
#pragma unroll
    for (int j = 0; j < 4; ++j) { const int nn = (lane >> 3) + 8 * j; const LAS float* s = scr + (8 * c) * 33 + nn;
        u32x4 o; o.x = pk2h(s[0 * 33], s[1 * 33]); o.y = pk2h(s[2 * 33], s[3 * 33]); o.z = pk2h(s[4 * 33], s[5 * 33]); o.w = pk2h(s[6 * 33], s[7 * 33]);
        *(u32x4*)(dst + (size_t)nn * K + k0 + 8 * c) = o; }
    LDS_WAIT(); asm volatile("" ::: "memory");
}
__device__ __forceinline__ int win_group_src(int g, int& nvalid) {
    const int tile = g >> 3, p = (g & 7) * 32, bj = p >> 7, wc = (p >> 5) & 3; nvalid = 32;
    if (tile < 8) { const int seg = tile >> 1; return seg * 512 + 64 * (4 * (tile & 1) + wc) + 32 * bj; }
    if (tile == 8) { if (p < 64) return 2048 + p; if (p == 64) { nvalid = 8; return 2112; } nvalid = 0; return 0; }
    if (tile < 11) return 2120 + 256 * (tile - 9) + p;
    return (bj == 0 ? 2632 : 3144) + 128 * (tile - 11) + 32 * wc;
}
__device__ __forceinline__ void p0_prologue(Frame& F) {
    LAS float* scr = (LAS float*)(F.lds + F.wave * 16384);
    const int gw = F.vcu * NWAVES + F.wave, NGW = F.G * NWAVES;
    const float* w_in = F.in[6]; const float* w_out = F.in[12]; const float* w_gate = F.in[18]; const float* w_up = F.in[19]; const float* w_down = F.in[20];
    h16* WINT = (h16*)(F.ws + WS_WINT); h16* WOUTT = (h16*)(F.ws + WS_WOUTT); h16* WGUT = (h16*)(F.ws + WS_WGUT); h16* WDT = (h16*)(F.ws + WS_WDT);
    constexpr int I_IN = 120 * 16, I_OUT = 32 * 16, I_GU = 32 * 16 * 16, I_D = 32 * 32 * 4, I_MOD = 96 * 16;
    constexpr int NITEMS = I_IN + I_OUT + I_GU + I_D + I_MOD;
    for (int it = gw; it < NITEMS; it += NGW) {
        int r = it;
        if (r < I_MOD) {
            const int cc = r % 96, ks = r / 96; const int col = cc * 64 + F.lane, k0 = ks * 64;
            const float* c = F.in[1]; const float* w_ada = F.in[3];
            float ca[8];
#pragma unroll
            for (int b = 0; b < 8; ++b) ca[b] = silu_f(c[b * 1024 + k0 + F.lane]);
            float a[8] = {0.f, 0.f, 0.f, 0.f, 0.f, 0.f, 0.f, 0.f};
#pragma unroll 8
            for (int kk = 0; kk < 64; ++kk) { const float w = w_ada[(size_t)(k0 + kk) * 6144 + col];
#pragma unroll
                for (int b = 0; b < 8; ++b) a[b] += __builtin_bit_cast(float, __builtin_amdgcn_readlane(__builtin_bit_cast(int, ca[b]), kk)) * w; }
            float* mp = (float*)(F.ws + WS_MODP) + (size_t)ks * 8 * 6144;
#pragma unroll
            for (int b = 0; b < 8; ++b) mp[b * 6144 + col] = a[b];
            continue;
        }
        r -= I_MOD;
        if (r < I_IN) { const int g = r >> 4, kb = r & 15; int nv; const int s0 = win_group_src(g, nv); transpose_item(w_in + s0, 3656, nv, kb * 64, WINT + (size_t)g * 32 * 1024, 1024, scr, F.lane); continue; } r -= I_IN;
        if (r < I_OUT) { const int g = r >> 4, kb = r & 15; transpose_item(w_out + g * 32, 1024, 32, kb * 64, WOUTT + (size_t)g * 32 * 1024, 1024, scr, F.lane); continue; } r -= I_OUT;
        if (r < I_GU) { const int e = r >> 8, g = (r >> 4) & 15, kb = r & 15; const int p = g * 32, t2 = p >> 8, bj = (p >> 7) & 1, wc = (p >> 5) & 3; const int f = 128 * t2 + 32 * wc;
            transpose_item((bj == 0 ? w_gate : w_up) + (size_t)e * 1024 * 256 + f, 256, 32, kb * 64, WGUT + ((size_t)e * 512 + p) * 1024, 1024, scr, F.lane); continue; } r -= I_GU;
        { const int e = r >> 7, g = (r >> 2) & 31, kb = r & 3; transpose_item(w_down + (size_t)e * 256 * 1024 + g * 32, 1024, 32, kb * 64, WDT + ((size_t)e * 1024 + g * 32) * 256, 256, scr, F.lane); }
    }
    { const float* wgr = F.in[14]; const float* wer = F.in[16]; h16* WRL = (h16*)(F.ws + WS_WRL);
      for (int idx = F.vcu * NTHR + F.tid; idx < 36 * 1024; idx += F.G * NTHR) { const int o = idx >> 10, rem = idx & 1023, ln = rem >> 4, ji = rem & 15, col = 4 * ln + 256 * (ji >> 2) + (ji & 3);
          WRL[idx] = (h16)(o < 4 ? wgr[col * 4 + o] : wer[col * 32 + (o - 4)]); } }
}

__device__ __forceinline__ void p1_norm1(Frame& F) {
    const float* modp = (const float*)(F.ws + WS_MODP); float* mod = (float*)(F.ws + WS_MOD); const float* b_ada = F.in[4];
    LAS float* sh = (LAS float*)F.lds; LAS float* sc = sh + 1024;
    const int b = F.vcu >> 5;
    for (int i = F.tid; i < 2048; i += NTHR) { float s = b_ada[i];
#pragma unroll
        for (int ks = 0; ks < 16; ++ks) s += modp[((size_t)ks * 8 + b) * 6144 + i];
        sh[i] = s; }
    if (F.tid < 192) { const int idx = F.vcu * 192 + F.tid; const int bb = idx / 6144, cc = idx % 6144; float s = b_ada[cc];
#pragma unroll
        for (int ks = 0; ks < 16; ++ks) s += modp[((size_t)ks * 8 + bb) * 6144 + cc];
        mod[idx] = s; }
    __syncthreads();
    const float* x = F.in[0]; const float* g1 = F.in[5]; h16* H = (h16*)(F.ws + WS_H);
    f32x4 gg[4], s1[4], h1[4];
#pragma unroll
    for (int j = 0; j < 4; ++j) { const int col = 4 * F.lane + 256 * j; gg[j] = *(const f32x4*)(g1 + col); h1[j] = *(const LAS f32x4*)(sh + col); s1[j] = *(const LAS f32x4*)(sc + col);
        gg[j] = gg[j] * (s1[j] + 1.f); }
    f32x4 vn[4];
    { const size_t row = (size_t)F.vcu * 128 + F.wave * 16;
#pragma unroll
      for (int j = 0; j < 4; ++j) vn[j] = *(const f32x4*)(x + row * 1024 + 4 * F.lane + 256 * j); }
    for (int rr = 0; rr < 16; ++rr) {
        const size_t row = (size_t)F.vcu * 128 + F.wave * 16 + rr; const size_t rown = row + (rr < 15 ? 1 : 0);
        f32x4 v[4]; float ss = 0.f;
#pragma unroll
        for (int j = 0; j < 4; ++j) { v[j] = vn[j]; vn[j] = *(const f32x4*)(x + rown * 1024 + 4 * F.lane + 256 * j); ss += (v[j][0] * v[j][0] + v[j][1] * v[j][1]) + (v[j][2] * v[j][2] + v[j][3] * v[j][3]); }
        const float rstd = rsqrtf(dpp_sum_f32(ss) * (1.f / 1024.f) + EPS);
#pragma unroll
        for (int j = 0; j < 4; ++j) { const f32x4 o = v[j] * rstd * gg[j] + h1[j]; u32x2 w; w.x = pk2h(o[0], o[1]); w.y = pk2h(o[2], o[3]); *(u32x2*)(H + row * 1024 + 4 * F.lane + 256 * j) = w; }
    }
}

__device__ __forceinline__ void p3_conv(Frame& F) {
    const h16* Z = (const h16*)(F.ws + WS_Z); const h16* GB = (const h16*)(F.ws + WS_GB); h16* MG = (h16*)(F.ws + WS_MERGED);
    const float* cw = F.in[9]; const float* cn = F.in[11];
    const int gw = F.vcu * NWAVES + F.wave, NGW = F.G * NWAVES; const int ch = 8 * F.lane;
    float w0[8], w1[8], w2[8], gn[8];
#pragma unroll
    for (int i = 0; i < 8; ++i) { w0[i] = cw[ch + i]; w1[i] = cw[512 + ch + i]; w2[i] = cw[1024 + ch + i]; gn[i] = cn[ch + i]; }
    for (int it = gw; it < M / 32; it += NGW) {
        const int t0 = it * 32; const bool first = (t0 & (SEQ - 1)) == 0;
        f16x8 zm2 = {}, zm1 = {};
        if (!first) { zm2 = *(const f16x8*)(Z + (size_t)(t0 - 2) * 512 + ch); zm1 = *(const f16x8*)(Z + (size_t)(t0 - 1) * 512 + ch); }
        for (int tt = 0; tt < 32; ++tt) {
            const size_t t = (size_t)t0 + tt;
            const f16x8 z0 = *(const f16x8*)(Z + t * 512 + ch); const f16x8 gb = *(const f16x8*)(GB + t * 512 + ch);
            float y[8]; float ss = 0.f;
#pragma unroll
            for (int i = 0; i < 8; ++i) { y[i] = (float)gb[i] * (w0[i] * (float)zm2[i] + w1[i] * (float)zm1[i] + w2[i] * (float)z0[i]); ss += y[i] * y[i]; }
            ss += __shfl_xor(ss, 1); ss += __shfl_xor(ss, 2); ss += __shfl_xor(ss, 4);
            const float rstd = rsqrtf(ss * (1.f / 64.f) + EPS);
            u32x4 o; o.x = pk2h(y[0] * rstd * gn[0], y[1] * rstd * gn[1]); o.y = pk2h(y[2] * rstd * gn[2], y[3] * rstd * gn[3]); o.z = pk2h(y[4] * rstd * gn[4], y[5] * rstd * gn[5]); o.w = pk2h(y[6] * rstd * gn[6], y[7] * rstd * gn[7]);
            *(u32x4*)(MG + t * 1024 + 512 + ch) = o;
            zm2 = zm1; zm1 = z0;
        }
    }
}

constexpr int IX_ROW = 4352, IX_NEG = 8 * IX_ROW * 4, IX_BM = IX_NEG + 256, IX_ST = IX_BM + 4096;
__device__ __forceinline__ unsigned fkey(float f) { const unsigned u = __builtin_bit_cast(unsigned, f); return u ^ ((u >> 31) ? 0xFFFFFFFFu : 0x80000000u); }
__device__ __forceinline__ float fkey_inv(unsigned k) { const unsigned u = (k >> 31) ? (k ^ 0x80000000u) : ~k; return __builtin_bit_cast(float, u); }
__device__ __forceinline__ float probit_lo(float p) {
    if (p < 0.02425f) { const float q = sqrtf(-2.f * __logf(p));
        return (((((-7.784894002430293e-03f * q - 3.223964580411365e-01f) * q - 2.400758277161838e+00f) * q - 2.549732539343734e+00f) * q + 4.374664141464968e+00f) * q + 2.938163982698783e+00f) /
               ((((7.784695709041462e-03f * q + 3.224671290700398e-01f) * q + 2.445134137142996e+00f) * q + 3.754408661907416e+00f) * q + 1.f); }
    const float q = p - 0.5f, r = q * q;
    return (((((-3.969683028665376e+01f * r + 2.209460984245205e+02f) * r - 2.759285104469687e+02f) * r + 1.383577518672690e+02f) * r - 3.066479806614716e+01f) * r + 2.506628277459239e+00f) * q /
           (((((-5.447609879822406e+01f * r + 1.615858368580409e+02f) * r - 1.556989798598866e+02f) * r + 6.680131188771972e+01f) * r - 1.328068155288572e+01f) * r + 1.f);
}
__device__ __forceinline__ void row_sum2(float v, float& h0, float& h1) {
    v += __builtin_bit_cast(float, __builtin_amdgcn_update_dpp(0, __builtin_bit_cast(int, v), 0xB1, 0xf, 0xf, false));
    v += __builtin_bit_cast(float, __builtin_amdgcn_update_dpp(0, __builtin_bit_cast(int, v), 0x4E, 0xf, 0xf, false));
    v += __builtin_bit_cast(float, __builtin_amdgcn_update_dpp(0, __builtin_bit_cast(int, v), 0x141, 0xf, 0xf, false));
    v += __builtin_bit_cast(float, __builtin_amdgcn_update_dpp(0, __builtin_bit_cast(int, v), 0x140, 0xf, 0xf, false));
    h0 = __builtin_bit_cast(float, __builtin_amdgcn_readlane(__builtin_bit_cast(int, v), 0)) + __builtin_bit_cast(float, __builtin_amdgcn_readlane(__builtin_bit_cast(int, v), 16));
    h1 = __builtin_bit_cast(float, __builtin_amdgcn_readlane(__builtin_bit_cast(int, v), 32)) + __builtin_bit_cast(float, __builtin_amdgcn_readlane(__builtin_bit_cast(int, v), 48));
}
__device__ __forceinline__ unsigned eval_mask(const float (&v)[64], float x, unsigned& a, unsigned& b) {
    unsigned ma = 0u, mb = 0u;
#pragma unroll
    for (int i = 31; i >= 0; --i) { ma = __builtin_amdgcn_alignbit(ma, __builtin_bit_cast(unsigned, v[i] - x), 31); mb = __builtin_amdgcn_alignbit(mb, __builtin_bit_cast(unsigned, v[32 + i] - x), 31); }
    a = ma; b = mb;
    return dpp_sum_u32(64u - (unsigned)__builtin_popcount(ma) - (unsigned)__builtin_popcount(mb));
}
__device__ __forceinline__ float probit(float p) { return p > 0.5f ? -probit_lo(1.f - p) : probit_lo(p); }
__device__ __forceinline__ unsigned count_ge(const float (&v)[64], float x) {
    unsigned c = 0;
#pragma unroll
    for (int i = 0; i < 64; ++i) c += (v[i] >= x) ? 1u : 0u;
    return dpp_sum_u32(c);
}
__device__ __forceinline__ float relu_i(float x) { const int i = __builtin_bit_cast(int, x); return __builtin_bit_cast(float, i > 0 ? i : 0); }
constexpr int IX_CTR = IX_ST + 512;
__device__ __forceinline__ void p3_indexer(Frame& F) {
    const h16* QI = (const h16*)(F.ws + WS_QI); const h16* KI = (const h16*)(F.ws + WS_KI); const float* WI = (const float*)(F.ws + WS_WI); u64* BM = (u64*)(F.ws + WS_BM);
    LAS float* sc = (LAS float*)F.lds;
    LAS float* st = (LAS float*)(F.lds + IX_ST);
    LAS unsigned* ctr = (LAS unsigned*)(F.lds + IX_CTR);
    const int lane = F.lane, wid = F.wave, r32 = lane & 31, hi = lane >> 5;
    if (F.tid < 64) ((LAS float*)(F.lds + IX_NEG))[F.tid] = -__builtin_inff();
    if (F.tid < 2) ctr[F.tid] = 0u;
    __syncthreads();
    const int hq = (r32 >> 2) & 1, rr = (r32 & 3) + 4 * (r32 >> 3), jq = 2 * hq + (rr >> 3), hh = rr & 7;
    f16x8 af[2][4]; f32x4 wraw[2][2][2];
#define IX_QLOAD(u_) do { const int idx_ = (u_) * 256 + (((u_) & 1) ? (255 - F.vcu) : F.vcu); const size_t rb_ = (size_t)(idx_ & 7) * SEQ + (size_t)(idx_ >> 3) * 8; \
        _Pragma("unroll") for (int rb = 0; rb < 2; ++rb) { const h16* qp = QI + (rb_ + 4 * rb + jq) * 512 + hh * 64 + hi * 8; \
            _Pragma("unroll") for (int ks = 0; ks < 4; ++ks) af[rb][ks] = *(const f16x8*)(qp + ks * 16); \
            _Pragma("unroll") for (int j2 = 0; j2 < 2; ++j2) { const float* wp = WI + (rb_ + 4 * rb + 2 * hi + j2) * 8; wraw[rb][j2][0] = *(const f32x4*)wp; wraw[rb][j2][1] = *(const f32x4*)(wp + 4); } } } while (0)
    IX_QLOAD(0);
    for (int u = 0; u < 16; ++u) {
        const int idx = u * 256 + ((u & 1) ? (255 - F.vcu) : F.vcu);
        const int b = idx & 7, t0 = (idx >> 3) * 8;
        const size_t rowb = (size_t)b * SEQ;
        const int nj = (t0 + 8 + 63) >> 6;
        {
            float wv[2][16];
#pragma unroll
            for (int rb = 0; rb < 2; ++rb)
#pragma unroll
                for (int j2 = 0; j2 < 2; ++j2)
#pragma unroll
                    for (int i = 0; i < 4; ++i) { wv[rb][8 * j2 + i] = wraw[rb][j2][0][i] * IDX_SCALE; wv[rb][8 * j2 + 4 + i] = wraw[rb][j2][1][i] * IDX_SCALE; }
            float ssum[2][2] = {{0.f, 0.f}, {0.f, 0.f}}, ssq[2][2] = {{0.f, 0.f}, {0.f, 0.f}};
            const h16* kbase = KI + (size_t)b * (128 * 2048) + lane * 8;
#define IX_TICKET(t_) do { asm volatile("ds_add_rtn_u32 %0, %1, %2" : "=v"(t_) : "v"(ctr_addr + 4u * (unsigned)(u & 1)), "v"(1u) : "memory"); } while (0)
#define IX_TGET(t_) ({ int g_; asm volatile("s_waitcnt lgkmcnt(0)\n\tv_readfirstlane_b32 %0, %1" : "=s"(g_) : "v"(t_) : "memory"); g_ >> 6; })
#define IX_LOAD(dst, g_) do { const int gg_ = (g_) < nj ? (g_) : nj - 1; _Pragma("unroll") for (int q = 0; q < 2; ++q) { const h16* kp = kbase + (size_t)(2 * gg_ + q) * 2048; \
                _Pragma("unroll") for (int ks = 0; ks < 4; ++ks) dst[q][ks] = *(const f16x8*)(kp + ks * 512); } } while (0)
#define IX_MMA(x0, x1, kt) do { x0 = f32x16{}; x1 = f32x16{}; \
                _Pragma("unroll") for (int ks = 0; ks < 4; ++ks) { x0 = __builtin_amdgcn_mfma_f32_32x32x16_f16(af[0][ks], kt[ks], x0, 0, 0, 0); x1 = __builtin_amdgcn_mfma_f32_32x32x16_f16(af[1][ks], kt[ks], x1, 0, 0, 0); } } while (0)
#define IX_VAL(x0, x1, tile_, DIAG) do { const int tile = (tile_); const int key = tile * 32 + r32; const int pos = key + 4 * (key >> 6); \
                _Pragma("unroll") for (int rb = 0; rb < 2; ++rb) { float s0 = 0.f, s1 = 0.f; \
                    _Pragma("unroll") for (int r = 0; r < 8; ++r) { const float d0 = rb ? x1[r] : x0[r], d1 = rb ? x1[8 + r] : x0[8 + r]; \
                        s0 = __builtin_fmaf(relu_i(d0), wv[rb][r], s0); s1 = __builtin_fmaf(relu_i(d1), wv[rb][8 + r], s1); } \
                    float z0 = s0, z1 = s1; \
                    if (DIAG) { if (tile * 32 + 31 > t0) { const int tq = t0 + 4 * rb + 2 * hi; const bool v0 = key <= tq, v1 = key <= tq + 1; z0 = v0 ? s0 : 0.f; z1 = v1 ? s1 : 0.f; s0 = v0 ? s0 : -__builtin_inff(); s1 = v1 ? s1 : -__builtin_inff(); } } \
                    ssum[rb][0] += z0; ssq[rb][0] = __builtin_fmaf(z0, z0, ssq[rb][0]); ssum[rb][1] += z1; ssq[rb][1] = __builtin_fmaf(z1, z1, ssq[rb][1]); \
                    sc[(4 * rb + 2 * hi) * IX_ROW + pos] = s0; sc[(4 * rb + 2 * hi + 1) * IX_ROW + pos] = s1; } } while (0)
            const int nf = nj - 1;
            const unsigned ctr_addr = (unsigned)(size_t)ctr;
            f16x8 kA[2][4], kB[2][4]; f32x16 a0, a1, b0, b1;
            unsigned tk; IX_TICKET(tk); int g0 = IX_TGET(tk), g1, gl = g0; bool lastInA = true;
            IX_LOAD(kA, g0);
            if (g0 < nf) {
                IX_TICKET(tk); g1 = IX_TGET(tk); IX_LOAD(kB, g1);
                IX_MMA(a0, a1, kA[0]);
                for (;;) {
                    IX_TICKET(tk);
                    IX_MMA(b0, b1, kA[1]); IX_VAL(a0, a1, 2 * g0, false);
                    IX_MMA(a0, a1, kB[0]); IX_VAL(b0, b1, 2 * g0 + 1, false);
                    const int g2 = IX_TGET(tk);
                    if (g1 >= nf) { gl = g1; lastInA = false; break; }
                    IX_LOAD(kA, g2);
                    IX_TICKET(tk);
                    IX_MMA(b0, b1, kB[1]); IX_VAL(a0, a1, 2 * g1, false);
                    IX_MMA(a0, a1, kA[0]); IX_VAL(b0, b1, 2 * g1 + 1, false);
                    g0 = g2; g1 = IX_TGET(tk);
                    if (g0 >= nf) { gl = g0; lastInA = true; break; }
                    IX_LOAD(kB, g1);
                }
            }
            if (gl == nf) {
                if (lastInA) { IX_MMA(a0, a1, kA[0]); IX_VAL(a0, a1, 2 * nf, true); IX_MMA(b0, b1, kA[1]); IX_VAL(b0, b1, 2 * nf + 1, true); }
                else         { IX_MMA(a0, a1, kB[0]); IX_VAL(a0, a1, 2 * nf, true); IX_MMA(b0, b1, kB[1]); IX_VAL(b0, b1, 2 * nf + 1, true); }
            }
#undef IX_TICKET
#undef IX_TGET
#undef IX_LOAD
#undef IX_MMA
#undef IX_VAL
#pragma unroll
            for (int rb = 0; rb < 2; ++rb)
#pragma unroll
                for (int j2 = 0; j2 < 2; ++j2) { float s0_, s1_, q0_, q1_; row_sum2(ssum[rb][j2], s0_, s1_); row_sum2(ssq[rb][j2], q0_, q1_);
                    if (lane == 0) { LAS float* sp = st + wid * 16 + (4 * rb + j2) * 2; sp[0] = s0_; sp[1] = q0_; sp[4] = s1_; sp[5] = q1_; } }
            IX_QLOAD(u < 15 ? u + 1 : 15);
        }
        __syncthreads();
        if (F.tid == 0) ctr[(u + 1) & 1] = 0u;
        const int t = t0 + wid, n = t + 1;
        float v[64]; float ssum_ = 0.f, ssq_ = 0.f;
        if (n > 256) {
            const LAS float* cp = (lane < nj) ? (sc + wid * IX_ROW + lane * 68) : (const LAS float*)(F.lds + IX_NEG);
#pragma unroll
            for (int i = 0; i < 16; ++i) { const f32x4 x = *(const LAS f32x4*)(cp + 4 * i); v[4 * i] = x[0]; v[4 * i + 1] = x[1]; v[4 * i + 2] = x[2]; v[4 * i + 3] = x[3]; }
#pragma unroll
            for (int w = 0; w < NWAVES; ++w) { ssum_ += st[w * 16 + wid * 2]; ssq_ += st[w * 16 + wid * 2 + 1]; }
        } else {
#pragma unroll
            for (int i = 0; i < 64; ++i) v[i] = 0.f;
        }
        __syncthreads();
        unsigned mlo = 0u, mhi = 0u;
        if (n <= 256) {
            const int rem = n - 64 * lane;
            if (rem > 0) { mlo = rem >= 32 ? 0xFFFFFFFFu : ((1u << rem) - 1u); mhi = rem >= 64 ? 0xFFFFFFFFu : (rem > 32 ? ((1u << (rem - 32)) - 1u) : 0u); }
        } else {
            const float fn = (float)n, mean = ssum_ / fn; const float var = fmaxf(ssq_ / fn - mean * mean, 1e-20f), sd = sqrtf(var);
            const float zq = -probit(256.f / fn);
            const float dens = fmaxf(fn * 0.3989423f * __expf(-0.5f * zq * zq) / sd, 1e-3f);
            float xl = -3.0e38f, xh = __builtin_inff(), cl = fn, ch = 0.f; bool hasL = false, hasH = false; int side = 0, zst = 0;
            float x = mean + fminf(fmaxf(zq, -6.f), 6.f) * sd, step = 0.f; unsigned na = 0u, nb = 0u;
            float tie_v = 0.f; int tie_need = 0;
            const float DMIN = __builtin_bit_cast(float, 1u);
            int it = 0;
            for (;;) {
                ++it;
                unsigned kx = fkey(x); const unsigned kl = fkey(xl), kh = fkey(xh);
                if (!(kx > kl && kx < kh)) kx = kl + ((kh - kl) >> 1);
                x = fkey_inv(kx);
                const unsigned c = eval_mask(v, x, na, nb);
                if (c == 256u) break;
                if (c > 256u) { xl = x; cl = (float)c; hasL = true; if (side == 1) ch = 256.f + 0.5f * (ch - 256.f); side = 1; }
                else          { xh = x; ch = (float)c; hasH = true; if (side == 2) cl = 256.f + 0.5f * (cl - 256.f); side = 2; }
                const unsigned kl2 = fkey(xl), kh2 = fkey(xh);
                if (kh2 - kl2 <= 1u) {
                    const unsigned chx = eval_mask(v, xh, na, nb); tie_v = xl; tie_need = 256 - (int)chx; break; }
                if (!(hasL && hasH)) { step = (step == 0.f) ? fminf(fabsf((float)c - 256.5f) / dens * 1.25f + 0.02f * sd, 2.f * sd) : 2.f * step; x = (c > 256u) ? x + step : x - step; }
                else if (zst == 0 && it >= 2 && xl <= 0.f && xh > DMIN) { zst = 1; x = DMIN; }
                else if (zst == 1 && xh == DMIN && xl < 0.f) { zst = 2; x = 0.f; }
                else if (it >= 8 && (it & 1)) x = fkey_inv(kl2 + ((kh2 - kl2) >> 1));
                else x = xl + (xh - xl) * ((cl - 256.5f) / (cl - ch));
            }
            mlo = ~na; mhi = ~nb;
            if (tie_need > 0) {
                unsigned ce = 0;
#pragma unroll
                for (int i = 0; i < 64; ++i) ce += (v[i] == tie_v) ? 1u : 0u;
                unsigned pre = ce;
#pragma unroll
                for (int o = 1; o < 64; o <<= 1) { const unsigned y = __shfl_up(pre, o); pre += (lane >= o) ? y : 0u; }
                int allow = tie_need - (int)(pre - ce); allow = allow < 0 ? 0 : allow;
#pragma unroll
                for (int i = 0; i < 64; ++i) { if (v[i] == tie_v && allow > 0) { if (i < 32) mlo |= 1u << i; else mhi |= 1u << (i - 32); --allow; } }
            }
        }
        if (lane <= 4 * (t0 >> 8) + 3) BM[((size_t)b * 64 + lane) * 4096 + t] = ((u64)mhi << 32) | mlo;
    }
    __syncthreads();
}

constexpr int AL_K = 0, AL_V = 16384, AL_M = 32768, AL_LUT = 36864, AL_WS = 37888, AL_OST = 40960;
constexpr int OST_STRIDE = 68;
__device__ __forceinline__ float sel_bfi(unsigned m, unsigned a, unsigned b) { unsigned d; asm("v_bfi_b32 %0, %1, %2, %3" : "=v"(d) : "v"(m), "v"(a), "s"(b)); return __builtin_bit_cast(float, d); }
__device__ __forceinline__ int crow(int r, int hi) { return (r & 3) + 8 * (r >> 2) + 4 * hi; }
__device__ __forceinline__ void attn_unit(Frame& F, int b, int h, int qb) {
    const h16* Q = (const h16*)(F.ws + WS_Q); const h16* Kg = (const h16*)(F.ws + WS_K); const h16* Vg = (const h16*)(F.ws + WS_V); const u64* BM = (const u64*)(F.ws + WS_BM);
    h16* MG = (h16*)(F.ws + WS_MERGED);
    const int tid = F.tid, lane = F.lane, wid = F.wave, r32 = lane & 31, hi = lane >> 5, grp = wid >> 2;
    const size_t rowb = (size_t)b * SEQ; const int q0 = qb * 256;
    LAS unsigned char* L = F.lds;
    LAS float* lut = (LAS float*)(L + AL_LUT); LAS float* wsf = (LAS float*)(L + AL_WS) + wid * 64; LAS float* ost = (LAS float*)(L + AL_OST) + wid * (32 * OST_STRIDE);
    if (tid < 129) lut[tid] = F.in[2][T5_BKT[tid] * 8 + h] * LOG2E;
    const float cfar = F.in[2][31 * 8 + h] * LOG2E;
    const int NT = (q0 + 256) / 64;
    const h16* ksrc = Kg + (size_t)(b * 8 + h) * 64 * 4096 + wid * 512 + lane * 8;
    const h16* vsrc = Vg + (size_t)(b * 8 + h) * 64 * 4096 + wid * 512 + lane * 8;
    const u64* msrc = BM + (size_t)b * 64 * 4096 + q0 + wid * 32 + r32;
    u32x4 kreg, vreg;
#define A_LOAD(t) do { kreg = *(const u32x4*)(ksrc + (size_t)(t) * 4096); vreg = *(const u32x4*)(vsrc + (size_t)(t) * 4096); } while (0)
#define A_STORE(buf) do { *(LAS u32x4*)(L + AL_K + (buf) * 8192 + wid * 1024 + lane * 16) = kreg; *(LAS u32x4*)(L + AL_V + (buf) * 8192 + wid * 1024 + lane * 16) = vreg; } while (0)
#define A_BAR() asm volatile("s_barrier" ::: "memory")
    const int qpos = q0 + wid * 32 + r32;
    const int qmin = q0 + wid * 32;
    const unsigned NEGINF = 0xFF800000u;
    float mref = 0.f, lrun = 0.f; bool hasmass = false; f32x16 o[2]; o[0] = f32x16{}; o[1] = f32x16{};
    f32x16 p0, p1;
#define A_COP(t_, mw_) do { const unsigned wl = (unsigned)(mw_) >> (4 * hi), wh = (unsigned)((mw_) >> 32) >> (4 * hi); \
        if ((qmin - (64 * (t_) + 63)) >= 128) { const unsigned cb = __builtin_bit_cast(unsigned, cfar - mref); \
            _Pragma("unroll") for (int r = 0; r < 16; ++r) { const int c = (r & 3) + 8 * (r >> 2); const unsigned s0 = (unsigned)__builtin_amdgcn_sbfe((int)wl, c, 1), s1 = (unsigned)__builtin_amdgcn_sbfe((int)wh, c, 1); \
                p0[r] = sel_bfi(s0, cb, NEGINF); p1[r] = sel_bfi(s1, cb, NEGINF); } \
        } else { const int base = qpos - 64 * (t_) - 4 * hi; \
            _Pragma("unroll") for (int r = 0; r < 16; ++r) { const int c = (r & 3) + 8 * (r >> 2); int i0 = base - c, i1 = base - c - 32; i0 = i0 < 0 ? 0 : (i0 > 128 ? 128 : i0); i1 = i1 < 0 ? 0 : (i1 > 128 ? 128 : i1); \
                const unsigned s0 = (unsigned)__builtin_amdgcn_sbfe((int)wl, c, 1), s1 = (unsigned)__builtin_amdgcn_sbfe((int)wh, c, 1); \
                const unsigned c0 = __builtin_bit_cast(unsigned, lut[i0] - mref), c1 = __builtin_bit_cast(unsigned, lut[i1] - mref); \
                p0[r] = sel_bfi(s0, c0, NEGINF); p1[r] = sel_bfi(s1, c1, NEGINF); } } } while (0)
    u64 mw, mwn;
    { const u32x4 k0r = *(const u32x4*)ksrc, v0r = *(const u32x4*)vsrc;
      A_LOAD(1); mw = msrc[0]; mwn = msrc[4096];
      *(LAS u32x4*)(L + AL_K + wid * 1024 + lane * 16) = k0r; *(LAS u32x4*)(L + AL_V + wid * 1024 + lane * 16) = v0r; }
    f16x8 qr[4];
    { const h16* qp = Q + (rowb + q0 + wid * 32 + r32) * 512 + h * 64 + hi * 8;
#pragma unroll
      for (int d0 = 0; d0 < 4; ++d0) qr[d0] = *(const f16x8*)(qp + d0 * 16); }
    __syncthreads();
    if (grp == 1) A_BAR();
    A_COP(0, mw); mw = mwn;
    const int vboff = ((lane >> 4) & 1) * 32 + (lane & 3) * 8 + (4 * hi + ((lane & 15) >> 2)) * 64;
    for (int t = 0; t < NT; ++t) {
        const int cur = t & 1;
        f16x8 kfr[8];
        { const LAS unsigned char* kb = L + AL_K + cur * 8192 + hi * 1024 + r32 * 16;
#pragma unroll
          for (int d0 = 0; d0 < 4; ++d0) { kfr[2 * d0] = *(const LAS f16x8*)(kb + d0 * 2048); kfr[2 * d0 + 1] = *(const LAS f16x8*)(kb + d0 * 2048 + 512); } }
        A_STORE(cur ^ 1);
        { const int tl = (t + 2 < NT) ? t + 2 : NT - 1; A_LOAD(tl); mwn = msrc[(size_t)tl * 4096]; }
        s16x4 vlo[8], vhi[8];
        { LAS unsigned char* vb = L + AL_V + cur * 8192 + vboff;
#pragma unroll
          for (int i = 0; i < 8; ++i) { vlo[i] = __builtin_amdgcn_ds_read_tr16_b64_v4i16((LAS s16x4*)(vb + (i >> 2) * 4096 + (i & 3) * 1024)); vhi[i] = __builtin_amdgcn_ds_read_tr16_b64_v4i16((LAS s16x4*)(vb + (i >> 2) * 4096 + (i & 3) * 1024 + 512)); } }
        __builtin_amdgcn_sched_barrier(0);
#pragma unroll
        for (int d0 = 0; d0 < 4; ++d0) { p0 = __builtin_amdgcn_mfma_f32_32x32x16_f16(kfr[2 * d0], qr[d0], p0, 0, 0, 0); p1 = __builtin_amdgcn_mfma_f32_32x32x16_f16(kfr[2 * d0 + 1], qr[d0], p1, 0, 0, 0); }
        __builtin_amdgcn_sched_barrier(0);
        asm volatile("s_waitcnt lgkmcnt(0)\n\ts_barrier" ::: "memory");
        __builtin_amdgcn_sched_barrier(0);
        float rs = 0.f;
#pragma unroll
        for (int r = 0; r < 16; ++r) { p0[r] = __builtin_amdgcn_exp2f(p0[r]); p1[r] = __builtin_amdgcn_exp2f(p1[r]); rs += p0[r] + p1[r]; }
        const float pm = rs + __shfl_xor(rs, 32);
        const bool need = (pm > 256.f) || (!hasmass && pm > 0.f);
        if (__any(need)) {
            const float f = need ? 1.f / pm : 1.f;
            mref += need ? __builtin_amdgcn_logf(pm) : 0.f;
            rs *= f; lrun *= f;
#pragma unroll
            for (int r = 0; r < 16; ++r) { float a_ = p0[r], b_ = p1[r]; asm("v_mul_f32 %0, %0, %1" : "+v"(a_) : "v"(f)); asm("v_mul_f32 %0, %0, %1" : "+v"(b_) : "v"(f)); p0[r] = a_; p1[r] = b_; }
            if (hi == 0) wsf[r32] = f;
            LDS_WAIT();
#pragma unroll
            for (int r = 0; r < 16; ++r) { const float a = wsf[crow(r, hi)]; o[0][r] *= a; o[1][r] *= a; }
        }
        hasmass = hasmass || (pm > 0.f);
        lrun += rs;
        u32x4 pw[4];
        pw[0] = (u32x4){pk2h(p0[0], p0[1]), pk2h(p0[2], p0[3]), pk2h(p0[4], p0[5]), pk2h(p0[6], p0[7])};
        pw[1] = (u32x4){pk2h(p0[8], p0[9]), pk2h(p0[10], p0[11]), pk2h(p0[12], p0[13]), pk2h(p0[14], p0[15])};
        pw[2] = (u32x4){pk2h(p1[0], p1[1]), pk2h(p1[2], p1[3]), pk2h(p1[4], p1[5]), pk2h(p1[6], p1[7])};
        pw[3] = (u32x4){pk2h(p1[8], p1[9]), pk2h(p1[10], p1[11]), pk2h(p1[12], p1[13]), pk2h(p1[14], p1[15])};
        __builtin_amdgcn_sched_barrier(0);
#pragma unroll
        for (int d0 = 0; d0 < 2; ++d0)
#pragma unroll
            for (int ks = 0; ks < 4; ++ks) { const int i = d0 * 4 + ks;
                typedef short s16x8 __attribute__((ext_vector_type(8)));
                const s16x8 vv = {vlo[i][0], vlo[i][1], vlo[i][2], vlo[i][3], vhi[i][0], vhi[i][1], vhi[i][2], vhi[i][3]};
                o[d0] = __builtin_amdgcn_mfma_f32_32x32x16_f16(__builtin_bit_cast(f16x8, pw[ks]), __builtin_bit_cast(f16x8, vv), o[d0], 0, 0, 0); }
        A_COP(t + 1, mw); mw = mwn;
        A_BAR();
    }
    if (grp == 0) A_BAR();
#undef A_LOAD
#undef A_STORE
#undef A_BAR
#undef A_COP
    lrun += __shfl_xor(lrun, 32);
    if (hi == 0) wsf[r32] = 1.f / lrun;
    LDS_WAIT();
#pragma unroll
    for (int r = 0; r < 16; ++r) { const float rl = wsf[crow(r, hi)]; const int qrow = crow(r, hi);
        ost[qrow * OST_STRIDE + r32] = o[0][r] * rl; ost[qrow * OST_STRIDE + 32 + r32] = o[1][r] * rl; }
    LDS_WAIT();
    { const int row = lane >> 1, hf = lane & 1; const LAS float* rp = ost + row * OST_STRIDE + hf * 32;
      f32x4 xv[8]; float ss = 0.f;
#pragma unroll
      for (int i = 0; i < 8; ++i) { xv[i] = *(const LAS f32x4*)(rp + 4 * i); ss += (xv[i][0] * xv[i][0] + xv[i][1] * xv[i][1]) + (xv[i][2] * xv[i][2] + xv[i][3] * xv[i][3]); }
      ss += __shfl_xor(ss, 1);
      const float rstd = rsqrtf(ss * (1.f / 64.f) + EPS);
      const float* gn = F.in[10] + h * 64 + hf * 32;
      h16* op = MG + (rowb + q0 + wid * 32 + row) * 1024 + h * 64 + hf * 32;
#pragma unroll
      for (int i = 0; i < 4; ++i) { const f32x4 g0 = *(const f32x4*)(gn + 8 * i), g1 = *(const f32x4*)(gn + 8 * i + 4);
          *(u32x4*)(op + 8 * i) = pk8h(xv[2 * i] * rstd * g0, xv[2 * i + 1] * rstd * g1); } }
    __syncthreads();
}
__device__ __forceinline__ void p4_attention(Frame& F) {
    const int bh = F.vcu >> 2, c = F.vcu & 3;
    for (int i = 0; i < 4; ++i) { const int qb = (i == 0) ? 2 * c : (i == 1) ? 15 - 2 * c : (i == 2) ? 2 * c + 1 : 14 - 2 * c; attn_unit(F, bh >> 3, bh & 7, qb); }
}

__device__ __forceinline__ void p6_norm2_route(Frame& F) {
    const float* mod = (const float*)(F.ws + WS_MOD); const float* g2 = F.in[13]; h16* H2 = (h16*)(F.ws + WS_H); const float* x1 = F.out;
    const h16* WRLg = (const h16*)(F.ws + WS_WRL);
    LAS h16* wrl = (LAS h16*)F.lds;
    LAS unsigned* lcnt = (LAS unsigned*)(F.lds + 73728);
    LAS unsigned* lbase = lcnt + 32;
    LAS unsigned* rinfo = (LAS unsigned*)(F.lds + 73728 + 256);
    for (int i = F.tid; i < 36 * 1024 / 8; i += NTHR) *(LAS u32x4*)(wrl + i * 8) = *(const u32x4*)(WRLg + i * 8);
    if (F.tid < 32) lcnt[F.tid] = 0u;
    __syncthreads();
    const int b = F.vcu >> 5;
    const float* bgr = F.in[15]; const float* ber = F.in[17];
    f32x4 gg[4], hh[4];
#pragma unroll
    for (int j = 0; j < 4; ++j) { const int col = 4 * F.lane + 256 * j; gg[j] = *(const f32x4*)(g2 + col) * (*(const f32x4*)(mod + (size_t)b * 6144 + 4096 + col) + 1.f); hh[j] = *(const f32x4*)(mod + (size_t)b * 6144 + 3072 + col); }
    f32x4 vn[4];
    { const size_t row = (size_t)F.vcu * 128 + F.wave * 16;
#pragma unroll
      for (int j = 0; j < 4; ++j) vn[j] = *(const f32x4*)(x1 + row * 1024 + 4 * F.lane + 256 * j); }
    for (int rr = 0; rr < 16; ++rr) {
        const int lrow = F.wave * 16 + rr; const size_t row = (size_t)F.vcu * 128 + lrow; const size_t rown = row + (rr < 15 ? 1 : 0);
        f32x4 v[4]; float ss = 0.f;
#pragma unroll
        for (int j = 0; j < 4; ++j) { v[j] = vn[j]; vn[j] = *(const f32x4*)(x1 + rown * 1024 + 4 * F.lane + 256 * j); ss += (v[j][0] * v[j][0] + v[j][1] * v[j][1]) + (v[j][2] * v[j][2] + v[j][3] * v[j][3]); }
        const float rstd = rsqrtf(dpp_sum_f32(ss) * (1.f / 1024.f) + EPS);
#pragma unroll
        for (int j = 0; j < 4; ++j) { v[j] = v[j] * rstd * gg[j] + hh[j]; u32x2 w; w.x = pk2h(v[j][0], v[j][1]); w.y = pk2h(v[j][2], v[j][3]); *(u32x2*)(H2 + row * 1024 + 4 * F.lane + 256 * j) = w; }
        float lg[4];
#pragma unroll
        for (int o = 0; o < 4; ++o) { const f16x8 wa = *(const LAS f16x8*)(wrl + (o * 64 + F.lane) * 16), wb = *(const LAS f16x8*)(wrl + (o * 64 + F.lane) * 16 + 8);
            float s = 0.f;
#pragma unroll
            for (int i = 0; i < 4; ++i) { s += v[0][i] * (float)wa[i]; s += v[1][i] * (float)wa[4 + i]; s += v[2][i] * (float)wb[i]; s += v[3][i] * (float)wb[4 + i]; }
            lg[o] = dpp_sum_f32(s) + bgr[o]; }
        int gs = 0; float gm = lg[0];
#pragma unroll
        for (int g = 1; g < 4; ++g) if (lg[g] > gm) { gm = lg[g]; gs = g; }
        float gden = 0.f;
#pragma unroll
        for (int g = 0; g < 4; ++g) gden += __expf(lg[g] - gm);
        const float pg = 1.f / gden;
        gs = __builtin_amdgcn_readfirstlane(gs);
        float el[8];
        { const LAS h16* wsel = wrl + ((4 + 8 * gs) * 64 + F.lane) * 16; const float* bsel = ber + 8 * gs;
#pragma unroll
          for (int e = 0; e < 8; ++e) { const f16x8 wa = *(const LAS f16x8*)(wsel + e * 1024), wb = *(const LAS f16x8*)(wsel + e * 1024 + 8);
            float s = 0.f;
#pragma unroll
            for (int i = 0; i < 4; ++i) { s += v[0][i] * (float)wa[i]; s += v[1][i] * (float)wa[4 + i]; s += v[2][i] * (float)wb[i]; s += v[3][i] * (float)wb[4 + i]; }
            el[e] = dpp_sum_f32(s) + bsel[e]; } }
        int e0 = 0; float m0 = el[0];
#pragma unroll
        for (int e = 1; e < 8; ++e) if (el[e] > m0) { m0 = el[e]; e0 = e; }
        int e1 = -1; float m1 = -__builtin_inff();
#pragma unroll
        for (int e = 0; e < 8; ++e) if (e != e0 && el[e] > m1) { m1 = el[e]; e1 = e; }
        const float p1 = __expf(m1 - m0); const float w0 = pg / (1.f + p1), w1 = pg * p1 / (1.f + p1);
        if (F.lane == 0) {
            const unsigned E0 = (unsigned)(gs * 8 + e0), E1 = (unsigned)(gs * 8 + e1);
            const unsigned r0 = atomicAdd((unsigned*)(lcnt + E0), 1u), r1 = atomicAdd((unsigned*)(lcnt + E1), 1u);
            rinfo[lrow * 8 + 0] = E0; rinfo[lrow * 8 + 1] = r0; rinfo[lrow * 8 + 2] = __builtin_bit_cast(unsigned, w0);
            rinfo[lrow * 8 + 3] = E1; rinfo[lrow * 8 + 4] = r1; rinfo[lrow * 8 + 5] = __builtin_bit_cast(unsigned, w1);
        }
    }
    __syncthreads();
    unsigned* gcnt = (unsigned*)(F.ws + WS_CTL) + CW_GCNT;
    if (F.tid < 32) lbase[F.tid] = atomicAdd(gcnt + F.tid, lcnt[F.tid]);
    __syncthreads();
    if (F.tid < 128) { unsigned* ro = (unsigned*)(F.ws + WS_ROUTE) + ((size_t)F.vcu * 128 + F.tid) * 8;
        const unsigned E0 = rinfo[F.tid * 8 + 0], E1 = rinfo[F.tid * 8 + 3];
        ro[0] = E0; ro[1] = lbase[E0] + rinfo[F.tid * 8 + 1]; ro[2] = rinfo[F.tid * 8 + 2]; ro[3] = E1; ro[4] = lbase[E1] + rinfo[F.tid * 8 + 4]; ro[5] = rinfo[F.tid * 8 + 5]; }
    __syncthreads();
}
__device__ __forceinline__ void expert_offsets(Frame& F, LAS unsigned* off) {
    const unsigned* gcnt = (const unsigned*)(F.ws + WS_CTL) + CW_GCNT;
    if (F.tid == 0) { unsigned a = 0; for (int e = 0; e < 32; ++e) { off[e] = a; a += (__hip_atomic_load(gcnt + e, RLX_AGENT) + 255u) & ~255u; } off[32] = a; }
    __syncthreads();
}
__device__ __forceinline__ void p7_rowmap(Frame& F) {
    LAS unsigned* off = (LAS unsigned*)F.lds;
    expert_offsets(F, off);
    int* rowmap = (int*)(F.ws + WS_ROWMAP); const unsigned* gcnt = (const unsigned*)(F.ws + WS_CTL) + CW_GCNT; int* tile_e = (int*)(F.ws + WS_CTL) + 1024;
    if (F.tid < 128) { const size_t tok = (size_t)F.vcu * 128 + F.tid; const unsigned* ro = (const unsigned*)(F.ws + WS_ROUTE) + tok * 8;
        rowmap[off[ro[0]] + ro[1]] = (int)tok; rowmap[off[ro[3]] + ro[4]] = (int)tok; }
    if (F.vcu < 32) { const int e = F.vcu; const unsigned c = __hip_atomic_load(gcnt + e, RLX_AGENT); for (unsigned r = off[e] + c + F.tid; r < off[e + 1]; r += NTHR) rowmap[r] = -1;
        for (unsigned t = off[e] / 256 + F.tid; t < off[e + 1] / 256; t += NTHR) tile_e[t] = e; }
    __syncthreads();
}
__device__ __forceinline__ void p10_combine(Frame& F) {
    LAS unsigned* off = (LAS unsigned*)F.lds;
    expert_offsets(F, off);
    const float* mod = (const float*)(F.ws + WS_MOD); const h16* Y = (const h16*)(F.ws + WS_Y); float* out = F.out;
    const int b = F.vcu >> 5;
    f32x4 g2[4];
#pragma unroll
    for (int j = 0; j < 4; ++j) g2[j] = *(const f32x4*)(mod + (size_t)b * 6144 + 5120 + 4 * F.lane + 256 * j);
    const size_t rowbase = (size_t)F.vcu * 128 + F.wave * 16;
    unsigned P0l = 0u, P1l = 0u; float C0l = 0.f, C1l = 0.f;
    if (F.lane < 16) { const unsigned* ro = (const unsigned*)(F.ws + WS_ROUTE) + (rowbase + F.lane) * 8; P0l = off[ro[0]] + ro[1]; P1l = off[ro[3]] + ro[4]; C0l = __builtin_bit_cast(float, ro[2]); C1l = __builtin_bit_cast(float, ro[5]); }
    f16x4 y0n[4], y1n[4]; f32x4 xn[4];
    { const size_t p0 = (unsigned)__shfl((int)P0l, 0), p1 = (unsigned)__shfl((int)P1l, 0);
#pragma unroll
      for (int j = 0; j < 4; ++j) { const int col = 4 * F.lane + 256 * j; y0n[j] = *(const f16x4*)(Y + p0 * 1024 + col); y1n[j] = *(const f16x4*)(Y + p1 * 1024 + col); xn[j] = *(const f32x4*)(out + rowbase * 1024 + col); } }
    for (int rr = 0; rr < 16; ++rr) {
        const size_t row = rowbase + rr; const int rn = rr < 15 ? rr + 1 : rr;
        const float c0 = __shfl(C0l, rr), c1 = __shfl(C1l, rr);
        const size_t p0n = (unsigned)__shfl((int)P0l, rn), p1n = (unsigned)__shfl((int)P1l, rn);
#pragma unroll
        for (int j = 0; j < 4; ++j) { const int col = 4 * F.lane + 256 * j;
            const f16x4 y0 = y0n[j], y1 = y1n[j]; f32x4 xv = xn[j];
            y0n[j] = *(const f16x4*)(Y + p0n * 1024 + col); y1n[j] = *(const f16x4*)(Y + p1n * 1024 + col); xn[j] = *(const f32x4*)(out + (rowbase + rn) * 1024 + col);
#pragma unroll
            for (int i = 0; i < 4; ++i) xv[i] += g2[j][i] * (c0 * (float)y0[i] + c1 * (float)y1[i]);
            *(f32x4*)(out + row * 1024 + col) = xv; }
    }
}
constexpr int N_PHASES = 11;
__global__ void __launch_bounds__(NTHR, 2) mega_fwd(Args args) {
    extern __shared__ __attribute__((aligned(16))) unsigned char lds_raw[];
    Frame F;
    F.lds = (LAS unsigned char*)lds_raw; F.ldsg = lds_raw;
    F.tid = threadIdx.x; F.lane = F.tid & 63; F.wave = __builtin_amdgcn_readfirstlane(F.tid >> 6);
    F.G = gridDim.x; { const int bx = blockIdx.x; F.vcu = (F.G % 8 == 0) ? (bx % 8) * (F.G / 8) + bx / 8 : bx; }
    F.in = (const float* const __attribute__((address_space(4)))*)__builtin_amdgcn_kernarg_segment_ptr();
    F.out = args.out; F.ws = args.ws;
    volatile LAS unsigned* MISC = (volatile LAS unsigned*)(F.lds + MISC_OFF);
    if (F.tid < 16) MISC[F.tid] = 0u;
    __syncthreads();
    const int lo = args.ph_lo, hi = args.ph_hi;
    XcdBarrier bar; bar.bar = (unsigned*)(F.ws + WS_CTL) + CW_BAR; bar.x = 0; bar.st = nullptr;
    if (hi - lo > 1) bar = xcd_barrier_post((unsigned*)(F.ws + WS_CTL) + CW_BAR, MISC + 8);
#define IN(k) (lo <= (k) && (k) < hi)
#define STAMP(k) do {} while (0)
#define SEAM(k) do { if (IN(k) && IN((k) + 1)) xcd_barrier(bar); STAMP((k) + 1); } while (0)
    STAMP(0);
    if (IN(0)) { p0_prologue(F); }
    if (lo < 0) { cg::this_grid().sync(); }
    SEAM(0);
    if (IN(1)) { p1_norm1(F); }
    SEAM(1);
    if (IN(2)) {
        pg8::Gemm g{(const h16*)(F.ws + WS_H), (const h16*)(F.ws + WS_WINT), M, NINP, DM, 0, nullptr}; pg8::StaticOrder S; S.init(M, NINP, F.G, (int)blockIdx.x);
        EpiInProj E{(h16*)(F.ws + WS_Q), (h16*)(F.ws + WS_K), (h16*)(F.ws + WS_V), (h16*)(F.ws + WS_QI), (h16*)(F.ws + WS_KI), (h16*)(F.ws + WS_GB), (h16*)(F.ws + WS_Z), (float*)(F.ws + WS_WI), F.in[7], F.in[8]};
        pg8::gemm_phase<EpiInProj, pg8::StaticOrder, false>(F.lds, g, S, E);
    }
    SEAM(2);
    if (IN(3)) { p3_conv(F); p3_indexer(F); }
    SEAM(3);
    if (IN(4)) { p4_attention(F); }
    SEAM(4);
    if (IN(5)) {
        pg8::Gemm g{(const h16*)(F.ws + WS_MERGED), (const h16*)(F.ws + WS_WOUTT), M, DM, DM, 0, nullptr}; pg8::StaticOrder S; S.init(M, DM, F.G, (int)blockIdx.x);
        EpiOutProj E{F.in[0], F.out, (const float*)(F.ws + WS_MOD)};
        pg8::gemm_phase<EpiOutProj, pg8::StaticOrder, false>(F.lds, g, S, E);
    }
    SEAM(5);
    if (IN(6)) { p6_norm2_route(F); }
    SEAM(6);
    if (IN(7)) { p7_rowmap(F); }
    SEAM(7);
    if (IN(8)) {
        LAS unsigned* off = (LAS unsigned*)(F.lds + RING_BYTES); expert_offsets(F, off); const int ntiles = (int)(off[32] / 256u); __syncthreads();
        pg8::Gemm g{(const h16*)(F.ws + WS_H), (const h16*)(F.ws + WS_WGUT), 0, 512, DM, (size_t)512 * 1024 * 2, (const int*)(F.ws + WS_ROWMAP)};
        pg8::GroupedOrder S{(const int*)(F.ws + WS_CTL) + 1024, ntiles, 2, F.G, F.vcu};
        EpiMoeUp E{(h16*)(F.ws + WS_HID)};
        pg8::gemm_phase<EpiMoeUp, pg8::GroupedOrder, true>(F.lds, g, S, E);
    }
    SEAM(8);
    if (IN(9)) {
        LAS unsigned* off = (LAS unsigned*)(F.lds + RING_BYTES); expert_offsets(F, off); const int ntiles = (int)(off[32] / 256u); __syncthreads();
        pg8::Gemm g{(const h16*)(F.ws + WS_HID), (const h16*)(F.ws + WS_WDT), 0, 1024, EFF, (size_t)1024 * 256 * 2, nullptr};
        pg8::GroupedOrder S{(const int*)(F.ws + WS_CTL) + 1024, ntiles, 4, F.G, F.vcu};
        EpiMoeDown E{(h16*)(F.ws + WS_Y)};
        pg8::gemm_phase<EpiMoeDown, pg8::GroupedOrder, false>(F.lds, g, S, E);
    }
    SEAM(9);
    if (IN(10)) { p10_combine(F); }

#undef IN
#undef SEAM
}

extern "C" void kernel_launch(void* const* d_in, const int* in_sizes, int n_in, void* d_out, int out_size, void* d_ws, size_t ws_size, hipStream_t stream) {
    static int grid = 0;
    if (grid == 0) {
        if (n_in != 21 || out_size != M * DM || ws_size < WS_END) { fprintf(stderr, "kernel_launch: unexpected shapes (n_in %d out %d ws %zu)\n", n_in, out_size, ws_size); grid = -1; return; }
        int dev = 0, cus = 0, per_cu = 0;
        (void)hipGetDevice(&dev); (void)hipDeviceGetAttribute(&cus, hipDeviceAttributeMultiprocessorCount, dev);
        if (hipFuncSetAttribute((const void*)mega_fwd, hipFuncAttributeMaxDynamicSharedMemorySize, LDS_BYTES) != hipSuccess) { fprintf(stderr, "kernel_launch: hipFuncSetAttribute failed\n"); grid = -1; return; }
        if (hipOccupancyMaxActiveBlocksPerMultiprocessor(&per_cu, (const void*)mega_fwd, NTHR, LDS_BYTES) != hipSuccess || per_cu < 1) { fprintf(stderr, "kernel_launch: occupancy query says %d\n", per_cu); per_cu = 1; }
        (void)hipGetLastError();
        grid = cus;
        if (grid != 256) { fprintf(stderr, "kernel_launch: built for 256 CUs, got %d\n", grid); }
    }
    if (grid < 0) return;
    (void)hipMemsetAsync((char*)d_ws + WS_CTL, 0, CTL_ZERO_BYTES, stream);
    Args a{};
    for (int i = 0; i < 21; ++i) a.in[i] = (const float*)d_in[i];
    a.out = (float*)d_out; a.ws = (unsigned char*)d_ws;
#if MK_N_LAUNCHES == 1
    a.ph_lo = 0; a.ph_hi = N_PHASES;
    void* kargs[] = {&a};
    hipError_t e = hipLaunchCooperativeKernel((const void*)mega_fwd, dim3(grid), dim3(NTHR), kargs, LDS_BYTES, stream);
    if (e != hipSuccess) fprintf(stderr, "cooperative launch failed: %s\n", hipGetErrorString(e));
#else
    for (int p = 0; p < N_PHASES; ++p) { a.ph_lo = p; a.ph_hi = p + 1; hipLaunchKernelGGL(mega_fwd, dim3(grid), dim3(NTHR), LDS_BYTES, stream, a); }
#endif
}
```

```cpp
#include <hip/hip_runtime.h>
#include <hip/hip_cooperative_groups.h>
#include <cstdio>
#include <cstdint>
namespace cg = cooperative_groups;

#ifndef MK_N_LAUNCHES

#define MK_N_LAUNCHES 1
#endif

#define LAS __attribute__((address_space(3)))
#define GAS __attribute__((address_space(1)))
typedef _Float16 h16;
typedef _Float16 f16x8 __attribute__((ext_vector_type(8)));
typedef _Float16 f16x4 __attribute__((ext_vector_type(4)));
typedef _Float16 f16x2 __attribute__((ext_vector_type(2)));
typedef short s16x4 __attribute__((ext_vector_type(4)));
typedef float f32x2 __attribute__((ext_vector_type(2)));
typedef float f32x4 __attribute__((ext_vector_type(4)));
typedef float f32x16 __attribute__((ext_vector_type(16)));
typedef unsigned u32x2 __attribute__((ext_vector_type(2)));
typedef unsigned u32x4 __attribute__((ext_vector_type(4)));
typedef unsigned long long u64;

constexpr int BATCH = 8, SEQ = 4096, DM = 1024, M = BATCH * SEQ;
constexpr int NINP = 3840;
constexpr int NEXP = 32, EFF = 256;
constexpr int MAXROWS = 2 * M + NEXP * 256;
constexpr float EPS = 1e-6f;
constexpr float LOG2E = 1.4426950408889634f;
constexpr float QSCALE = 0.125f * LOG2E;
constexpr float IDX_SCALE = 0.125f * 0.35355339059327373f;
constexpr int NWAVES = 8, NTHR = 512;

constexpr size_t MiB = 1u << 20;
constexpr size_t WS_CTL = 0, CTL_ZERO_BYTES = 64 * 1024;
constexpr size_t WS_MODP = 1 * MiB;
constexpr size_t WS_MOD = 4 * MiB;
constexpr size_t WS_ROUTE = 5 * MiB;
constexpr size_t WS_ROWMAP = 6 * MiB + 512 * 1024;
constexpr size_t WS_WINT = 8 * MiB;
constexpr size_t WS_WOUTT = 16 * MiB;
constexpr size_t WS_WRL = 18 * MiB;
constexpr size_t WS_WGUT = 20 * MiB;
constexpr size_t WS_WDT = 52 * MiB;
constexpr size_t WS_H = 72 * MiB;
constexpr size_t WS_Q = 136 * MiB, WS_K = 168 * MiB, WS_V = 200 * MiB, WS_QI = 232 * MiB;
constexpr size_t WS_KI = 264 * MiB;
constexpr size_t WS_WI = 268 * MiB;
constexpr size_t WS_GB = 270 * MiB, WS_Z = 302 * MiB;
constexpr size_t WS_BM = 334 * MiB;
constexpr size_t WS_MERGED = 350 * MiB;
constexpr size_t WS_HID = 416 * MiB;
constexpr size_t WS_Y = 136 * MiB;
constexpr size_t WS_END = 456 * MiB;
static_assert(WS_Y + (size_t)MAXROWS * 1024 * 2 <= WS_Z + 32 * MiB, "Y overlay");
static_assert(WS_HID + (size_t)MAXROWS * 256 * 2 <= WS_END, "HID");
constexpr int CW_GCNT = 64;
constexpr int CW_BAR = 4096;

constexpr int LDS_BYTES = 147456;
constexpr int RING_BYTES = 131072;
constexpr int MISC_OFF = 147456 - 256;

__device__ const unsigned char T5_BKT[129] = {0, 1, 2, 3, 4, 5, 6, 7, 8, 9, 10, 11, 12, 13, 14, 15, 16, 16, 16, 17, 17, 18, 18, 18, 19, 19, 19, 20, 20, 20, 20, 21, 21, 21, 21, 22, 22, 22, 22, 22, 23, 23, 23, 23, 23, 23, 24, 24, 24, 24, 24, 24, 25, 25, 25, 25, 25, 25, 25, 26, 26, 26, 26, 26, 26, 26, 26, 27, 27, 27, 27, 27, 27, 27, 27, 27, 27, 28, 28, 28, 28, 28, 28, 28, 28, 28, 28, 29, 29, 29, 29, 29, 29, 29, 29, 29, 29, 29, 29, 30, 30, 30, 30, 30, 30, 30, 30, 30, 30, 30, 30, 30, 30, 31, 31, 31, 31, 31, 31, 31, 31, 31, 31, 31, 31, 31, 31, 31, 31};

#define LDS_WAIT() asm volatile("s_waitcnt lgkmcnt(0)" ::: "memory")
#define VM_WAIT() asm volatile("s_waitcnt vmcnt(0)" ::: "memory")
#define RLX_AGENT __ATOMIC_RELAXED, __HIP_MEMORY_SCOPE_AGENT
__device__ __forceinline__ unsigned pk2h(float lo, float hi) { f32x2 v = {lo, hi}; f16x2 h = __builtin_convertvector(v, f16x2); return __builtin_bit_cast(unsigned, h); }
__device__ __forceinline__ u32x4 pk8h(f32x4 a, f32x4 b) { u32x4 w; w.x = pk2h(a[0], a[1]); w.y = pk2h(a[2], a[3]); w.z = pk2h(b[0], b[1]); w.w = pk2h(b[2], b[3]); return w; }
__device__ __forceinline__ float wave_sum(float v) {
#pragma unroll
    for (int o = 1; o < 64; o <<= 1) v += __shfl_xor(v, o);
    return v;
}
__device__ __forceinline__ unsigned dpp_sum_u32(unsigned v) {
    v += (unsigned)__builtin_amdgcn_update_dpp(0, (int)v, 0xB1, 0xf, 0xf, false);
    v += (unsigned)__builtin_amdgcn_update_dpp(0, (int)v, 0x4E, 0xf, 0xf, false);
    v += (unsigned)__builtin_amdgcn_update_dpp(0, (int)v, 0x141, 0xf, 0xf, false);
    v += (unsigned)__builtin_amdgcn_update_dpp(0, (int)v, 0x140, 0xf, 0xf, false);
    return __builtin_amdgcn_readlane(v, 0) + __builtin_amdgcn_readlane(v, 16) + __builtin_amdgcn_readlane(v, 32) + __builtin_amdgcn_readlane(v, 48);
}
__device__ __forceinline__ float dpp_sum_f32(float v) {
    v += __builtin_bit_cast(float, __builtin_amdgcn_update_dpp(0, __builtin_bit_cast(int, v), 0xB1, 0xf, 0xf, false));
    v += __builtin_bit_cast(float, __builtin_amdgcn_update_dpp(0, __builtin_bit_cast(int, v), 0x4E, 0xf, 0xf, false));
    v += __builtin_bit_cast(float, __builtin_amdgcn_update_dpp(0, __builtin_bit_cast(int, v), 0x141, 0xf, 0xf, false));
    v += __builtin_bit_cast(float, __builtin_amdgcn_update_dpp(0, __builtin_bit_cast(int, v), 0x140, 0xf, 0xf, false));
    return __builtin_bit_cast(float, __builtin_amdgcn_readlane(__builtin_bit_cast(int, v), 0)) + __builtin_bit_cast(float, __builtin_amdgcn_readlane(__builtin_bit_cast(int, v), 16)) +
           __builtin_bit_cast(float, __builtin_amdgcn_readlane(__builtin_bit_cast(int, v), 32)) + __builtin_bit_cast(float, __builtin_amdgcn_readlane(__builtin_bit_cast(int, v), 48));
}
__device__ __forceinline__ float dpp_max_f32(float v) {
    v = fmaxf(v, __builtin_bit_cast(float, __builtin_amdgcn_update_dpp(__builtin_bit_cast(int, v), __builtin_bit_cast(int, v), 0xB1, 0xf, 0xf, false)));
    v = fmaxf(v, __builtin_bit_cast(float, __builtin_amdgcn_update_dpp(__builtin_bit_cast(int, v), __builtin_bit_cast(int, v), 0x4E, 0xf, 0xf, false)));
    v = fmaxf(v, __builtin_bit_cast(float, __builtin_amdgcn_update_dpp(__builtin_bit_cast(int, v), __builtin_bit_cast(int, v), 0x141, 0xf, 0xf, false)));
    v = fmaxf(v, __builtin_bit_cast(float, __builtin_amdgcn_update_dpp(__builtin_bit_cast(int, v), __builtin_bit_cast(int, v), 0x140, 0xf, 0xf, false)));
    float a = __builtin_bit_cast(float, __builtin_amdgcn_readlane(__builtin_bit_cast(int, v), 0)), b = __builtin_bit_cast(float, __builtin_amdgcn_readlane(__builtin_bit_cast(int, v), 16));
    float c = __builtin_bit_cast(float, __builtin_amdgcn_readlane(__builtin_bit_cast(int, v), 32)), d = __builtin_bit_cast(float, __builtin_amdgcn_readlane(__builtin_bit_cast(int, v), 48));
    return fmaxf(fmaxf(a, b), fmaxf(c, d));
}
__device__ __forceinline__ float dpp_min_f32(float v) { return -dpp_max_f32(-v); }
__device__ __forceinline__ float silu_f(float v) { return v / (1.f + __expf(-v)); }

namespace pg8 {
#define PG8_LAS __attribute__((address_space(3)))
constexpr int BM = 256, BK = 64, HALF = 128, HTB = HALF * BK * 2, STAGE_BYTES = 8 * HTB, NXCD = 8, WGM = 8;
__host__ __device__ __forceinline__ int lds_byte(int r, int c) { const int st = (r >> 4) * 2 + (c >> 5), rr = r & 15, cc = c & 31, ob = rr * 64 + cc * 2; return st * 1024 + (ob ^ (((ob >> 9) & 1) << 5)); }
__host__ __device__ __forceinline__ void stage_rc(int b, int& R, int& C) { const int st = b / 1024, sb = b % 1024, swz = sb ^ (((sb >> 9) & 1) << 5); R = (st >> 1) * 16 + swz / 64; C = (st & 1) * 32 + (swz % 64) / 2; }
__host__ __device__ __forceinline__ int perm32(int rho) { const int n = rho >> 4, i = rho & 15; return 8 * (i >> 2) + 4 * n + (i & 3); }

struct Unit { int pm, pn, eb; };
struct Gemm { const h16* A; const h16* Bt; int M, N, K; size_t bstride; const int* rowmap; };

struct StaticOrder {
    int nM, nN, nwg, G, c;
    __device__ void init(int M_, int N_, int G_, int c_) { nM = M_ / BM; nN = N_ / BM; nwg = nM * nN; G = G_; c = c_; }
    __device__ bool next(int i, Unit& u) const {
        const long L = (long)i * G + c; if (L >= nwg) return false;
        int wgid = (int)L; { const int q = nwg / NXCD, r = nwg % NXCD, xcd = wgid % NXCD, off = wgid / NXCD; wgid = (xcd < r ? xcd * (q + 1) : r * (q + 1) + (xcd - r) * q) + off; }
        const int nig = WGM * nN, gid = wgid / nig, fm = gid * WGM, gsz = (nM - fm) < WGM ? (nM - fm) : WGM;
        u.pm = fm + ((wgid % nig) % gsz); u.pn = (wgid % nig) / gsz; u.eb = 0; return true;
    }
};
struct GroupedOrder {
    const int* tile_e; int nN, first, step, n;
    __device__ bool next(int i, Unit& u) const {
        if (i >= n) return false;
        const int L = first + i * step;
        u.pm = L / nN; u.pn = L % nN; u.eb = tile_e[u.pm]; return true;
    }
};

template <class Epi, class Sched, bool GATHER>
__device__ __forceinline__ void gemm_phase(PG8_LAS unsigned char* lds, const Gemm g, const Sched& S, const Epi& E) {
    const int tid = threadIdx.x, wid = __builtin_amdgcn_readfirstlane(tid >> 6), lane = tid & 63, wr = wid >> 2, wc = wid & 3, fr = lane & 15, fq = lane >> 4;
    int K_ = g.K; asm volatile("" : "+s"(K_));
    const int K = K_, nt = K / BK;
    unsigned voffB[2]; unsigned cC[2]; int cR[2];
    unsigned vA0[2], vA1[2];
#pragma unroll
    for (int i = 0; i < 2; ++i) { int R, C; stage_rc(tid * 16 + i * 8192, R, C); const int Rb = Epi::PERM ? ((R & ~31) + perm32(R & 31)) : R;
        cR[i] = R; cC[i] = (unsigned)C * 2u; voffB[i] = (unsigned)(Rb * K + C) * 2u; vA0[i] = (unsigned)(R * K + C) * 2u; vA1[i] = vA0[i]; }
    const size_t kstep = (size_t)(BK * 2);
    const size_t hstep = (size_t)HALF * K * 2;
    const size_t tstep = 2 * hstep;
    const unsigned ldsw = (unsigned)wid * 1024u;
    const int aoff = lds_byte(wr * 64 + fr, fq * 8), boff = lds_byte(wc * 32 + fr, fq * 8);
#define PG8_SA(b, h) (((b) * 2 + (h)) * HTB)
#define PG8_SB(b, h) ((4 + (b) * 2 + (h)) * HTB)
#define PG8_STAGE(bufoff, gbase, voff) do { _Pragma("unroll") for (int _i = 0; _i < 2; ++_i) \
        __builtin_amdgcn_global_load_lds((const unsigned*)((const char*)(gbase) + (voff)[_i]), (PG8_LAS unsigned*)(lds + (bufoff) + ldsw + _i * 8192), 16, 0, 0); } while (0)
#define PG8_LDA(dst, b, h) do { _Pragma("unroll") for (int m = 0; m < 4; ++m) _Pragma("unroll") for (int k = 0; k < 2; ++k) dst[m][k] = *(const PG8_LAS f16x8*)(lds + PG8_SA(b, h) + aoff + m * 2048 + k * 1024); } while (0)
#define PG8_LDB(dst, b, h) do { _Pragma("unroll") for (int n = 0; n < 2; ++n) _Pragma("unroll") for (int k = 0; k < 2; ++k) dst[n][k] = *(const PG8_LAS f16x8*)(lds + PG8_SB(b, h) + boff + n * 2048 + k * 1024); } while (0)
#define PG8_MMA(ai, bj, At, Bt) do { __builtin_amdgcn_s_setprio(1); _Pragma("unroll") for (int m = 0; m < 4; ++m) _Pragma("unroll") for (int n = 0; n < 2; ++n) _Pragma("unroll") for (int k = 0; k < 2; ++k) \
        acc[ai][bj][m][n] = __builtin_amdgcn_mfma_f32_16x16x32_f16(Bt[n][k], At[m][k], acc[ai][bj][m][n], 0, 0, 0); __builtin_amdgcn_s_setprio(0); } while (0)
#define PG8_WAIT_V(n) asm volatile("s_waitcnt vmcnt(" #n ")" ::: "memory")
#define PG8_WAIT_L(n) asm volatile("s_waitcnt lgkmcnt(" #n ")" ::: "memory")
#define PG8_BAR __builtin_amdgcn_s_barrier()
#define PG8_SCHED __builtin_amdgcn_sched_barrier(0)
#define PG8_ABASE(u_) (GATHER ? (const char*)g.A : (const char*)g.A + (size_t)(u_).pm * tstep)
#define PG8_AH1 (GATHER ? (size_t)0 : hstep)
#define PG8_GATHER_OFF(u_, d0, d1) do { if (GATHER) { _Pragma("unroll") for (int _i = 0; _i < 2; ++_i) { \
        int r0_ = g.rowmap[(u_).pm * BM + cR[_i]], r1_ = g.rowmap[(u_).pm * BM + HALF + cR[_i]]; r0_ = r0_ < 0 ? 0 : r0_; r1_ = r1_ < 0 ? 0 : r1_; \
        d0[_i] = (unsigned)r0_ * (unsigned)(K * 2) + cC[_i]; d1[_i] = (unsigned)r1_ * (unsigned)(K * 2) + cC[_i]; } } } while (0)
    Unit cur, nxt; int ui = 0;
    if (!S.next(0, cur)) return;
    f32x4 acc[2][2][4][2];
#pragma unroll
    for (int a = 0; a < 2; ++a)
#pragma unroll
        for (int b = 0; b < 2; ++b)
#pragma unroll
            for (int m = 0; m < 4; ++m)
#pragma unroll
                for (int n = 0; n < 2; ++n) acc[a][b][m][n] = (f32x4){0.f, 0.f, 0.f, 0.f};
    f16x8 At[4][2], B0[2][2], B1[2][2];
    PG8_GATHER_OFF(cur, vA0, vA1);
    const char* cA = PG8_ABASE(cur); const char* cB = (const char*)g.Bt + (size_t)cur.eb * g.bstride + (size_t)cur.pn * tstep;
    PG8_STAGE(PG8_SB(0, 0), cB, voffB); PG8_STAGE(PG8_SB(0, 1), cB + hstep, voffB); PG8_STAGE(PG8_SA(0, 0), cA, vA0); PG8_STAGE(PG8_SA(0, 1), cA + PG8_AH1, vA1);
    if (wr == 1) PG8_BAR;
    PG8_WAIT_V(2); PG8_BAR;
    PG8_STAGE(PG8_SB(1, 0), cB + kstep, voffB); PG8_STAGE(PG8_SA(1, 0), cA + kstep, vA0); PG8_STAGE(PG8_SB(1, 1), cB + hstep + kstep, voffB);
    PG8_WAIT_V(6); PG8_BAR;
    for (;;) {
        const bool has_next = S.next(ui + 1, nxt);
        unsigned nA0[2] = {vA0[0], vA0[1]}, nA1[2] = {vA1[0], vA1[1]};
        if (has_next) PG8_GATHER_OFF(nxt, nA0, nA1);
        const char* nA = has_next ? PG8_ABASE(nxt) : cA; const char* nB = has_next ? (const char*)g.Bt + (size_t)nxt.eb * g.bstride + (size_t)nxt.pn * tstep : cB;
        for (int t = 0; t < nt; t += 2) {
            const bool last = (t == nt - 2);
            const char* a1 = cA + (size_t)(t + 1) * kstep;
            const char* a2 = last ? nA : cA + (size_t)(t + 2) * kstep; const char* b2 = last ? nB : cB + (size_t)(t + 2) * kstep;
            const char* a3 = a2 + kstep; const char* b3 = b2 + kstep;
            unsigned w0[2], w1[2];
#pragma unroll
            for (int i = 0; i < 2; ++i) { w0[i] = last ? nA0[i] : vA0[i]; w1[i] = last ? nA1[i] : vA1[i]; }
            PG8_LDB(B0, 0, 0); PG8_LDB(B1, 0, 1); PG8_SCHED; PG8_LDA(At, 0, 0); PG8_STAGE(PG8_SA(1, 1), a1 + PG8_AH1, vA1);
            PG8_WAIT_V(8); PG8_WAIT_L(0); PG8_BAR; PG8_MMA(0, 0, At, B0); PG8_MMA(0, 1, At, B1); PG8_BAR; PG8_SCHED;
            PG8_LDA(At, 0, 1); PG8_STAGE(PG8_SB(0, 0), b2, voffB); PG8_STAGE(PG8_SB(0, 1), b2 + hstep, voffB); PG8_STAGE(PG8_SA(0, 0), a2, w0);
            PG8_WAIT_V(8); PG8_WAIT_L(0); PG8_BAR; PG8_MMA(1, 0, At, B0); PG8_MMA(1, 1, At, B1); PG8_BAR; PG8_SCHED;
            PG8_LDB(B0, 1, 0); PG8_LDB(B1, 1, 1); PG8_SCHED; PG8_LDA(At, 1, 0); PG8_STAGE(PG8_SA(0, 1), a2 + PG8_AH1, w1);
            PG8_WAIT_V(8); PG8_WAIT_L(0); PG8_BAR; PG8_MMA(0, 0, At, B0); PG8_MMA(0, 1, At, B1); PG8_BAR; PG8_SCHED;
            PG8_LDA(At, 1, 1); PG8_STAGE(PG8_SB(1, 0), b3, voffB); PG8_STAGE(PG8_SB(1, 1), b3 + hstep, voffB); PG8_STAGE(PG8_SA(1, 0), a3, w0);
            PG8_WAIT_V(8); PG8_WAIT_L(0); PG8_BAR; PG8_MMA(1, 0, At, B0); PG8_MMA(1, 1, At, B1); PG8_BAR; PG8_SCHED;
        }
        if (wr == 0) PG8_BAR;
        E(acc, cur, wr, wc, fr, fq);
        if (!has_next) break;
#pragma unroll
        for (int a = 0; a < 2; ++a)
#pragma unroll
            for (int b = 0; b < 2; ++b)
#pragma unroll
                for (int m = 0; m < 4; ++m)
#pragma unroll
                    for (int n = 0; n < 2; ++n) acc[a][b][m][n] = (f32x4){0.f, 0.f, 0.f, 0.f};
        cur = nxt; cA = nA; cB = nB; ++ui;
#pragma unroll
        for (int i = 0; i < 2; ++i) { vA0[i] = nA0[i]; vA1[i] = nA1[i]; }
        if (wr == 1) PG8_BAR;
    }
    PG8_WAIT_V(0);
    PG8_BAR;
#undef PG8_SA
#undef PG8_SB
#undef PG8_STAGE
#undef PG8_LDA
#undef PG8_LDB
#undef PG8_MMA
#undef PG8_WAIT_V
#undef PG8_WAIT_L
#undef PG8_BAR
#undef PG8_SCHED
#undef PG8_ABASE
#undef PG8_AH1
#undef PG8_GATHER_OFF
}
}

struct EpiInProj {
    static constexpr bool PERM = true;
    h16 *Q, *K, *V, *QI, *KI, *GB, *Z; float* WI; const float *qn, *kn;
    __device__ __forceinline__ void operator()(const f32x4 (&acc)[2][2][4][2], const pg8::Unit& u, int wr, int wc, int fr, int fq) const {
        const int row0 = u.pm * 256 + wr * 64 + fr; const int pn = u.pn;
        if (pn < 4) {
            const bool isq = pn < 2; const float* g = isq ? qn : kn; h16* O = isq ? Q : K; const int head = 4 * (pn & 1) + wc; const float sc = isq ? QSCALE : 1.f;
            f32x4 gv[2][2];
#pragma unroll
            for (int bj = 0; bj < 2; ++bj)
#pragma unroll
                for (int n = 0; n < 2; ++n) gv[bj][n] = *(const f32x4*)(g + 32 * bj + 8 * fq + 4 * n) * sc;
#pragma unroll
            for (int ai = 0; ai < 2; ++ai)
#pragma unroll
                for (int m = 0; m < 4; ++m) {
                    float ss = 0.f;
#pragma unroll
                    for (int bj = 0; bj < 2; ++bj)
#pragma unroll
                        for (int n = 0; n < 2; ++n) { const f32x4 v = acc[ai][bj][m][n]; ss += (v[0] * v[0] + v[1] * v[1]) + (v[2] * v[2] + v[3] * v[3]); }
                    ss += __shfl_xor(ss, 16); ss += __shfl_xor(ss, 32);
                    const float rstd = rsqrtf(ss * (1.f / 64.f) + EPS);
                    const int R = row0 + ai * 128 + m * 16;
                    if (isq) { h16* rowp = O + (size_t)R * 512 + head * 64 + 8 * fq;
#pragma unroll
                        for (int bj = 0; bj < 2; ++bj) *(u32x4*)(rowp + 32 * bj) = pk8h(acc[ai][bj][m][0] * rstd * gv[bj][0], acc[ai][bj][m][1] * rstd * gv[bj][1]); }
                    else {
                        h16* tp = O + ((size_t)((R >> 12) * 8 + head) * 64 + ((R & 4095) >> 6)) * 4096 + (R & 63) * 8;
#pragma unroll
                        for (int bj = 0; bj < 2; ++bj) *(u32x4*)(tp + (4 * bj + fq) * 512) = pk8h(acc[ai][bj][m][0] * rstd * gv[bj][0], acc[ai][bj][m][1] * rstd * gv[bj][1]); }
                }
        } else if (pn < 8) {
            h16* O = pn < 6 ? V : QI; const int head = 4 * (pn & 1) + wc;
#pragma unroll
            for (int ai = 0; ai < 2; ++ai)
#pragma unroll
                for (int m = 0; m < 4; ++m) { const int R = row0 + ai * 128 + m * 16;
                    if (pn >= 6) { h16* rowp = O + (size_t)R * 512 + head * 64 + 8 * fq;
#pragma unroll
                        for (int bj = 0; bj < 2; ++bj) *(u32x4*)(rowp + 32 * bj) = pk8h(acc[ai][bj][m][0], acc[ai][bj][m][1]); }
                    else {
                        const int kv = R & 63; h16* tp = O + ((size_t)((R >> 12) * 8 + head) * 64 + ((R & 4095) >> 6)) * 4096 + ((kv >> 4) * 64 + (kv & 15) * 4 + fq) * 8;
#pragma unroll
                        for (int bj = 0; bj < 2; ++bj) *(u32x4*)(tp + bj * 2048) = pk8h(acc[ai][bj][m][0], acc[ai][bj][m][1]); } }
        } else if (pn == 8) {
#pragma unroll
            for (int ai = 0; ai < 2; ++ai)
#pragma unroll
                for (int m = 0; m < 4; ++m) { const size_t row = (size_t)(row0 + ai * 128 + m * 16);
                    if (wc < 2) { const int R = (int)row, c8 = 4 * wc + fq;
                        *(u32x4*)(KI + ((((size_t)(R >> 12) * 128 + ((R & 4095) >> 5)) * 4 + (c8 >> 1)) * 64 + (R & 31) + 32 * (c8 & 1)) * 8) = pk8h(acc[ai][0][m][0], acc[ai][0][m][1]); }
                    else if (wc == 2 && fq == 0) { *(f32x4*)(WI + row * 8) = acc[ai][0][m][0]; *(f32x4*)(WI + row * 8 + 4) = acc[ai][0][m][1]; } }
        } else if (pn < 11) {
            const int colb = 256 * (pn - 9) + 32 * wc + 8 * fq;
#pragma unroll
            for (int ai = 0; ai < 2; ++ai)
#pragma unroll
                for (int m = 0; m < 4; ++m) { h16* rowp = GB + (size_t)(row0 + ai * 128 + m * 16) * 512 + colb;
#pragma unroll
                    for (int bj = 0; bj < 2; ++bj) *(u32x4*)(rowp + 128 * bj) = pk8h(acc[ai][bj][m][0], acc[ai][bj][m][1]); }
        } else {
            const int ch = 128 * (pn - 11) + 32 * wc + 8 * fq;
#pragma unroll
            for (int ai = 0; ai < 2; ++ai)
#pragma unroll
                for (int m = 0; m < 4; ++m) *(u32x4*)(Z + (size_t)(row0 + ai * 128 + m * 16) * 512 + ch) = pk8h(acc[ai][0][m][0] * acc[ai][1][m][0], acc[ai][0][m][1] * acc[ai][1][m][1]);
        }
    }
};
struct EpiOutProj {
    static constexpr bool PERM = false;
    const float* x; float* out; const float* mod;
    __device__ __forceinline__ void operator()(const f32x4 (&acc)[2][2][4][2], const pg8::Unit& u, int wr, int wc, int fr, int fq) const {
        const int row0 = u.pm * 256 + wr * 64 + fr; const int b = (u.pm * 256) >> 12; const int col0 = u.pn * 256 + wc * 32 + 4 * fq;
        f32x4 gv[2][2];
#pragma unroll
        for (int bj = 0; bj < 2; ++bj)
#pragma unroll
            for (int n = 0; n < 2; ++n) gv[bj][n] = *(const f32x4*)(mod + (size_t)b * 6144 + 2048 + col0 + bj * 128 + n * 16);
#pragma unroll
        for (int ai = 0; ai < 2; ++ai)
#pragma unroll
            for (int m = 0; m < 4; ++m) { const size_t off = (size_t)(row0 + ai * 128 + m * 16) * 1024 + col0;
#pragma unroll
                for (int bj = 0; bj < 2; ++bj)
#pragma unroll
                    for (int n = 0; n < 2; ++n) { const f32x4 xv = *(const f32x4*)(x + off + bj * 128 + n * 16); *(f32x4*)(out + off + bj * 128 + n * 16) = xv + gv[bj][n] * acc[ai][bj][m][n]; } }
    }
};
struct EpiMoeUp {
    static constexpr bool PERM = true;
    h16* HID;
    __device__ __forceinline__ void operator()(const f32x4 (&acc)[2][2][4][2], const pg8::Unit& u, int wr, int wc, int fr, int fq) const {
        const int row0 = u.pm * 256 + wr * 64 + fr; const int f0 = 128 * u.pn + 32 * wc + 8 * fq;
#pragma unroll
        for (int ai = 0; ai < 2; ++ai)
#pragma unroll
            for (int m = 0; m < 4; ++m) { f32x4 hv[2];
#pragma unroll
                for (int n = 0; n < 2; ++n) { const f32x4 a = acc[ai][0][m][n], bb = acc[ai][1][m][n];
#pragma unroll
                    for (int i = 0; i < 4; ++i) hv[n][i] = silu_f(a[i]) * bb[i]; }
                *(u32x4*)(HID + (size_t)(row0 + ai * 128 + m * 16) * 256 + f0) = pk8h(hv[0], hv[1]); }
    }
};
struct EpiMoeDown {
    static constexpr bool PERM = true;
    h16* Y;
    __device__ __forceinline__ void operator()(const f32x4 (&acc)[2][2][4][2], const pg8::Unit& u, int wr, int wc, int fr, int fq) const {
        const int row0 = u.pm * 256 + wr * 64 + fr; const int c0 = 256 * u.pn + 32 * wc + 8 * fq;
#pragma unroll
        for (int ai = 0; ai < 2; ++ai)
#pragma unroll
            for (int m = 0; m < 4; ++m) { h16* rowp = Y + (size_t)(row0 + ai * 128 + m * 16) * 1024 + c0;
#pragma unroll
                for (int bj = 0; bj < 2; ++bj) *(u32x4*)(rowp + 128 * bj) = pk8h(acc[ai][bj][m][0], acc[ai][bj][m][1]); }
    }
};

struct Args { const float* in[21]; float* out; unsigned char* ws; int ph_lo, ph_hi; };
struct Frame {
    LAS unsigned char* lds; unsigned char* ldsg;
    int tid, lane, wave, vcu, G;
    const float* const __attribute__((address_space(4)))* in; float* out; unsigned char* ws;
};

#define XB_TMO      128
#define XB_XCNT(j)  (256  + 64 * (j))
#define XB_XSUB(j)  (1280 + 64 * (j))
#define XB_XGEN(j)  (2304 + 64 * (j))
#define XB_TOP      3328
#define XB_TOPGEN   3392
#define XCD_BAR_WORDS 3456
#define XB_SPIN_CAP (1u << 20)
__device__ __forceinline__ unsigned xb_ld(unsigned* p)              { return __hip_atomic_load(p, __ATOMIC_RELAXED, __HIP_MEMORY_SCOPE_AGENT); }
__device__ __forceinline__ unsigned xb_add(unsigned* p, unsigned v) { return __hip_atomic_fetch_add(p, v, __ATOMIC_RELAXED, __HIP_MEMORY_SCOPE_AGENT); }
__device__ __forceinline__ unsigned xb_xcc_id() { return (unsigned)__builtin_amdgcn_s_getreg((3 << 11) | 20) & 0xFu; }
#define XB_SPIN(cond, bar) do { unsigned _sp = 0; while (cond) { __builtin_amdgcn_s_sleep(1); \
    if ((++_sp & 255u) == 0u) { if (xb_ld(&(bar)[XB_TMO])) break; if (_sp > XB_SPIN_CAP) { atomicAdd(&(bar)[XB_TMO], 1u); break; } } } } while (0)
struct XcdBarrier { unsigned* bar; unsigned x; volatile LAS unsigned* st; };
__device__ __forceinline__ XcdBarrier xcd_barrier_post(unsigned* bar, volatile LAS unsigned* st) {
    XcdBarrier b; b.bar = bar; b.x = xb_xcc_id(); b.st = st;
    if (threadIdx.x == 0) (void)xb_add(&bar[XB_XCNT(b.x)], 1u);
    return b;
}
__device__ __forceinline__ void xcd_barrier_complete(unsigned* bar, unsigned x, unsigned& nloc, unsigned& nx) {
    const unsigned G = gridDim.x * gridDim.y * gridDim.z;
    unsigned sum, cnt, mine, sp = 0u;
    for (;;) {
        sum = 0u; cnt = 0u; mine = 0u;
#pragma unroll
        for (unsigned j = 0; j < 16; ++j) { const unsigned c = xb_ld(&bar[XB_XCNT(j)]); sum += c; cnt += (c > 0u) ? 1u : 0u; mine = (j == x) ? c : mine; }
        if (sum == G) break;
        __builtin_amdgcn_s_sleep(1);
        if ((++sp & 255u) == 0u) { if (xb_ld(&bar[XB_TMO])) break; if (sp > XB_SPIN_CAP) { atomicAdd(&bar[XB_TMO], 1u); break; } }
    }
    nloc = mine > 0u ? mine : 1u; nx = cnt > 0u ? cnt : 1u;
}
__device__ __forceinline__ void xcd_barrier(const XcdBarrier& b) {
    asm volatile("s_waitcnt vmcnt(0)" ::: "memory");
    __syncthreads();
    if (threadIdx.x == 0) {
        unsigned* bar = b.bar;
        __builtin_amdgcn_s_waitcnt(0);
        unsigned nloc = b.st[0], nx = b.st[1];
        if (nloc == 0u) { xcd_barrier_complete(bar, b.x, nloc, nx); b.st[0] = nloc; b.st[1] = nx; }
        const unsigned old = xb_add(&bar[XB_XSUB(b.x)], 1u);
        const unsigned gen = old / nloc;
        if (old + 1u == (gen + 1u) * nloc) {
            __builtin_amdgcn_fence(__ATOMIC_RELEASE, "agent");
            asm volatile("s_waitcnt vmcnt(0)" ::: "memory");
            const unsigned og = xb_add(&bar[XB_TOP], 1u);
            const unsigned tg = og / nx;
            if (og + 1u == (tg + 1u) * nx) xb_add(&bar[XB_TOPGEN], 1u);
            else XB_SPIN(xb_ld(&bar[XB_TOPGEN]) == tg, bar);
            __builtin_amdgcn_fence(__ATOMIC_ACQUIRE, "agent");
            xb_add(&bar[XB_XGEN(b.x)], 1u);
            asm volatile("s_waitcnt vmcnt(0)" ::: "memory");
        } else {
            XB_SPIN(xb_ld(&bar[XB_XGEN(b.x)]) == gen, bar);
            __builtin_amdgcn_fence(__ATOMIC_ACQUIRE, "agent");
            asm volatile("s_waitcnt vmcnt(0)" ::: "memory");
        }
    }
    __syncthreads();
}

__device__ __forceinline__ void transpose_item(const float* src, int ldw, int nvalid, int k0, h16* dst, int K, LAS float* scr, int lane) {
    const int c4 = lane & 7, rsub = lane >> 3;
    f32x4 v[8];
#pragma unroll
    for (int i = 0; i < 8; ++i) v[i] = (4 * c4 < nvalid) ? *(const f32x4*)(src + (size_t)(k0 + 8 * i + rsub) * ldw + 4 * c4) : (f32x4){0.f, 0.f, 0.f, 0.f};
#pragma unroll
    for (int i = 0; i < 8; ++i) { LAS float* p = scr + (8 * i + rsub) * 33 + 4 * c4; p[0] = v[i][0]; p[1] = v[i][1]; p[2] = v[i][2]; p[3] = v[i][3]; }
    LDS_WAIT(); asm volatile("" ::: "memory");
    const int c = lane & 7;
#pragma unroll
    for (int j = 0; j < 4; ++j) { const int nn = (lane >> 3) + 8 * j; const LAS float* s = scr + (8 * c) * 33 + nn;
        u32x4 o; o.x = pk2h(s[0 * 33], s[1 * 33]); o.y = pk2h(s[2 * 33], s[3 * 33]); o.z = pk2h(s[4 * 33], s[5 * 33]); o.w = pk2h(s[6 * 33], s[7 * 33]);
        *(u32x4*)(dst + (size_t)nn * K + k0 + 8 * c) = o; }
    LDS_WAIT(); asm volatile("" ::: "memory");
}
__device__ __forceinline__ int win_group_src(int g, int& nvalid) {
    const int tile = g >> 3, p = (g & 7) * 32, bj = p >> 7, wc = (p >> 5) & 3; nvalid = 32;
    if (tile < 8) { const int seg = tile >> 1; return seg * 512 + 64 * (4 * (tile & 1) + wc) + 32 * bj; }
    if (tile == 8) { if (p < 64) return 2048 + p; if (p == 64) { nvalid = 8; return 2112; } nvalid = 0; return 0; }
    if (tile < 11) return 2120 + 256 * (tile - 9) + p;
    return (bj == 0 ? 2632 : 3144) + 128 * (tile - 11) + 32 * wc;
}
__device__ __forceinline__ void p0_prologue(Frame& F) {
    LAS float* scr = (LAS float*)(F.lds + F.wave * 16384);
    const int gw = F.vcu * NWAVES + F.wave, NGW = F.G * NWAVES;
    const float* w_in = F.in[6]; const float* w_out = F.in[12]; const float* w_gate = F.in[18]; const float* w_up = F.in[19]; const float* w_down = F.in[20];
    h16* WINT = (h16*)(F.ws + WS_WINT); h16* WOUTT = (h16*)(F.ws + WS_WOUTT); h16* WGUT = (h16*)(F.ws + WS_WGUT); h16* WDT = (h16*)(F.ws + WS_WDT);
    constexpr int I_IN = 120 * 16, I_OUT = 32 * 16, I_GU = 32 * 16 * 16, I_D = 32 * 32 * 4, I_MOD = 96 * 16;
    constexpr int NITEMS = I_IN + I_OUT + I_GU + I_D + I_MOD;
    for (int it = gw; it < NITEMS; it += NGW) {
        int r = it;
        if (r < I_MOD) {
            const int cc = r % 96, ks = r / 96; const int col = cc * 64 + F.lane, k0 = ks * 64;
            const float* c = F.in[1]; const float* w_ada = F.in[3];
            float ca[8];
#pragma unroll
            for (int b = 0; b < 8; ++b) ca[b] = silu_f(c[b * 1024 + k0 + F.lane]);
            float a[8] = {0.f, 0.f, 0.f, 0.f, 0.f, 0.f, 0.f, 0.f};
#pragma unroll 8
            for (int kk = 0; kk < 64; ++kk) { const float w = w_ada[(size_t)(k0 + kk) * 6144 + col];
#pragma unroll
                for (int b = 0; b < 8; ++b) a[b] += __builtin_bit_cast(float, __builtin_amdgcn_readlane(__builtin_bit_cast(int, ca[b]), kk)) * w; }
            float* mp = (float*)(F.ws + WS_MODP) + (size_t)ks * 8 * 6144;
#pragma unroll
            for (int b = 0; b < 8; ++b) mp[b * 6144 + col] = a[b];
            continue;
        }
        r -= I_MOD;
        if (r < I_IN) { const int g = r >> 4, kb = r & 15; int nv; const int s0 = win_group_src(g, nv); transpose_item(w_in + s0, 3656, nv, kb * 64, WINT + (size_t)g * 32 * 1024, 1024, scr, F.lane); continue; } r -= I_IN;
        if (r < I_OUT) { const int g = r >> 4, kb = r & 15; transpose_item(w_out + g * 32, 1024, 32, kb * 64, WOUTT + (size_t)g * 32 * 1024, 1024, scr, F.lane); continue; } r -= I_OUT;
        if (r < I_GU) { const int e = r >> 8, g = (r >> 4) & 15, kb = r & 15; const int p = g * 32, t2 = p >> 8, bj = (p >> 7) & 1, wc = (p >> 5) & 3; const int f = 128 * t2 + 32 * wc;
            transpose_item((bj == 0 ? w_gate : w_up) + (size_t)e * 1024 * 256 + f, 256, 32, kb * 64, WGUT + ((size_t)e * 512 + p) * 1024, 1024, scr, F.lane); continue; } r -= I_GU;
        { const int e = r >> 7, g = (r >> 2) & 31, kb = r & 3; transpose_item(w_down + (size_t)e * 256 * 1024 + g * 32, 1024, 32, kb * 64, WDT + ((size_t)e * 1024 + g * 32) * 256, 256, scr, F.lane); }
    }
    { const float* wgr = F.in[14]; const float* wer = F.in[16]; h16* WRL = (h16*)(F.ws + WS_WRL);
      for (int idx = F.vcu * NTHR + F.tid; idx < 36 * 1024; idx += F.G * NTHR) { const int o = idx >> 10, rem = idx & 1023, ln = rem >> 4, ji = rem & 15, col = 4 * ln + 256 * (ji >> 2) + (ji & 3);
          WRL[idx] = (h16)(o < 4 ? wgr[col * 4 + o] : wer[col * 32 + (o - 4)]); } }
}

__device__ __forceinline__ void p1_norm1(Frame& F) {
    const float* modp = (const float*)(F.ws + WS_MODP); float* mod = (float*)(F.ws + WS_MOD); const float* b_ada = F.in[4];
    LAS float* sh = (LAS float*)F.lds; LAS float* sc = sh + 1024;
    const int b = F.vcu >> 5;
    for (int i = F.tid; i < 2048; i += NTHR) { float s = b_ada[i];
#pragma unroll
        for (int ks = 0; ks < 16; ++ks) s += modp[((size_t)ks * 8 + b) * 6144 + i];
        sh[i] = s; }
    if (F.tid < 192) { const int idx = F.vcu * 192 + F.tid; const int bb = idx / 6144, cc = idx % 6144; float s = b_ada[cc];
#pragma unroll
        for (int ks = 0; ks < 16; ++ks) s += modp[((size_t)ks * 8 + bb) * 6144 + cc];
        mod[idx] = s; }
    __syncthreads();
    const float* x = F.in[0]; const float* g1 = F.in[5]; h16* H = (h16*)(F.ws + WS_H);
    f32x4 gg[4], s1[4], h1[4];
#pragma unroll
    for (int j = 0; j < 4; ++j) { const int col = 4 * F.lane + 256 * j; gg[j] = *(const f32x4*)(g1 + col); h1[j] = *(const LAS f32x4*)(sh + col); s1[j] = *(const LAS f32x4*)(sc + col);
        gg[j] = gg[j] * (s1[j] + 1.f); }
    f32x4 vn[4];
    { const size_t row = (size_t)F.vcu * 128 + F.wave * 16;
#pragma unroll
      for (int j = 0; j < 4; ++j) vn[j] = *(const f32x4*)(x + row * 1024 + 4 * F.lane + 256 * j); }
    for (int rr = 0; rr < 16; ++rr) {
        const size_t row = (size_t)F.vcu * 128 + F.wave * 16 + rr; const size_t rown = row + (rr < 15 ? 1 : 0);
        f32x4 v[4]; float ss = 0.f;
#pragma unroll
        for (int j = 0; j < 4; ++j) { v[j] = vn[j]; vn[j] = *(const f32x4*)(x + rown * 1024 + 4 * F.lane + 256 * j); ss += (v[j][0] * v[j][0] + v[j][1] * v[j][1]) + (v[j][2] * v[j][2] + v[j][3] * v[j][3]); }
        const float rstd = rsqrtf(dpp_sum_f32(ss) * (1.f / 1024.f) + EPS);
#pragma unroll
        for (int j = 0; j < 4; ++j) { const f32x4 o = v[j] * rstd * gg[j] + h1[j]; u32x2 w; w.x = pk2h(o[0], o[1]); w.y = pk2h(o[2], o[3]); *(u32x2*)(H + row * 1024 + 4 * F.lane + 256 * j) = w; }
    }
}

__device__ __forceinline__ void p3_conv(Frame& F) {
    const h16* Z = (const h16*)(F.ws + WS_Z); const h16* GB = (const h16*)(F.ws + WS_GB); h16* MG = (h16*)(F.ws + WS_MERGED);
    const float* cw = F.in[9]; const float* cn = F.in[11];
    const int gw = F.vcu * NWAVES + F.wave, NGW = F.G * NWAVES; const int ch = 8 * F.lane;
    float w0[8], w1[8], w2[8], gn[8];
#pragma unroll
    for (int i = 0; i < 8; ++i) { w0[i] = cw[ch + i]; w1[i] = cw[512 + ch + i]; w2[i] = cw[1024 + ch + i]; gn[i] = cn[ch + i]; }
    for (int it = gw; it < M / 32; it += NGW) {
        const int t0 = it * 32; const bool first = (t0 & (SEQ - 1)) == 0;
        f16x8 zm2 = {}, zm1 = {};
        if (!first) { zm2 = *(const f16x8*)(Z + (size_t)(t0 - 2) * 512 + ch); zm1 = *(const f16x8*)(Z + (size_t)(t0 - 1) * 512 + ch); }
        for (int tt = 0; tt < 32; ++tt) {
            const size_t t = (size_t)t0 + tt;
            const f16x8 z0 = *(const f16x8*)(Z + t * 512 + ch); const f16x8 gb = *(const f16x8*)(GB + t * 512 + ch);
            float y[8]; float ss = 0.f;
#pragma unroll
            for (int i = 0; i < 8; ++i) { y[i] = (float)gb[i] * (w0[i] * (float)zm2[i] + w1[i] * (float)zm1[i] + w2[i] * (float)z0[i]); ss += y[i] * y[i]; }
            ss += __shfl_xor(ss, 1); ss += __shfl_xor(ss, 2); ss += __shfl_xor(ss, 4);
            const float rstd = rsqrtf(ss * (1.f / 64.f) + EPS);
            u32x4 o; o.x = pk2h(y[0] * rstd * gn[0], y[1] * rstd * gn[1]); o.y = pk2h(y[2] * rstd * gn[2], y[3] * rstd * gn[3]); o.z = pk2h(y[4] * rstd * gn[4], y[5] * rstd * gn[5]); o.w = pk2h(y[6] * rstd * gn[6], y[7] * rstd * gn[7]);
            *(u32x4*)(MG + t * 1024 + 512 + ch) = o;
            zm2 = zm1; zm1 = z0;
        }
    }
}

constexpr int IX_ROW = 4352, IX_NEG = 8 * IX_ROW * 4, IX_BM = IX_NEG + 256, IX_ST = IX_BM + 4096;
__device__ __forceinline__ unsigned fkey(float f) { const unsigned u = __builtin_bit_cast(unsigned, f); return u ^ ((u >> 31) ? 0xFFFFFFFFu : 0x80000000u); }
__device__ __forceinline__ float fkey_inv(unsigned k) { const unsigned u = (k >> 31) ? (k ^ 0x80000000u) : ~k; return __builtin_bit_cast(float, u); }
__device__ __forceinline__ float probit_lo(float p) {
    if (p < 0.02425f) { const float q = sqrtf(-2.f * __logf(p));
        return (((((-7.784894002430293e-03f * q - 3.223964580411365e-01f) * q - 2.400758277161838e+00f) * q - 2.549732539343734e+00f) * q + 4.374664141464968e+00f) * q + 2.938163982698783e+00f) /
               ((((7.784695709041462e-03f * q + 3.224671290700398e-01f) * q + 2.445134137142996e+00f) * q + 3.754408661907416e+00f) * q + 1.f); }
    const float q = p - 0.5f, r = q * q;
    return (((((-3.969683028665376e+01f * r + 2.209460984245205e+02f) * r - 2.759285104469687e+02f) * r + 1.383577518672690e+02f) * r - 3.066479806614716e+01f) * r + 2.506628277459239e+00f) * q /
           (((((-5.447609879822406e+01f * r + 1.615858368580409e+02f) * r - 1.556989798598866e+02f) * r + 6.680131188771972e+01f) * r - 1.328068155288572e+01f) * r + 1.f);
}
__device__ __forceinline__ void row_sum2(float v, float& h0, float& h1) {
    v += __builtin_bit_cast(float, __builtin_amdgcn_update_dpp(0, __builtin_bit_cast(int, v), 0xB1, 0xf, 0xf, false));
    v += __builtin_bit_cast(float, __builtin_amdgcn_update_dpp(0, __builtin_bit_cast(int, v), 0x4E, 0xf, 0xf, false));
    v += __builtin_bit_cast(float, __builtin_amdgcn_update_dpp(0, __builtin_bit_cast(int, v), 0x141, 0xf, 0xf, false));
    v += __builtin_bit_cast(float, __builtin_amdgcn_update_dpp(0, __builtin_bit_cast(int, v), 0x140, 0xf, 0xf, false));
    h0 = __builtin_bit_cast(float, __builtin_amdgcn_readlane(__builtin_bit_cast(int, v), 0)) + __builtin_bit_cast(float, __builtin_amdgcn_readlane(__builtin_bit_cast(int, v), 16));
    h1 = __builtin_bit_cast(float, __builtin_amdgcn_readlane(__builtin_bit_cast(int, v), 32)) + __builtin_bit_cast(float, __builtin_amdgcn_readlane(__builtin_bit_cast(int, v), 48));
}
__device__ __forceinline__ unsigned eval_mask(const float (&v)[64], float x, unsigned& a, unsigned& b) {
    unsigned ma = 0u, mb = 0u;
#pragma unroll
    for (int i = 31; i >= 0; --i) { ma = __builtin_amdgcn_alignbit(ma, __builtin_bit_cast(unsigned, v[i] - x), 31); mb = __builtin_amdgcn_alignbit(mb, __builtin_bit_cast(unsigned, v[32 + i] - x), 31); }
    a = ma; b = mb;
    return dpp_sum_u32(64u - (unsigned)__builtin_popcount(ma) - (unsigned)__builtin_popcount(mb));
}
__device__ __forceinline__ float probit(float p) { return p > 0.5f ? -probit_lo(1.f - p) : probit_lo(p); }
__device__ __forceinline__ unsigned count_ge(const float (&v)[64], float x) {
    unsigned c = 0;
#pragma unroll
    for (int i = 0; i < 64; ++i) c += (v[i] >= x) ? 1u : 0u;
    return dpp_sum_u32(c);
}
__device__ __forceinline__ float relu_i(float x) { const int i = __builtin_bit_cast(int, x); return __builtin_bit_cast(float, i > 0 ? i : 0); }
constexpr int IX_CTR = IX_ST + 512;
__device__ __forceinline__ void p3_indexer(Frame& F) {
    const h16* QI = (const h16*)(F.ws + WS_QI); const h16* KI = (const h16*)(F.ws + WS_KI); const float* WI = (const float*)(F.ws + WS_WI); u64* BM = (u64*)(F.ws + WS_BM);
    LAS float* sc = (LAS float*)F.lds;
    LAS float* st = (LAS float*)(F.lds + IX_ST);
    LAS unsigned* ctr = (LAS unsigned*)(F.lds + IX_CTR);
    const int lane = F.lane, wid = F.wave, r32 = lane & 31, hi = lane >> 5;
    if (F.tid < 64) ((LAS float*)(F.lds + IX_NEG))[F.tid] = -__builtin_inff();
    if (F.tid < 2) ctr[F.tid] = 0u;
    __syncthreads();
    const int hq = (r32 >> 2) & 1, rr = (r32 & 3) + 4 * (r32 >> 3), jq = 2 * hq + (rr >> 3), hh = rr & 7;
    f16x8 af[2][4]; f32x4 wraw[2][2][2];
#define IX_QLOAD(u_) do { const int idx_ = (u_) * 256 + (((u_) & 1) ? (255 - F.vcu) : F.vcu); const size_t rb_ = (size_t)(idx_ & 7) * SEQ + (size_t)(idx_ >> 3) * 8; \
        _Pragma("unroll") for (int rb = 0; rb < 2; ++rb) { const h16* qp = QI + (rb_ + 4 * rb + jq) * 512 + hh * 64 + hi * 8; \
            _Pragma("unroll") for (int ks = 0; ks < 4; ++ks) af[rb][ks] = *(const f16x8*)(qp + ks * 16); \
            _Pragma("unroll") for (int j2 = 0; j2 < 2; ++j2) { const float* wp = WI + (rb_ + 4 * rb + 2 * hi + j2) * 8; wraw[rb][j2][0] = *(const f32x4*)wp; wraw[rb][j2][1] = *(const f32x4*)(wp + 4); } } } while (0)
    IX_QLOAD(0);
    for (int u = 0; u < 16; ++u) {
        const int idx = u * 256 + ((u & 1) ? (255 - F.vcu) : F.vcu);
        const int b = idx & 7, t0 = (idx >> 3) * 8;
        const size_t rowb = (size_t)b * SEQ;
        const int nj = (t0 + 8 + 63) >> 6;
        {
            float wv[2][16];
#pragma unroll
            for (int rb = 0; rb < 2; ++rb)
#pragma unroll
                for (int j2 = 0; j2 < 2; ++j2)
#pragma unroll
                    for (int i = 0; i < 4; ++i) { wv[rb][8 * j2 + i] = wraw[rb][j2][0][i] * IDX_SCALE; wv[rb][8 * j2 + 4 + i] = wraw[rb][j2][1][i] * IDX_SCALE; }
            float ssum[2][2] = {{0.f, 0.f}, {0.f, 0.f}}, ssq[2][2] = {{0.f, 0.f}, {0.f, 0.f}};
            const h16* kbase = KI + (size_t)b * (128 * 2048) + lane * 8;
#define IX_TICKET(t_) do { asm volatile("ds_add_rtn_u32 %0, %1, %2" : "=v"(t_) : "v"(ctr_addr + 4u * (unsigned)(u & 1)), "v"(1u) : "memory"); } while (0)
#define IX_TGET(t_) ({ int g_; asm volatile("s_waitcnt lgkmcnt(0)\n\tv_readfirstlane_b32 %0, %1" : "=s"(g_) : "v"(t_) : "memory"); g_ >> 6; })
#define IX_LOAD(dst, g_) do { const int gg_ = (g_) < nj ? (g_) : nj - 1; _Pragma("unroll") for (int q = 0; q < 2; ++q) { const h16* kp = kbase + (size_t)(2 * gg_ + q) * 2048; \
                _Pragma("unroll") for (int ks = 0; ks < 4; ++ks) dst[q][ks] = *(const f16x8*)(kp + ks * 512); } } while (0)
#define IX_MMA(x0, x1, kt) do { x0 = f32x16{}; x1 = f32x16{}; \
                _Pragma("unroll") for (int ks = 0; ks < 4; ++ks) { x0 = __builtin_amdgcn_mfma_f32_32x32x16_f16(af[0][ks], kt[ks], x0, 0, 0, 0); x1 = __builtin_amdgcn_mfma_f32_32x32x16_f16(af[1][ks], kt[ks], x1, 0, 0, 0); } } while (0)
#define IX_VAL(x0, x1, tile_, DIAG) do { const int tile = (tile_); const int key = tile * 32 + r32; const int pos = key + 4 * (key >> 6); \
                _Pragma("unroll") for (int rb = 0; rb < 2; ++rb) { float s0 = 0.f, s1 = 0.f; \
                    _Pragma("unroll") for (int r = 0; r < 8; ++r) { const float d0 = rb ? x1[r] : x0[r], d1 = rb ? x1[8 + r] : x0[8 + r]; \
                        s0 = __builtin_fmaf(relu_i(d0), wv[rb][r], s0); s1 = __builtin_fmaf(relu_i(d1), wv[rb][8 + r], s1); } \
                    float z0 = s0, z1 = s1; \
                    if (DIAG) { if (tile * 32 + 31 > t0) { const int tq = t0 + 4 * rb + 2 * hi; const bool v0 = key <= tq, v1 = key <= tq + 1; z0 = v0 ? s0 : 0.f; z1 = v1 ? s1 : 0.f; s0 = v0 ? s0 : -__builtin_inff(); s1 = v1 ? s1 : -__builtin_inff(); } } \
                    ssum[rb][0] += z0; ssq[rb][0] = __builtin_fmaf(z0, z0, ssq[rb][0]); ssum[rb][1] += z1; ssq[rb][1] = __builtin_fmaf(z1, z1, ssq[rb][1]); \
                    sc[(4 * rb + 2 * hi) * IX_ROW + pos] = s0; sc[(4 * rb + 2 * hi + 1) * IX_ROW + pos] = s1; } } while (0)
            const int nf = nj - 1;
            const unsigned ctr_addr = (unsigned)(size_t)ctr;
            f16x8 kA[2][4], kB[2][4]; f32x16 a0, a1, b0, b1;
            unsigned tk; IX_TICKET(tk); int g0 = IX_TGET(tk), g1, gl = g0; bool lastInA = true;
            IX_LOAD(kA, g0);
            if (g0 < nf) {
                IX_TICKET(tk); g1 = IX_TGET(tk); IX_LOAD(kB, g1);
                IX_MMA(a0, a1, kA[0]);
                for (;;) {
                    IX_TICKET(tk);
                    IX_MMA(b0, b1, kA[1]); IX_VAL(a0, a1, 2 * g0, false);
                    IX_MMA(a0, a1, kB[0]); IX_VAL(b0, b1, 2 * g0 + 1, false);
                    const int g2 = IX_TGET(tk);
                    if (g1 >= nf) { gl = g1; lastInA = false; break; }
                    IX_LOAD(kA, g2);
                    IX_TICKET(tk);
                    IX_MMA(b0, b1, kB[1]); IX_VAL(a0, a1, 2 * g1, false);
                    IX_MMA(a0, a1, kA[0]); IX_VAL(b0, b1, 2 * g1 + 1, false);
                    g0 = g2; g1 = IX_TGET(tk);
                    if (g0 >= nf) { gl = g0; lastInA = true; break; }
                    IX_LOAD(kB, g1);
                }
            }
            if (gl == nf) {
                if (lastInA) { IX_MMA(a0, a1, kA[0]); IX_VAL(a0, a1, 2 * nf, true); IX_MMA(b0, b1, kA[1]); IX_VAL(b0, b1, 2 * nf + 1, true); }
                else         { IX_MMA(a0, a1, kB[0]); IX_VAL(a0, a1, 2 * nf, true); IX_MMA(b0, b1, kB[1]); IX_VAL(b0, b1, 2 * nf + 1, true); }
            }
#undef IX_TICKET
#undef IX_TGET
#undef IX_LOAD
#undef IX_MMA
#undef IX_VAL
#pragma unroll
            for (int rb = 0; rb < 2; ++rb)
#pragma unroll
                for (int j2 = 0; j2 < 2; ++j2) { float s0_, s1_, q0_, q1_; row_sum2(ssum[rb][j2], s0_, s1_); row_sum2(ssq[rb][j2], q0_, q1_);
                    if (lane == 0) { LAS float* sp = st + wid * 16 + (4 * rb + j2) * 2; sp[0] = s0_; sp[1] = q0_; sp[4] = s1_; sp[5] = q1_; } }
            IX_QLOAD(u < 15 ? u + 1 : 15);
        }
        __syncthreads();
        if (F.tid == 0) ctr[(u + 1) & 1] = 0u;
        const int t = t0 + wid, n = t + 1;
        float v[64]; float ssum_ = 0.f, ssq_ = 0.f;
        if (n > 256) {
            const LAS float* cp = (lane < nj) ? (sc + wid * IX_ROW + lane * 68) : (const LAS float*)(F.lds + IX_NEG);
#pragma unroll
            for (int i = 0; i < 16; ++i) { const f32x4 x = *(const LAS f32x4*)(cp + 4 * i); v[4 * i] = x[0]; v[4 * i + 1] = x[1]; v[4 * i + 2] = x[2]; v[4 * i + 3] = x[3]; }
#pragma unroll
            for (int w = 0; w < NWAVES; ++w) { ssum_ += st[w * 16 + wid * 2]; ssq_ += st[w * 16 + wid * 2 + 1]; }
        } else {
#pragma unroll
            for (int i = 0; i < 64; ++i) v[i] = 0.f;
        }
        __syncthreads();
        unsigned mlo = 0u, mhi = 0u;
        if (n <= 256) {
            const int rem = n - 64 * lane;
            if (rem > 0) { mlo = rem >= 32 ? 0xFFFFFFFFu : ((1u << rem) - 1u); mhi = rem >= 64 ? 0xFFFFFFFFu : (rem > 32 ? ((1u << (rem - 32)) - 1u) : 0u); }
        } else {
            const float fn = (float)n, mean = ssum_ / fn; const float var = fmaxf(ssq_ / fn - mean * mean, 1e-20f), sd = sqrtf(var);
            const float zq = -probit(256.f / fn);
            const float dens = fmaxf(fn * 0.3989423f * __expf(-0.5f * zq * zq) / sd, 1e-3f);
            float xl = -3.0e38f, xh = __builtin_inff(), cl = fn, ch = 0.f; bool hasL = false, hasH = false; int side = 0, zst = 0;
            float x = mean + fminf(fmaxf(zq, -6.f), 6.f) * sd, step = 0.f; unsigned na = 0u, nb = 0u;
            float tie_v = 0.f; int tie_need = 0;
            const float DMIN = __builtin_bit_cast(float, 1u);
            int it = 0;
            for (;;) {
                ++it;
                unsigned kx = fkey(x); const unsigned kl = fkey(xl), kh = fkey(xh);
                if (!(kx > kl && kx < kh)) kx = kl + ((kh - kl) >> 1);
                x = fkey_inv(kx);
                const unsigned c = eval_mask(v, x, na, nb);
                if (c == 256u) break;
                if (c > 256u) { xl = x; cl = (float)c; hasL = true; if (side == 1) ch = 256.f + 0.5f * (ch - 256.f); side = 1; }
                else          { xh = x; ch = (float)c; hasH = true; if (side == 2) cl = 256.f + 0.5f * (cl - 256.f); side = 2; }
                const unsigned kl2 = fkey(xl), kh2 = fkey(xh);
                if (kh2 - kl2 <= 1u) {
                    const unsigned chx = eval_mask(v, xh, na, nb); tie_v = xl; tie_need = 256 - (int)chx; break; }
                if (!(hasL && hasH)) { step = (step == 0.f) ? fminf(fabsf((float)c - 256.5f) / dens * 1.25f + 0.02f * sd, 2.f * sd) : 2.f * step; x = (c > 256u) ? x + step : x - step; }
                else if (zst == 0 && it >= 2 && xl <= 0.f && xh > DMIN) { zst = 1; x = DMIN; }
                else if (zst == 1 && xh == DMIN && xl < 0.f) { zst = 2; x = 0.f; }
                else if (it >= 8 && (it & 1)) x = fkey_inv(kl2 + ((kh2 - kl2) >> 1));
                else x = xl + (xh - xl) * ((cl - 256.5f) / (cl - ch));
            }
            mlo = ~na; mhi = ~nb;
            if (tie_need > 0) {
                unsigned ce = 0;
#pragma unroll
                for (int i = 0; i < 64; ++i) ce += (v[i] == tie_v) ? 1u : 0u;
                unsigned pre = ce;
#pragma unroll
                for (int o = 1; o < 64; o <<= 1) { const unsigned y = __shfl_up(pre, o); pre += (lane >= o) ? y : 0u; }
                int allow = tie_need - (int)(pre - ce); allow = allow < 0 ? 0 : allow;
#pragma unroll
                for (int i = 0; i < 64; ++i) { if (v[i] == tie_v && allow > 0) { if (i < 32) mlo |= 1u << i; else mhi |= 1u << (i - 32); --allow; } }
            }
        }
        if (lane <= 4 * (t0 >> 8) + 3) BM[((size_t)b * 64 + lane) * 4096 + t] = ((u64)mhi << 32) | mlo;
    }
    __syncthreads();
}

constexpr int AL_K = 0, AL_V = 16384, AL_M = 32768, AL_LUT = 36864, AL_WS = 37888, AL_OST = 40960;
constexpr int OST_STRIDE = 68;
__device__ __forceinline__ float sel_bfi(unsigned m, unsigned a, unsigned b) { unsigned d; asm("v_bfi_b32 %0, %1, %2, %3" : "=v"(d) : "v"(m), "v"(a), "s"(b)); return __builtin_bit_cast(float, d); }
__device__ __forceinline__ int crow(int r, int hi) { return (r & 3) + 8 * (r >> 2) + 4 * hi; }
__device__ __forceinline__ void attn_unit(Frame& F, int b, int h, int qb) {
    const h16* Q = (const h16*)(F.ws + WS_Q); const h16* Kg = (const h16*)(F.ws + WS_K); const h16* Vg = (const h16*)(F.ws + WS_V); const u64* BM = (const u64*)(F.ws + WS_BM);
    h16* MG = (h16*)(F.ws + WS_MERGED);
    const int tid = F.tid, lane = F.lane, wid = F.wave, r32 = lane & 31, hi = lane >> 5, grp = wid >> 2;
    const size_t rowb = (size_t)b * SEQ; const int q0 = qb * 256;
    LAS unsigned char* L = F.lds;
    LAS float* lut = (LAS float*)(L + AL_LUT); LAS float* wsf = (LAS float*)(L + AL_WS) + wid * 64; LAS float* ost = (LAS float*)(L + AL_OST) + wid * (32 * OST_STRIDE);
    if (tid < 129) lut[tid] = F.in[2][T5_BKT[tid] * 8 + h] * LOG2E;
    const float cfar = F.in[2][31 * 8 + h] * LOG2E;
    const int NT = (q0 + 256) / 64;
    const h16* ksrc = Kg + (size_t)(b * 8 + h) * 64 * 4096 + wid * 512 + lane * 8;
    const h16* vsrc = Vg + (size_t)(b * 8 + h) * 64 * 4096 + wid * 512 + lane * 8;
    const u64* msrc = BM + (size_t)b * 64 * 4096 + q0 + wid * 32 + r32;
    u32x4 kreg, vreg;
#define A_LOAD(t) do { kreg = *(const u32x4*)(ksrc + (size_t)(t) * 4096); vreg = *(const u32x4*)(vsrc + (size_t)(t) * 4096); } while (0)
#define A_STORE(buf) do { *(LAS u32x4*)(L + AL_K + (buf) * 8192 + wid * 1024 + lane * 16) = kreg; *(LAS u32x4*)(L + AL_V + (buf) * 8192 + wid * 1024 + lane * 16) = vreg; } while (0)
#define A_BAR() asm volatile("s_barrier" ::: "memory")
    const int qpos = q0 + wid * 32 + r32;
    const int qmin = q0 + wid * 32;
    const unsigned NEGINF = 0xFF800000u;
    float mref = 0.f, lrun = 0.f; bool hasmass = false; f32x16 o[2]; o[0] = f32x16{}; o[1] = f32x16{};
    f32x16 p0, p1;
#define A_COP(t_, mw_) do { const unsigned wl = (unsigned)(mw_) >> (4 * hi), wh = (unsigned)((mw_) >> 32) >> (4 * hi); \
        if ((qmin - (64 * (t_) + 63)) >= 128) { const unsigned cb = __builtin_bit_cast(unsigned, cfar - mref); \
            _Pragma("unroll") for (int r = 0; r < 16; ++r) { const int c = (r & 3) + 8 * (r >> 2); const unsigned s0 = (unsigned)__builtin_amdgcn_sbfe((int)wl, c, 1), s1 = (unsigned)__builtin_amdgcn_sbfe((int)wh, c, 1); \
                p0[r] = sel_bfi(s0, cb, NEGINF); p1[r] = sel_bfi(s1, cb, NEGINF); } \
        } else { const int base = qpos - 64 * (t_) - 4 * hi; \
            _Pragma("unroll") for (int r = 0; r < 16; ++r) { const int c = (r & 3) + 8 * (r >> 2); int i0 = base - c, i1 = base - c - 32; i0 = i0 < 0 ? 0 : (i0 > 128 ? 128 : i0); i1 = i1 < 0 ? 0 : (i1 > 128 ? 128 : i1); \
                const unsigned s0 = (unsigned)__builtin_amdgcn_sbfe((int)wl, c, 1), s1 = (unsigned)__builtin_amdgcn_sbfe((int)wh, c, 1); \
                const unsigned c0 = __builtin_bit_cast(unsigned, lut[i0] - mref), c1 = __builtin_bit_cast(unsigned, lut[i1] - mref); \
                p0[r] = sel_bfi(s0, c0, NEGINF); p1[r] = sel_bfi(s1, c1, NEGINF); } } } while (0)
    u64 mw, mwn;
    { const u32x4 k0r = *(const u32x4*)ksrc, v0r = *(const u32x4*)vsrc;
      A_LOAD(1); mw = msrc[0]; mwn = msrc[4096];
      *(LAS u32x4*)(L + AL_K + wid * 1024 + lane * 16) = k0r; *(LAS u32x4*)(L + AL_V + wid * 1024 + lane * 16) = v0r; }
    f16x8 qr[4];
    { const h16* qp = Q + (rowb + q0 + wid * 32 + r32) * 512 + h * 64 + hi * 8;
#pragma unroll
      for (int d0 = 0; d0 < 4; ++d0) qr[d0] = *(const f16x8*)(qp + d0 * 16); }
    __syncthreads();
    if (grp == 1) A_BAR();
    A_COP(0, mw); mw = mwn;
    const int vboff = ((lane >> 4) & 1) * 32 + (lane & 3) * 8 + (4 * hi + ((lane & 15) >> 2)) * 64;
    for (int t = 0; t < NT; ++t) {
        const int cur = t & 1;
        f16x8 kfr[8];
        { const LAS unsigned char* kb = L + AL_K + cur * 8192 + hi * 1024 + r32 * 16;
#pragma unroll
          for (int d0 = 0; d0 < 4; ++d0) { kfr[2 * d0] = *(const LAS f16x8*)(kb + d0 * 2048); kfr[2 * d0 + 1] = *(const LAS f16x8*)(kb + d0 * 2048 + 512); } }
        A_STORE(cur ^ 1);
        { const int tl = (t + 2 < NT) ? t + 2 : NT - 1; A_LOAD(tl); mwn = msrc[(size_t)tl * 4096]; }
        s16x4 vlo[8], vhi[8];
        { LAS unsigned char* vb = L + AL_V + cur * 8192 + vboff;
#pragma unroll
          for (int i = 0; i < 8; ++i) { vlo[i] = __builtin_amdgcn_ds_read_tr16_b64_v4i16((LAS s16x4*)(vb + (i >> 2) * 4096 + (i & 3) * 1024)); vhi[i] = __builtin_amdgcn_ds_read_tr16_b64_v4i16((LAS s16x4*)(vb + (i >> 2) * 4096 + (i & 3) * 1024 + 512)); } }
        __builtin_amdgcn_sched_barrier(0);
#pragma unroll
        for (int d0 = 0; d0 < 4; ++d0) { p0 = __builtin_amdgcn_mfma_f32_32x32x16_f16(kfr[2 * d0], qr[d0], p0, 0, 0, 0); p1 = __builtin_amdgcn_mfma_f32_32x32x16_f16(kfr[2 * d0 + 1], qr[d0], p1, 0, 0, 0); }
        __builtin_amdgcn_sched_barrier(0);
        asm volatile("s_waitcnt lgkmcnt(0)\n\ts_barrier" ::: "memory");
        __builtin_amdgcn_sched_barrier(0);
        float rs = 0.f;
#pragma unroll
        for (int r = 0; r < 16; ++r) { p0[r] = __builtin_amdgcn_exp2f(p0[r]); p1[r] = __builtin_amdgcn_exp2f(p1[r]); rs += p0[r] + p1[r]; }
        const float pm = rs + __shfl_xor(rs, 32);
        const bool need = (pm > 256.f) || (!hasmass && pm > 0.f);
        if (__any(need)) {
            const float f = need ? 1.f / pm : 1.f;
            mref += need ? __builtin_amdgcn_logf(pm) : 0.f;
            rs *= f; lrun *= f;
#pragma unroll
            for (int r = 0; r < 16; ++r) { float a_ = p0[r], b_ = p1[r]; asm("v_mul_f32 %0, %0, %1" : "+v"(a_) : "v"(f)); asm("v_mul_f32 %0, %0, %1" : "+v"(b_) : "v"(f)); p0[r] = a_; p1[r] = b_; }
            if (hi == 0) wsf[r32] = f;
            LDS_WAIT();
#pragma unroll
            for (int r = 0; r < 16; ++r) { const float a = wsf[crow(r, hi)]; o[0][r] *= a; o[1][r] *= a; }
        }
        hasmass = hasmass || (pm > 0.f);
        lrun += rs;
        u32x4 pw[4];
        pw[0] = (u32x4){pk2h(p0[0], p0[1]), pk2h(p0[2], p0[3]), pk2h(p0[4], p0[5]), pk2h(p0[6], p0[7])};
        pw[1] = (u32x4){pk2h(p0[8], p0[9]), pk2h(p0[10], p0[11]), pk2h(p0[12], p0[13]), pk2h(p0[14], p0[15])};
        pw[2] = (u32x4){pk2h(p1[0], p1[1]), pk2h(p1[2], p1[3]), pk2h(p1[4], p1[5]), pk2h(p1[6], p1[7])};
        pw[3] = (u32x4){pk2h(p1[8], p1[9]), pk2h(p1[10], p1[11]), pk2h(p1[12], p1[13]), pk2h(p1[14], p1[15])};
        __builtin_amdgcn_sched_barrier(0);
#pragma unroll
        for (int d0 = 0; d0 < 2; ++d0)
#pragma unroll
            for (int ks = 0; ks < 4; ++ks) { const int i = d0 * 4 + ks;
                typedef short s16x8 __attribute__((ext_vector_type(8)));
                const s16x8 vv = {vlo[i][0], vlo[i][1], vlo[i][2], vlo[i][3], vhi[i][0], vhi[i][1], vhi[i][2], vhi[i][3]};
                o[d0] = __builtin_amdgcn_mfma_f32_32x32x16_f16(__builtin_bit_cast(f16x8, pw[ks]), __builtin_bit_cast(f16x8, vv), o[d0], 0, 0, 0); }
        A_COP(t + 1, mw); mw = mwn;
        A_BAR();
    }
    if (grp == 0) A_BAR();
#undef A_LOAD
#undef A_STORE
#undef A_BAR
#undef A_COP
    lrun += __shfl_xor(lrun, 32);
    if (hi == 0) wsf[r32] = 1.f / lrun;
    LDS_WAIT();
#pragma unroll
    for (int r = 0; r < 16; ++r) { const float rl = wsf[crow(r, hi)]; const int qrow = crow(r, hi);
        ost[qrow * OST_STRIDE + r32] = o[0][r] * rl; ost[qrow * OST_STRIDE + 32 + r32] = o[1][r] * rl; }
    LDS_WAIT();
    { const int row = lane >> 1, hf = lane & 1; const LAS float* rp = ost + row * OST_STRIDE + hf * 32;
      f32x4 xv[8]; float ss = 0.f;
#pragma unroll
      for (int i = 0; i < 8; ++i) { xv[i] = *(const LAS f32x4*)(rp + 4 * i); ss += (xv[i][0] * xv[i][0] + xv[i][1] * xv[i][1]) + (xv[i][2] * xv[i][2] + xv[i][3] * xv[i][3]); }
      ss += __shfl_xor(ss, 1);
      const float rstd = rsqrtf(ss * (1.f / 64.f) + EPS);
      const float* gn = F.in[10] + h * 64 + hf * 32;
      h16* op = MG + (rowb + q0 + wid * 32 + row) * 1024 + h * 64 + hf * 32;
#pragma unroll
      for (int i = 0; i < 4; ++i) { const f32x4 g0 = *(const f32x4*)(gn + 8 * i), g1 = *(const f32x4*)(gn + 8 * i + 4);
          *(u32x4*)(op + 8 * i) = pk8h(xv[2 * i] * rstd * g0, xv[2 * i + 1] * rstd * g1); } }
    __syncthreads();
}
__device__ __forceinline__ void p4_attention(Frame& F) {
    const int bh = F.vcu >> 2, c = F.vcu & 3;
    for (int i = 0; i < 4; ++i) { const int qb = (i == 0) ? 2 * c : (i == 1) ? 15 - 2 * c : (i == 2) ? 2 * c + 1 : 14 - 2 * c; attn_unit(F, bh >> 3, bh & 7, qb); }
}

__device__ __forceinline__ void p6_norm2_route(Frame& F) {
    const float* mod = (const float*)(F.ws + WS_MOD); const float* g2 = F.in[13]; h16* H2 = (h16*)(F.ws + WS_H); const float* x1 = F.out;
    const h16* WRLg = (const h16*)(F.ws + WS_WRL);
    LAS h16* wrl = (LAS h16*)F.lds;
    LAS unsigned* lcnt = (LAS unsigned*)(F.lds + 73728);
    LAS unsigned* lbase = lcnt + 32;
    LAS unsigned* rinfo = (LAS unsigned*)(F.lds + 73728 + 256);
    for (int i = F.tid; i < 36 * 1024 / 8; i += NTHR) *(LAS u32x4*)(wrl + i * 8) = *(const u32x4*)(WRLg + i * 8);
    if (F.tid < 32) lcnt[F.tid] = 0u;
    __syncthreads();
    const int b = F.vcu >> 5;
    const float* bgr = F.in[15]; const float* ber = F.in[17];
    f32x4 gg[4], hh[4];
#pragma unroll
    for (int j = 0; j < 4; ++j) { const int col = 4 * F.lane + 256 * j; gg[j] = *(const f32x4*)(g2 + col) * (*(const f32x4*)(mod + (size_t)b * 6144 + 4096 + col) + 1.f); hh[j] = *(const f32x4*)(mod + (size_t)b * 6144 + 3072 + col); }
    f32x4 vn[4];
    { const size_t row = (size_t)F.vcu * 128 + F.wave * 16;
#pragma unroll
      for (int j = 0; j < 4; ++j) vn[j] = *(const f32x4*)(x1 + row * 1024 + 4 * F.lane + 256 * j); }
    for (int rr = 0; rr < 16; ++rr) {
        const int lrow = F.wave * 16 + rr; const size_t row = (size_t)F.vcu * 128 + lrow; const size_t rown = row + (rr < 15 ? 1 : 0);
        f32x4 v[4]; float ss = 0.f;
#pragma unroll
        for (int j = 0; j < 4; ++j) { v[j] = vn[j]; vn[j] = *(const f32x4*)(x1 + rown * 1024 + 4 * F.lane + 256 * j); ss += (v[j][0] * v[j][0] + v[j][1] * v[j][1]) + (v[j][2] * v[j][2] + v[j][3] * v[j][3]); }
        const float rstd = rsqrtf(dpp_sum_f32(ss) * (1.f / 1024.f) + EPS);
#pragma unroll
        for (int j = 0; j < 4; ++j) { v[j] = v[j] * rstd * gg[j] + hh[j]; u32x2 w; w.x = pk2h(v[j][0], v[j][1]); w.y = pk2h(v[j][2], v[j][3]); *(u32x2*)(H2 + row * 1024 + 4 * F.lane + 256 * j) = w; }
        float lg[4];
#pragma unroll
        for (int o = 0; o < 4; ++o) { const f16x8 wa = *(const LAS f16x8*)(wrl + (o * 64 + F.lane) * 16), wb = *(const LAS f16x8*)(wrl + (o * 64 + F.lane) * 16 + 8);
            float s = 0.f;
#pragma unroll
            for (int i = 0; i < 4; ++i) { s += v[0][i] * (float)wa[i]; s += v[1][i] * (float)wa[4 + i]; s += v[2][i] * (float)wb[i]; s += v[3][i] * (float)wb[4 + i]; }
            lg[o] = dpp_sum_f32(s) + bgr[o]; }
        int gs = 0; float gm = lg[0];
#pragma unroll
        for (int g = 1; g < 4; ++g) if (lg[g] > gm) { gm = lg[g]; gs = g; }
        float gden = 0.f;
#pragma unroll
        for (int g = 0; g < 4; ++g) gden += __expf(lg[g] - gm);
        const float pg = 1.f / gden;
        gs = __builtin_amdgcn_readfirstlane(gs);
        float el[8];
        { const LAS h16* wsel = wrl + ((4 + 8 * gs) * 64 + F.lane) * 16; const float* bsel = ber + 8 * gs;
#pragma unroll
          for (int e = 0; e < 8; ++e) { const f16x8 wa = *(const LAS f16x8*)(wsel + e * 1024), wb = *(const LAS f16x8*)(wsel + e * 1024 + 8);
            float s = 0.f;
#pragma unroll
            for (int i = 0; i < 4; ++i) { s += v[0][i] * (float)wa[i]; s += v[1][i] * (float)wa[4 + i]; s += v[2][i] * (float)wb[i]; s += v[3][i] * (float)wb[4 + i]; }
            el[e] = dpp_sum_f32(s) + bsel[e]; } }
        int e0 = 0; float m0 = el[0];
#pragma unroll
        for (int e = 1; e < 8; ++e) if (el[e] > m0) { m0 = el[e]; e0 = e; }
        int e1 = -1; float m1 = -__builtin_inff();
#pragma unroll
        for (int e = 0; e < 8; ++e) if (e != e0 && el[e] > m1) { m1 = el[e]; e1 = e; }
        const float p1 = __expf(m1 - m0); const float w0 = pg / (1.f + p1), w1 = pg * p1 / (1.f + p1);
        if (F.lane == 0) {
            const unsigned E0 = (unsigned)(gs * 8 + e0), E1 = (unsigned)(gs * 8 + e1);
            const unsigned r0 = atomicAdd((unsigned*)(lcnt + E0), 1u), r1 = atomicAdd((unsigned*)(lcnt + E1), 1u);
            rinfo[lrow * 8 + 0] = E0; rinfo[lrow * 8 + 1] = r0; rinfo[lrow * 8 + 2] = __builtin_bit_cast(unsigned, w0);
            rinfo[lrow * 8 + 3] = E1; rinfo[lrow * 8 + 4] = r1; rinfo[lrow * 8 + 5] = __builtin_bit_cast(unsigned, w1);
        }
    }
    __syncthreads();
    unsigned* gcnt = (unsigned*)(F.ws + WS_CTL) + CW_GCNT;
    if (F.tid < 32) lbase[F.tid] = atomicAdd(gcnt + F.tid, lcnt[F.tid]);
    __syncthreads();
    if (F.tid < 128) { unsigned* ro = (unsigned*)(F.ws + WS_ROUTE) + ((size_t)F.vcu * 128 + F.tid) * 8;
        const unsigned E0 = rinfo[F.tid * 8 + 0], E1 = rinfo[F.tid * 8 + 3];
        ro[0] = E0; ro[1] = lbase[E0] + rinfo[F.tid * 8 + 1]; ro[2] = rinfo[F.tid * 8 + 2]; ro[3] = E1; ro[4] = lbase[E1] + rinfo[F.tid * 8 + 4]; ro[5] = rinfo[F.tid * 8 + 5]; }
    __syncthreads();
}
__device__ __forceinline__ void expert_offsets(Frame& F, LAS unsigned* off) {
    const unsigned* gcnt = (const unsigned*)(F.ws + WS_CTL) + CW_GCNT;
    if (F.tid == 0) { unsigned a = 0; for (int e = 0; e < 32; ++e) { off[e] = a; a += (__hip_atomic_load(gcnt + e, RLX_AGENT) + 255u) & ~255u; } off[32] = a; }
    __syncthreads();
}
__device__ __forceinline__ void p7_rowmap(Frame& F) {
    LAS unsigned* off = (LAS unsigned*)F.lds;
    expert_offsets(F, off);
    int* rowmap = (int*)(F.ws + WS_ROWMAP); const unsigned* gcnt = (const unsigned*)(F.ws + WS_CTL) + CW_GCNT; int* tile_e = (int*)(F.ws + WS_CTL) + 1024;
    if (F.tid < 128) { const size_t tok = (size_t)F.vcu * 128 + F.tid; const unsigned* ro = (const unsigned*)(F.ws + WS_ROUTE) + tok * 8;
        rowmap[off[ro[0]] + ro[1]] = (int)tok; rowmap[off[ro[3]] + ro[4]] = (int)tok; }
    if (F.vcu < 32) { const int e = F.vcu; const unsigned c = __hip_atomic_load(gcnt + e, RLX_AGENT); for (unsigned r = off[e] + c + F.tid; r < off[e + 1]; r += NTHR) rowmap[r] = -1;
        for (unsigned t = off[e] / 256 + F.tid; t < off[e + 1] / 256; t += NTHR) tile_e[t] = e; }
    __syncthreads();
}
__device__ __forceinline__ void p10_combine(Frame& F) {
    LAS unsigned* off = (LAS unsigned*)F.lds;
    expert_offsets(F, off);
    const float* mod = (const float*)(F.ws + WS_MOD); const h16* Y = (const h16*)(F.ws + WS_Y); float* out = F.out;
    const int b = F.vcu >> 5;
    f32x4 g2[4];
#pragma unroll
    for (int j = 0; j < 4; ++j) g2[j] = *(const f32x4*)(mod + (size_t)b * 6144 + 5120 + 4 * F.lane + 256 * j);
    const size_t rowbase = (size_t)F.vcu * 128 + F.wave * 16;
    unsigned P0l = 0u, P1l = 0u; float C0l = 0.f, C1l = 0.f;
    if (F.lane < 16) { const unsigned* ro = (const unsigned*)(F.ws + WS_ROUTE) + (rowbase + F.lane) * 8; P0l = off[ro[0]] + ro[1]; P1l = off[ro[3]] + ro[4]; C0l = __builtin_bit_cast(float, ro[2]); C1l = __builtin_bit_cast(float, ro[5]); }
    f16x4 y0n[4], y1n[4]; f32x4 xn[4];
    { const size_t p0 = (unsigned)__shfl((int)P0l, 0), p1 = (unsigned)__shfl((int)P1l, 0);
#pragma unroll
      for (int j = 0; j < 4; ++j) { const int col = 4 * F.lane + 256 * j; y0n[j] = *(const f16x4*)(Y + p0 * 1024 + col); y1n[j] = *(const f16x4*)(Y + p1 * 1024 + col); xn[j] = *(const f32x4*)(out + rowbase * 1024 + col); } }
    for (int rr = 0; rr < 16; ++rr) {
        const size_t row = rowbase + rr; const int rn = rr < 15 ? rr + 1 : rr;
        const float c0 = __shfl(C0l, rr), c1 = __shfl(C1l, rr);
        const size_t p0n = (unsigned)__shfl((int)P0l, rn), p1n = (unsigned)__shfl((int)P1l, rn);
#pragma unroll
        for (int j = 0; j < 4; ++j) { const int col = 4 * F.lane + 256 * j;
            const f16x4 y0 = y0n[j], y1 = y1n[j]; f32x4 xv = xn[j];
            y0n[j] = *(const f16x4*)(Y + p0n * 1024 + col); y1n[j] = *(const f16x4*)(Y + p1n * 1024 + col); xn[j] = *(const f32x4*)(out + (rowbase + rn) * 1024 + col);
#pragma unroll
            for (int i = 0; i < 4; ++i) xv[i] += g2[j][i] * (c0 * (float)y0[i] + c1 * (float)y1[i]);
            *(f32x4*)(out + row * 1024 + col) = xv; }
    }
}
constexpr int N_PHASES = 12;
__global__ void __launch_bounds__(NTHR, 2) mega_fwd(Args args) {
    extern __shared__ __attribute__((aligned(16))) unsigned char lds_raw[];
    Frame F;
    F.lds = (LAS unsigned char*)lds_raw; F.ldsg = lds_raw;
    F.tid = threadIdx.x; F.lane = F.tid & 63; F.wave = __builtin_amdgcn_readfirstlane(F.tid >> 6);
    F.G = gridDim.x; { const int bx = blockIdx.x; F.vcu = (F.G % 8 == 0) ? (bx % 8) * (F.G / 8) + bx / 8 : bx; }
    F.in = (const float* const __attribute__((address_space(4)))*)__builtin_amdgcn_kernarg_segment_ptr();
    F.out = args.out; F.ws = args.ws;
    volatile LAS unsigned* MISC = (volatile LAS unsigned*)(F.lds + MISC_OFF);
    if (F.tid < 16) MISC[F.tid] = 0u;
    __syncthreads();
    const int lo = args.ph_lo, hi = args.ph_hi;
    XcdBarrier bar; bar.bar = (unsigned*)(F.ws + WS_CTL) + CW_BAR; bar.x = 0; bar.st = nullptr;
    if (hi - lo > 1) bar = xcd_barrier_post((unsigned*)(F.ws + WS_CTL) + CW_BAR, MISC + 8);
#define IN(k) (lo <= (k) && (k) < hi)
#define STAMP(k) do {} while (0)
#define SEAM(k) do { if (IN(k) && IN((k) + 1)) xcd_barrier(bar); STAMP((k) + 1); } while (0)
    STAMP(0);
    if (IN(0)) { p0_prologue(F); }
    if (lo < 0) { cg::this_grid().sync(); }
    SEAM(0);
    if (IN(1)) { p1_norm1(F); }
    SEAM(1);
    if (IN(2)) {
        pg8::Gemm g{(const h16*)(F.ws + WS_H), (const h16*)(F.ws + WS_WINT), M, NINP, DM, 0, nullptr}; pg8::StaticOrder S; S.init(M, NINP, F.G, (int)blockIdx.x);
        EpiInProj E{(h16*)(F.ws + WS_Q), (h16*)(F.ws + WS_K), (h16*)(F.ws + WS_V), (h16*)(F.ws + WS_QI), (h16*)(F.ws + WS_KI), (h16*)(F.ws + WS_GB), (h16*)(F.ws + WS_Z), (float*)(F.ws + WS_WI), F.in[7], F.in[8]};
        pg8::gemm_phase<EpiInProj, pg8::StaticOrder, false>(F.lds, g, S, E);
    }
    SEAM(2);
    if (IN(3)) { p3_conv(F); p3_indexer(F); }
    SEAM(3);
    if (IN(4)) { p4_attention(F); }
    SEAM(4);
    if (IN(5)) {
        pg8::Gemm g{(const h16*)(F.ws + WS_MERGED), (const h16*)(F.ws + WS_WOUTT), M, DM, DM, 0, nullptr}; pg8::StaticOrder S; S.init(M, DM, F.G, (int)blockIdx.x);
        EpiOutProj E{F.in[0], F.out, (const float*)(F.ws + WS_MOD)};
        pg8::gemm_phase<EpiOutProj, pg8::StaticOrder, false>(F.lds, g, S, E);
    }
    SEAM(5);
    if (IN(6)) { p6_norm2_route(F); }
    SEAM(6);
    if (IN(7)) { p7_rowmap(F); }
    SEAM(7);
    if (IN(8) || IN(9) || IN(10)) {
        LAS unsigned* off = (LAS unsigned*)(F.lds + RING_BYTES); expert_offsets(F, off); const int ntiles = (int)(off[32] / 256u); __syncthreads();
        const int* tile_e = (const int*)(F.ws + WS_CTL) + 1024;
        const int n8 = 2 * ntiles, R8 = n8 / F.G, rem8 = n8 - R8 * F.G;
        const int pmA = (R8 * F.G) / 2;
        const int n9 = 4 * ntiles; int nB = 2 * (F.G - rem8); nB = nB < 4 * pmA ? nB : 4 * pmA; nB = nB < n9 ? nB : n9;
        const pg8::Gemm gU{(const h16*)(F.ws + WS_H), (const h16*)(F.ws + WS_WGUT), 0, 512, DM, (size_t)512 * 1024 * 2, (const int*)(F.ws + WS_ROWMAP)};
        const pg8::Gemm gD{(const h16*)(F.ws + WS_HID), (const h16*)(F.ws + WS_WDT), 0, 1024, EFF, (size_t)1024 * 256 * 2, nullptr};
        const EpiMoeUp EU{(h16*)(F.ws + WS_HID)}; const EpiMoeDown ED{(h16*)(F.ws + WS_Y)};
        if (IN(8)) { pg8::GroupedOrder S{tile_e, 2, F.vcu, F.G, R8}; pg8::gemm_phase<EpiMoeUp, pg8::GroupedOrder, true>(F.lds, gU, S, EU); }
        SEAM(8);
        if (IN(9)) {
            if (F.vcu < rem8) { pg8::GroupedOrder S{tile_e, 2, R8 * F.G + F.vcu, F.G, 1}; pg8::gemm_phase<EpiMoeUp, pg8::GroupedOrder, true>(F.lds, gU, S, EU); }
            else { const int f = 2 * (F.vcu - rem8); int n = nB - f; n = n < 0 ? 0 : (n > 2 ? 2 : n);
                   pg8::GroupedOrder S{tile_e, 4, f, 1, n}; pg8::gemm_phase<EpiMoeDown, pg8::GroupedOrder, false>(F.lds, gD, S, ED); }
        }
        SEAM(9);
        if (IN(10)) { const int f = nB + F.vcu; const int n = f < n9 ? (n9 - f + F.G - 1) / F.G : 0;
            pg8::GroupedOrder S{tile_e, 4, f, F.G, n}; pg8::gemm_phase<EpiMoeDown, pg8::GroupedOrder, false>(F.lds, gD, S, ED); }
    }
    SEAM(10);
    if (IN(11)) { p10_combine(F); }

#undef IN
#undef SEAM
}

extern "C" void kernel_launch(void* const* d_in, const int* in_sizes, int n_in, void* d_out, int out_size, void* d_ws, size_t ws_size, hipStream_t stream) {
    static int grid = 0;
    if (grid == 0) {
        if (n_in != 21 || out_size != M * DM || ws_size < WS_END) { fprintf(stderr, "kernel_launch: unexpected shapes (n_in %d out %d ws %zu)\n", n_in, out_size, ws_size); grid = -1; return; }
        int dev = 0, cus = 0, per_cu = 0;
        (void)hipGetDevice(&dev); (void)hipDeviceGetAttribute(&cus, hipDeviceAttributeMultiprocessorCount, dev);
        if (hipFuncSetAttribute((const void*)mega_fwd, hipFuncAttributeMaxDynamicSharedMemorySize, LDS_BYTES) != hipSuccess) { fprintf(stderr, "kernel_launch: hipFuncSetAttribute failed\n"); grid = -1; return; }
        if (hipOccupancyMaxActiveBlocksPerMultiprocessor(&per_cu, (const void*)mega_fwd, NTHR, LDS_BYTES) != hipSuccess || per_cu < 1) { fprintf(stderr, "kernel_launch: occupancy query says %d\n", per_cu); per_cu = 1; }
        (void)hipGetLastError();
        grid = cus;
        if (grid != 256) { fprintf(stderr, "kernel_launch: built for 256 CUs, got %d\n", grid); }
    }
    if (grid < 0) return;
    (void)hipMemsetAsync((char*)d_ws + WS_CTL, 0, CTL_ZERO_BYTES, stream);
    Args a{};
    for (int i = 0; i < 21; ++i) a.in[i] = (const float*)d_in[i];
    a.out = (float*)d_out; a.ws = (unsigned char*)d_ws;
#if MK_N_LAUNCHES == 1
    a.ph_lo = 0; a.ph_hi = N_PHASES;
    void* kargs[] = {&a};
    hipError_t e = hipLaunchCooperativeKernel((const void*)mega_fwd, dim3(grid), dim3(NTHR), kargs, LDS_BYTES, stream);
    if (e != hipSuccess) fprintf(stderr, "cooperative launch failed: %s\n", hipGetErrorString(e));
#else
    for (int p = 0; p < N_PHASES; ++p) { a.ph_lo = p; a.ph_hi = p + 1; hipLaunchKernelGGL(mega_fwd, dim3(grid), dim3(NTHR), LDS_BYTES, stream, a); }
#endif
}
```

```cpp
#include <hip/hip_runtime.h>
#include <hip/hip_cooperative_groups.h>
#include <cstdio>
#include <cstdint>
namespace cg = cooperative_groups;

#ifndef MK_N_LAUNCHES

#define MK_N_LAUNCHES 1
#endif

#define LAS __attribute__((address_space(3)))
#define GAS __attribute__((address_space(1)))
typedef _Float16 h16;
typedef _Float16 f16x8 __attribute__((ext_vector_type(8)));
typedef _Float16 f16x4 __attribute__((ext_vector_type(4)));
typedef _Float16 f16x2 __attribute__((ext_vector_type(2)));
typedef short s16x4 __attribute__((ext_vector_type(4)));
typedef float f32x2 __attribute__((ext_vector_type(2)));
typedef float f32x4 __attribute__((ext_vector_type(4)));
typedef float f32x16 __attribute__((ext_vector_type(16)));
typedef unsigned u32x2 __attribute__((ext_vector_type(2)));
typedef unsigned u32x4 __attribute__((ext_vector_type(4)));
typedef unsigned long long u64;

constexpr int BATCH = 8, SEQ = 4096, DM = 1024, M = BATCH * SEQ;
constexpr int NINP = 3840;
constexpr int NEXP = 32, EFF = 256;
constexpr int MAXROWS = 2 * M + NEXP * 256;
constexpr float EPS = 1e-6f;
constexpr float LOG2E = 1.4426950408889634f;
constexpr float QSCALE = 0.125f * LOG2E;
constexpr float IDX_SCALE = 0.125f * 0.35355339059327373f;
constexpr int NWAVES = 8, NTHR = 512;

constexpr size_t MiB = 1u << 20;
constexpr size_t WS_CTL = 0, CTL_ZERO_BYTES = 64 * 1024;
constexpr size_t WS_MODP = 1 * MiB;
constexpr size_t WS_MOD = 4 * MiB;
constexpr size_t WS_ROUTE = 5 * MiB;
constexpr size_t WS_ROWMAP = 6 * MiB + 512 * 1024;
constexpr size_t WS_WINT = 8 * MiB;
constexpr size_t WS_WOUTT = 16 * MiB;
constexpr size_t WS_WRL = 18 * MiB;
constexpr size_t WS_WGUT = 20 * MiB;
constexpr size_t WS_WDT = 52 * MiB;
constexpr size_t WS_H = 72 * MiB;
constexpr size_t WS_Q = 136 * MiB, WS_K = 168 * MiB, WS_V = 200 * MiB, WS_QI = 232 * MiB;
constexpr size_t WS_KI = 264 * MiB;
constexpr size_t WS_WI = 268 * MiB;
constexpr size_t WS_GB = 270 * MiB, WS_Z = 302 * MiB;
constexpr size_t WS_BM = 334 * MiB;
constexpr size_t WS_MERGED = 350 * MiB;
constexpr size_t WS_HID = 416 * MiB;
constexpr size_t WS_Y = 136 * MiB;
constexpr size_t WS_END = 456 * MiB;
static_assert(WS_Y + (size_t)MAXROWS * 1024 * 2 <= WS_Z + 32 * MiB, "Y overlay");
static_assert(WS_HID + (size_t)MAXROWS * 256 * 2 <= WS_END, "HID");
constexpr int CW_GCNT = 64;
constexpr int CW_BAR = 4096;

constexpr int LDS_BYTES = 147456;
constexpr int RING_BYTES = 131072;
constexpr int MISC_OFF = 147456 - 256;

__device__ const unsigned char T5_BKT[129] = {0, 1, 2, 3, 4, 5, 6, 7, 8, 9, 10, 11, 12, 13, 14, 15, 16, 16, 16, 17, 17, 18, 18, 18, 19, 19, 19, 20, 20, 20, 20, 21, 21, 21, 21, 22, 22, 22, 22, 22, 23, 23, 23, 23, 23, 23, 24, 24, 24, 24, 24, 24, 25, 25, 25, 25, 25, 25, 25, 26, 26, 26, 26, 26, 26, 26, 26, 27, 27, 27, 27, 27, 27, 27, 27, 27, 27, 28, 28, 28, 28, 28, 28, 28, 28, 28, 28, 29, 29, 29, 29, 29, 29, 29, 29, 29, 29, 29, 29, 30, 30, 30, 30, 30, 30, 30, 30, 30, 30, 30, 30, 30, 30, 31, 31, 31, 31, 31, 31, 31, 31, 31, 31, 31, 31, 31, 31, 31, 31};

#define LDS_WAIT() asm volatile("s_waitcnt lgkmcnt(0)" ::: "memory")
#define VM_WAIT() asm volatile("s_waitcnt vmcnt(0)" ::: "memory")
#define RLX_AGENT __ATOMIC_RELAXED, __HIP_MEMORY_SCOPE_AGENT
__device__ __forceinline__ unsigned pk2h(float lo, float hi) { f32x2 v = {lo, hi}; f16x2 h = __builtin_convertvector(v, f16x2); return __builtin_bit_cast(unsigned, h); }
__device__ __forceinline__ u32x4 pk8h(f32x4 a, f32x4 b) { u32x4 w; w.x = pk2h(a[0], a[1]); w.y = pk2h(a[2], a[3]); w.z = pk2h(b[0], b[1]); w.w = pk2h(b[2], b[3]); return w; }
__device__ __forceinline__ float wave_sum(float v) {
#pragma unroll
    for (int o = 1; o < 64; o <<= 1) v += __shfl_xor(v, o);
    return v;
}
__device__ __forceinline__ unsigned dpp_sum_u32(unsigned v) {
    v += (unsigned)__builtin_amdgcn_update_dpp(0, (int)v, 0xB1, 0xf, 0xf, false);
    v += (unsigned)__builtin_amdgcn_update_dpp(0, (int)v, 0x4E, 0xf, 0xf, false);
    v += (unsigned)__builtin_amdgcn_update_dpp(0, (int)v, 0x141, 0xf, 0xf, false);
    v += (unsigned)__builtin_amdgcn_update_dpp(0, (int)v, 0x140, 0xf, 0xf, false);
    return __builtin_amdgcn_readlane(v, 0) + __builtin_amdgcn_readlane(v, 16) + __builtin_amdgcn_readlane(v, 32) + __builtin_amdgcn_readlane(v, 48);
}
__device__ __forceinline__ float dpp_sum_f32(float v) {
    v += __builtin_bit_cast(float, __builtin_amdgcn_update_dpp(0, __builtin_bit_cast(int, v), 0xB1, 0xf, 0xf, false));
    v += __builtin_bit_cast(float, __builtin_amdgcn_update_dpp(0, __builtin_bit_cast(int, v), 0x4E, 0xf, 0xf, false));
    v += __builtin_bit_cast(float, __builtin_amdgcn_update_dpp(0, __builtin_bit_cast(int, v), 0x141, 0xf, 0xf, false));
    v += __builtin_bit_cast(float, __builtin_amdgcn_update_dpp(0, __builtin_bit_cast(int, v), 0x140, 0xf, 0xf, false));
    return __builtin_bit_cast(float, __builtin_amdgcn_readlane(__builtin_bit_cast(int, v), 0)) + __builtin_bit_cast(float, __builtin_amdgcn_readlane(__builtin_bit_cast(int, v), 16)) +
           __builtin_bit_cast(float, __builtin_amdgcn_readlane(__builtin_bit_cast(int, v), 32)) + __builtin_bit_cast(float, __builtin_amdgcn_readlane(__builtin_bit_cast(int, v), 48));
}
__device__ __forceinline__ float dpp_max_f32(float v) {
    v = fmaxf(v, __builtin_bit_cast(float, __builtin_amdgcn_update_dpp(__builtin_bit_cast(int, v), __builtin_bit_cast(int, v), 0xB1, 0xf, 0xf, false)));
    v = fmaxf(v, __builtin_bit_cast(float, __builtin_amdgcn_update_dpp(__builtin_bit_cast(int, v), __builtin_bit_cast(int, v), 0x4E, 0xf, 0xf, false)));
    v = fmaxf(v, __builtin_bit_cast(float, __builtin_amdgcn_update_dpp(__builtin_bit_cast(int, v), __builtin_bit_cast(int, v), 0x141, 0xf, 0xf, false)));
    v = fmaxf(v, __builtin_bit_cast(float, __builtin_amdgcn_update_dpp(__builtin_bit_cast(int, v), __builtin_bit_cast(int, v), 0x140, 0xf, 0xf, false)));
    float a = __builtin_bit_cast(float, __builtin_amdgcn_readlane(__builtin_bit_cast(int, v), 0)), b = __builtin_bit_cast(float, __builtin_amdgcn_readlane(__builtin_bit_cast(int, v), 16));
    float c = __builtin_bit_cast(float, __builtin_amdgcn_readlane(__builtin_bit_cast(int, v), 32)), d = __builtin_bit_cast(float, __builtin_amdgcn_readlane(__builtin_bit_cast(int, v), 48));
    return fmaxf(fmaxf(a, b), fmaxf(c, d));
}
__device__ __forceinline__ float dpp_min_f32(float v) { return -dpp_max_f32(-v); }
__device__ __forceinline__ float silu_f(float v) { return v / (1.f + __expf(-v)); }

namespace pg8 {
#define PG8_LAS __attribute__((address_space(3)))
constexpr int BM = 256, BK = 64, HALF = 128, HTB = HALF * BK * 2, STAGE_BYTES = 8 * HTB, NXCD = 8, WGM = 8;
__host__ __device__ __forceinline__ int lds_byte(int r, int c) { const int st = (r >> 4) * 2 + (c >> 5), rr = r & 15, cc = c & 31, ob = rr * 64 + cc * 2; return st * 1024 + (ob ^ (((ob >> 9) & 1) << 5)); }
__host__ __device__ __forceinline__ void stage_rc(int b, int& R, int& C) { const int st = b / 1024, sb = b % 1024, swz = sb ^ (((sb >> 9) & 1) << 5); R = (st >> 1) * 16 + swz / 64; C = (st & 1) * 32 + (swz % 64) / 2; }
__host__ __device__ __forceinline__ int perm32(int rho) { const int n = rho >> 4, i = rho & 15; return 8 * (i >> 2) + 4 * n + (i & 3); }

struct Unit { int pm, pn, eb; };
struct Gemm { const h16* A; const h16* Bt; int M, N, K; size_t bstride; const int* rowmap; };

struct StaticOrder {
    int nM, nN, nwg, G, c;
    __device__ void init(int M_, int N_, int G_, int c_) { nM = M_ / BM; nN = N_ / BM; nwg = nM * nN; G = G_; c = c_; }
    __device__ bool next(int i, Unit& u) const {
        const long L = (long)i * G + c; if (L >= nwg) return false;
        int wgid = (int)L; { const int q = nwg / NXCD, r = nwg % NXCD, xcd = wgid % NXCD, off = wgid / NXCD; wgid = (xcd < r ? xcd * (q + 1) : r * (q + 1) + (xcd - r) * q) + off; }
        const int nig = WGM * nN, gid = wgid / nig, fm = gid * WGM, gsz = (nM - fm) < WGM ? (nM - fm) : WGM;
        u.pm = fm + ((wgid % nig) % gsz); u.pn = (wgid % nig) / gsz; u.eb = 0; return true;
    }
};
struct GroupedOrder {
    const int* tile_e; int nN, first, step, n;
    __device__ bool next(int i, Unit& u) const {
        if (i >= n) return false;
        const int L = first + i * step;
        u.pm = L / nN; u.pn = L % nN; u.eb = tile_e[u.pm]; return true;
    }
};

template <class Epi, class Sched, bool GATHER>
__device__ __forceinline__ void gemm_phase(PG8_LAS unsigned char* lds, const Gemm g, const Sched& S, const Epi& E) {
    const int tid = threadIdx.x, wid = __builtin_amdgcn_readfirstlane(tid >> 6), lane = tid & 63, wr = wid >> 2, wc = wid & 3, fr = lane & 15, fq = lane >> 4;
    int K_ = g.K; asm volatile("" : "+s"(K_));
    const int K = K_, nt = K / BK;
    unsigned voffB[2]; unsigned cC[2]; int cR[2];
    unsigned vA0[2], vA1[2];
#pragma unroll
    for (int i = 0; i < 2; ++i) { int R, C; stage_rc(tid * 16 + i * 8192, R, C); const int Rb = Epi::PERM ? ((R & ~31) + perm32(R & 31)) : R;
        cR[i] = R; cC[i] = (unsigned)C * 2u; voffB[i] = (unsigned)(Rb * K + C) * 2u; vA0[i] = (unsigned)(R * K + C) * 2u; vA1[i] = vA0[i]; }
    const size_t kstep = (size_t)(BK * 2);
    const size_t hstep = (size_t)HALF * K * 2;
    const size_t tstep = 2 * hstep;
    const unsigned ldsw = (unsigned)wid * 1024u;
    const int aoff = lds_byte(wr * 64 + fr, fq * 8), boff = lds_byte(wc * 32 + fr, fq * 8);
#define PG8_SA(b, h) (((b) * 2 + (h)) * HTB)
#define PG8_SB(b, h) ((4 + (b) * 2 + (h)) * HTB)
#define PG8_STAGE(bufoff, gbase, voff) do { _Pragma("unroll") for (int _i = 0; _i < 2; ++_i) \
        __builtin_amdgcn_global_load_lds((const unsigned*)((const char*)(gbase) + (voff)[_i]), (PG8_LAS unsigned*)(lds + (bufoff) + ldsw + _i * 8192), 16, 0, 0); } while (0)
#define PG8_LDA(dst, b, h) do { _Pragma("unroll") for (int m = 0; m < 4; ++m) _Pragma("unroll") for (int k = 0; k < 2; ++k) dst[m][k] = *(const PG8_LAS f16x8*)(lds + PG8_SA(b, h) + aoff + m * 2048 + k * 1024); } while (0)
#define PG8_LDB(dst, b, h) do { _Pragma("unroll") for (int n = 0; n < 2; ++n) _Pragma("unroll") for (int k = 0; k < 2; ++k) dst[n][k] = *(const PG8_LAS f16x8*)(lds + PG8_SB(b, h) + boff + n * 2048 + k * 1024); } while (0)
#define PG8_MMA(ai, bj, At, Bt) do { __builtin_amdgcn_s_setprio(1); _Pragma("unroll") for (int m = 0; m < 4; ++m) _Pragma("unroll") for (int n = 0; n < 2; ++n) _Pragma("unroll") for (int k = 0; k < 2; ++k) \
        acc[ai][bj][m][n] = __builtin_amdgcn_mfma_f32_16x16x32_f16(Bt[n][k], At[m][k], acc[ai][bj][m][n], 0, 0, 0); __builtin_amdgcn_s_setprio(0); } while (0)
#define PG8_WAIT_V(n) asm volatile("s_waitcnt vmcnt(" #n ")" ::: "memory")
#define PG8_WAIT_L(n) asm volatile("s_waitcnt lgkmcnt(" #n ")" ::: "memory")
#define PG8_BAR __builtin_amdgcn_s_barrier()
#define PG8_SCHED __builtin_amdgcn_sched_barrier(0)
#define PG8_ABASE(u_) (GATHER ? (const char*)g.A : (const char*)g.A + (size_t)(u_).pm * tstep)
#define PG8_AH1 (GATHER ? (size_t)0 : hstep)
#define PG8_GATHER_OFF(u_, d0, d1) do { if (GATHER) { _Pragma("unroll") for (int _i = 0; _i < 2; ++_i) { \
        int r0_ = g.rowmap[(u_).pm * BM + cR[_i]], r1_ = g.rowmap[(u_).pm * BM + HALF + cR[_i]]; r0_ = r0_ < 0 ? 0 : r0_; r1_ = r1_ < 0 ? 0 : r1_; \
        d0[_i] = (unsigned)r0_ * (unsigned)(K * 2) + cC[_i]; d1[_i] = (unsigned)r1_ * (unsigned)(K * 2) + cC[_i]; } } } while (0)
    Unit cur, nxt; int ui = 0;
    if (!S.next(0, cur)) return;
    f32x4 acc[2][2][4][2];
#pragma unroll
    for (int a = 0; a < 2; ++a)
#pragma unroll
        for (int b = 0; b < 2; ++b)
#pragma unroll
            for (int m = 0; m < 4; ++m)
#pragma unroll
                for (int n = 0; n < 2; ++n) acc[a][b][m][n] = (f32x4){0.f, 0.f, 0.f, 0.f};
    f16x8 At[4][2], B0[2][2], B1[2][2];
    PG8_GATHER_OFF(cur, vA0, vA1);
    const char* cA = PG8_ABASE(cur); const char* cB = (const char*)g.Bt + (size_t)cur.eb * g.bstride + (size_t)cur.pn * tstep;
    PG8_STAGE(PG8_SB(0, 0), cB, voffB); PG8_STAGE(PG8_SB(0, 1), cB + hstep, voffB); PG8_STAGE(PG8_SA(0, 0), cA, vA0); PG8_STAGE(PG8_SA(0, 1), cA + PG8_AH1, vA1);
    if (wr == 1) PG8_BAR;
    PG8_WAIT_V(2); PG8_BAR;
    PG8_STAGE(PG8_SB(1, 0), cB + kstep, voffB); PG8_STAGE(PG8_SA(1, 0), cA + kstep, vA0); PG8_STAGE(PG8_SB(1, 1), cB + hstep + kstep, voffB);
    PG8_WAIT_V(6); PG8_BAR;
    for (;;) {
        const bool has_next = S.next(ui + 1, nxt);
        unsigned nA0[2] = {vA0[0], vA0[1]}, nA1[2] = {vA1[0], vA1[1]};
        if (has_next) PG8_GATHER_OFF(nxt, nA0, nA1);
        const char* nA = has_next ? PG8_ABASE(nxt) : cA; const char* nB = has_next ? (const char*)g.Bt + (size_t)nxt.eb * g.bstride + (size_t)nxt.pn * tstep : cB;
        for (int t = 0; t < nt; t += 2) {
            const bool last = (t == nt - 2);
            const char* a1 = cA + (size_t)(t + 1) * kstep;
            const char* a2 = last ? nA : cA + (size_t)(t + 2) * kstep; const char* b2 = last ? nB : cB + (size_t)(t + 2) * kstep;
            const char* a3 = a2 + kstep; const char* b3 = b2 + kstep;
            unsigned w0[2], w1[2];
#pragma unroll
            for (int i = 0; i < 2; ++i) { w0[i] = last ? nA0[i] : vA0[i]; w1[i] = last ? nA1[i] : vA1[i]; }
            PG8_LDB(B0, 0, 0); PG8_LDB(B1, 0, 1); PG8_SCHED; PG8_LDA(At, 0, 0); PG8_STAGE(PG8_SA(1, 1), a1 + PG8_AH1, vA1);
            PG8_WAIT_V(8); PG8_WAIT_L(0); PG8_BAR; PG8_MMA(0, 0, At, B0); PG8_MMA(0, 1, At, B1); PG8_BAR; PG8_SCHED;
            PG8_LDA(At, 0, 1); PG8_STAGE(PG8_SB(0, 0), b2, voffB); PG8_STAGE(PG8_SB(0, 1), b2 + hstep, voffB); PG8_STAGE(PG8_SA(0, 0), a2, w0);
            PG8_WAIT_V(8); PG8_WAIT_L(0); PG8_BAR; PG8_MMA(1, 0, At, B0); PG8_MMA(1, 1, At, B1); PG8_BAR; PG8_SCHED;
            PG8_LDB(B0, 1, 0); PG8_LDB(B1, 1, 1); PG8_SCHED; PG8_LDA(At, 1, 0); PG8_STAGE(PG8_SA(0, 1), a2 + PG8_AH1, w1);
            PG8_WAIT_V(8); PG8_WAIT_L(0); PG8_BAR; PG8_MMA(0, 0, At, B0); PG8_MMA(0, 1, At, B1); PG8_BAR; PG8_SCHED;
            PG8_LDA(At, 1, 1); PG8_STAGE(PG8_SB(1, 0), b3, voffB); PG8_STAGE(PG8_SB(1, 1), b3 + hstep, voffB); PG8_STAGE(PG8_SA(1, 0), a3, w0);
            PG8_WAIT_V(8); PG8_WAIT_L(0); PG8_BAR; PG8_MMA(1, 0, At, B0); PG8_MMA(1, 1, At, B1); PG8_BAR; PG8_SCHED;
        }
        if (wr == 0) PG8_BAR;
        E(acc, cur, wr, wc, fr, fq);
        if (!has_next) break;
#pragma unroll
        for (int a = 0; a < 2; ++a)
#pragma unroll
            for (int b = 0; b < 2; ++b)
#pragma unroll
                for (int m = 0; m < 4; ++m)
#pragma unroll
                    for (int n = 0; n < 2; ++n) acc[a][b][m][n] = (f32x4){0.f, 0.f, 0.f, 0.f};
        cur = nxt; cA = nA; cB = nB; ++ui;
#pragma unroll
        for (int i = 0; i < 2; ++i) { vA0[i] = nA0[i]; vA1[i] = nA1[i]; }
        if (wr == 1) PG8_BAR;
    }
    PG8_WAIT_V(0);
    PG8_BAR;
#undef PG8_SA
#undef PG8_SB
#undef PG8_STAGE
#undef PG8_LDA
#undef PG8_LDB
#undef PG8_MMA
#undef PG8_WAIT_V
#undef PG8_WAIT_L
#undef PG8_BAR
#undef PG8_SCHED
#undef PG8_ABASE
#undef PG8_AH1
#undef PG8_GATHER_OFF
}
}

struct EpiInProj {
    static constexpr bool PERM = true;
    h16 *Q, *K, *V, *QI, *KI, *GB, *Z; float* WI; const float *qn, *kn;
    __device__ __forceinline__ void operator()(const f32x4 (&acc)[2][2][4][2], const pg8::Unit& u, int wr, int wc, int fr, int fq) const {
        const int row0 = u.pm * 256 + wr * 64 + fr; const int pn = u.pn;
        if (pn < 4) {
            const bool isq = pn < 2; const float* g = isq ? qn : kn; h16* O = isq ? Q : K; const int head = 4 * (pn & 1) + wc; const float sc = isq ? QSCALE : 1.f;
            f32x4 gv[2][2];
#pragma unroll
            for (int bj = 0; bj < 2; ++bj)
#pragma unroll
                for (int n = 0; n < 2; ++n) gv[bj][n] = *(const f32x4*)(g + 32 * bj + 8 * fq + 4 * n) * sc;
#pragma unroll
            for (int ai = 0; ai < 2; ++ai)
#pragma unroll
                for (int m = 0; m < 4; ++m) {
                    float ss = 0.f;
#pragma unroll
                    for (int bj = 0; bj < 2; ++bj)
#pragma unroll
                        for (int n = 0; n < 2; ++n) { const f32x4 v = acc[ai][bj][m][n]; ss += (v[0] * v[0] + v[1] * v[1]) + (v[2] * v[2] + v[3] * v[3]); }
                    ss += __shfl_xor(ss, 16); ss += __shfl_xor(ss, 32);
                    const float rstd = rsqrtf(ss * (1.f / 64.f) + EPS);
                    const int R = row0 + ai * 128 + m * 16;
                    if (isq) { h16* rowp = O + (size_t)R * 512 + head * 64 + 8 * fq;
#pragma unroll
                        for (int bj = 0; bj < 2; ++bj) *(u32x4*)(rowp + 32 * bj) = pk8h(acc[ai][bj][m][0] * rstd * gv[bj][0], acc[ai][bj][m][1] * rstd * gv[bj][1]); }
                    else {
                        h16* tp = O + ((size_t)((R >> 12) * 8 + head) * 64 + ((R & 4095) >> 6)) * 4096 + (R & 63) * 8;
#pragma unroll
                        for (int bj = 0; bj < 2; ++bj) *(u32x4*)(tp + (4 * bj + fq) * 512) = pk8h(acc[ai][bj][m][0] * rstd * gv[bj][0], acc[ai][bj][m][1] * rstd * gv[bj][1]); }
                }
        } else if (pn < 8) {
            h16* O = pn < 6 ? V : QI; const int head = 4 * (pn & 1) + wc;
#pragma unroll
            for (int ai = 0; ai < 2; ++ai)
#pragma unroll
                for (int m = 0; m < 4; ++m) { const int R = row0 + ai * 128 + m * 16;
                    if (pn >= 6) { h16* rowp = O + (size_t)R * 512 + head * 64 + 8 * fq;
#pragma unroll
                        for (int bj = 0; bj < 2; ++bj) *(u32x4*)(rowp + 32 * bj) = pk8h(acc[ai][bj][m][0], acc[ai][bj][m][1]); }
                    else {
                        const int kv = R & 63; h16* tp = O + ((size_t)((R >> 12) * 8 + head) * 64 + ((R & 4095) >> 6)) * 4096 + ((kv >> 4) * 64 + (kv & 15) * 4 + fq) * 8;
#pragma unroll
                        for (int bj = 0; bj < 2; ++bj) *(u32x4*)(tp + bj * 2048) = pk8h(acc[ai][bj][m][0], acc[ai][bj][m][1]); } }
        } else if (pn == 8) {
#pragma unroll
            for (int ai = 0; ai < 2; ++ai)
#pragma unroll
                for (int m = 0; m < 4; ++m) { const size_t row = (size_t)(row0 + ai * 128 + m * 16);
                    if (wc < 2) { const int R = (int)row, c8 = 4 * wc + fq;
                        *(u32x4*)(KI + ((((size_t)(R >> 12) * 128 + ((R & 4095) >> 5)) * 4 + (c8 >> 1)) * 64 + (R & 31) + 32 * (c8 & 1)) * 8) = pk8h(acc[ai][0][m][0], acc[ai][0][m][1]); }
                    else if (wc == 2 && fq == 0) { *(f32x4*)(WI + row * 8) = acc[ai][0][m][0]; *(f32x4*)(WI + row * 8 + 4) = acc[ai][0][m][1]; } }
        } else if (pn < 11) {
            const int colb = 256 * (pn - 9) + 32 * wc + 8 * fq;
#pragma unroll
            for (int ai = 0; ai < 2; ++ai)
#pragma unroll
                for (int m = 0; m < 4; ++m) { h16* rowp = GB + (size_t)(row0 + ai * 128 + m * 16) * 512 + colb;
#pragma unroll
                    for (int bj = 0; bj < 2; ++bj) *(u32x4*)(rowp + 128 * bj) = pk8h(acc[ai][bj][m][0], acc[ai][bj][m][1]); }
        } else {
            const int ch = 128 * (pn - 11) + 32 * wc + 8 * fq;
#pragma unroll
            for (int ai = 0; ai < 2; ++ai)
#pragma unroll
                for (int m = 0; m < 4; ++m) *(u32x4*)(Z + (size_t)(row0 + ai * 128 + m * 16) * 512 + ch) = pk8h(acc[ai][0][m][0] * acc[ai][1][m][0], acc[ai][0][m][1] * acc[ai][1][m][1]);
        }
    }
};
struct EpiOutProj {
    static constexpr bool PERM = false;
    const float* x; float* out; const float* mod;
    __device__ __forceinline__ void operator()(const f32x4 (&acc)[2][2][4][2], const pg8::Unit& u, int wr, int wc, int fr, int fq) const {
        const int row0 = u.pm * 256 + wr * 64 + fr; const int b = (u.pm * 256) >> 12; const int col0 = u.pn * 256 + wc * 32 + 4 * fq;
        f32x4 gv[2][2];
#pragma unroll
        for (int bj = 0; bj < 2; ++bj)
#pragma unroll
            for (int n = 0; n < 2; ++n) gv[bj][n] = *(const f32x4*)(mod + (size_t)b * 6144 + 2048 + col0 + bj * 128 + n * 16);
#pragma unroll
        for (int ai = 0; ai < 2; ++ai)
#pragma unroll
            for (int m = 0; m < 4; ++m) { const size_t off = (size_t)(row0 + ai * 128 + m * 16) * 1024 + col0;
#pragma unroll
                for (int bj = 0; bj < 2; ++bj)
#pragma unroll
                    for (int n = 0; n < 2; ++n) { const f32x4 xv = *(const f32x4*)(x + off + bj * 128 + n * 16); *(f32x4*)(out + off + bj * 128 + n * 16) = xv + gv[bj][n] * acc[ai][bj][m][n]; } }
    }
};
struct EpiMoeUp {
    static constexpr bool PERM = true;
    h16* HID;
    __device__ __forceinline__ void operator()(const f32x4 (&acc)[2][2][4][2], const pg8::Unit& u, int wr, int wc, int fr, int fq) const {
        const int row0 = u.pm * 256 + wr * 64 + fr; const int f0 = 128 * u.pn + 32 * wc + 8 * fq;
#pragma unroll
        for (int ai = 0; ai < 2; ++ai)
#pragma unroll
            for (int m = 0; m < 4; ++m) { f32x4 hv[2];
#pragma unroll
                for (int n = 0; n < 2; ++n) { const f32x4 a = acc[ai][0][m][n], bb = acc[ai][1][m][n];
#pragma unroll
                    for (int i = 0; i < 4; ++i) hv[n][i] = silu_f(a[i]) * bb[i]; }
                *(u32x4*)(HID + (size_t)(row0 + ai * 128 + m * 16) * 256 + f0) = pk8h(hv[0], hv[1]); }
    }
};
struct EpiMoeDown {
    static constexpr bool PERM = true;
    h16* Y;
    __device__ __forceinline__ void operator()(const f32x4 (&acc)[2][2][4][2], const pg8::Unit& u, int wr, int wc, int fr, int fq) const {
        const int row0 = u.pm * 256 + wr * 64 + fr; const int c0 = 256 * u.pn + 32 * wc + 8 * fq;
#pragma unroll
        for (int ai = 0; ai < 2; ++ai)
#pragma unroll
            for (int m = 0; m < 4; ++m) { h16* rowp = Y + (size_t)(row0 + ai * 128 + m * 16) * 1024 + c0;
#pragma unroll
                for (int bj = 0; bj < 2; ++bj) *(u32x4*)(rowp + 128 * bj) = pk8h(acc[ai][bj][m][0], acc[ai][bj][m][1]); }
    }
};

struct Args { const float* in[21]; float* out; unsigned char* ws; int ph_lo, ph_hi; };
struct Frame {
    LAS unsigned char* lds; unsigned char* ldsg;
    int tid, lane, wave, vcu, G;
    const float* const __attribute__((address_space(4)))* in; float* out; unsigned char* ws;
};

#define XB_TMO      128
#define XB_XCNT(j)  (256  + 64 * (j))
#define XB_XSUB(j)  (1280 + 64 * (j))
#define XB_XGEN(j)  (2304 + 64 * (j))
#define XB_TOP      3328
#define XB_TOPGEN   3392
#define XCD_BAR_WORDS 3456
#define XB_SPIN_CAP (1u << 20)
__device__ __forceinline__ unsigned xb_ld(unsigned* p)              { return __hip_atomic_load(p, __ATOMIC_RELAXED, __HIP_MEMORY_SCOPE_AGENT); }
__device__ __forceinline__ unsigned xb_add(unsigned* p, unsigned v) { return __hip_atomic_fetch_add(p, v, __ATOMIC_RELAXED, __HIP_MEMORY_SCOPE_AGENT); }
__device__ __forceinline__ unsigned xb_xcc_id() { return (unsigned)__builtin_amdgcn_s_getreg((3 << 11) | 20) & 0xFu; }
#define XB_SPIN(cond, bar) do { unsigned _sp = 0; while (cond) { __builtin_amdgcn_s_sleep(1); \
    if ((++_sp & 255u) == 0u) { if (xb_ld(&(bar)[XB_TMO])) break; if (_sp > XB_SPIN_CAP) { atomicAdd(&(bar)[XB_TMO], 1u); break; } } } } while (0)
struct XcdBarrier { unsigned* bar; unsigned x; volatile LAS unsigned* st; };
__device__ __forceinline__ XcdBarrier xcd_barrier_post(unsigned* bar, volatile LAS unsigned* st) {
    XcdBarrier b; b.bar = bar; b.x = xb_xcc_id(); b.st = st;
    if (threadIdx.x == 0) (void)xb_add(&bar[XB_XCNT(b.x)], 1u);
    return b;
}
__device__ __forceinline__ void xcd_barrier_complete(unsigned* bar, unsigned x, unsigned& nloc, unsigned& nx) {
    const unsigned G = gridDim.x * gridDim.y * gridDim.z;
    unsigned sum, cnt, mine, sp = 0u;
    for (;;) {
        sum = 0u; cnt = 0u; mine = 0u;
#pragma unroll
        for (unsigned j = 0; j < 16; ++j) { const unsigned c = xb_ld(&bar[XB_XCNT(j)]); sum += c; cnt += (c > 0u) ? 1u : 0u; mine = (j == x) ? c : mine; }
        if (sum == G) break;
        __builtin_amdgcn_s_sleep(1);
        if ((++sp & 255u) == 0u) { if (xb_ld(&bar[XB_TMO])) break; if (sp > XB_SPIN_CAP) { atomicAdd(&bar[XB_TMO], 1u); break; } }
    }
    nloc = mine > 0u ? mine : 1u; nx = cnt > 0u ? cnt : 1u;
}
__device__ __forceinline__ void xcd_barrier(const XcdBarrier& b) {
    asm volatile("s_waitcnt vmcnt(0)" ::: "memory");
    __syncthreads();
    if (threadIdx.x == 0) {
        unsigned* bar = b.bar;
        __builtin_amdgcn_s_waitcnt(0);
        unsigned nloc = b.st[0], nx = b.st[1];
        if (nloc == 0u) { xcd_barrier_complete(bar, b.x, nloc, nx); b.st[0] = nloc; b.st[1] = nx; }
        const unsigned old = xb_add(&bar[XB_XSUB(b.x)], 1u);
        const unsigned gen = old / nloc;
        if (old + 1u == (gen + 1u) * nloc) {
            __builtin_amdgcn_fence(__ATOMIC_RELEASE, "agent");
            asm volatile("s_waitcnt vmcnt(0)" ::: "memory");
            const unsigned og = xb_add(&bar[XB_TOP], 1u);
            const unsigned tg = og / nx;
            if (og + 1u == (tg + 1u) * nx) xb_add(&bar[XB_TOPGEN], 1u);
            else XB_SPIN(xb_ld(&bar[XB_TOPGEN]) == tg, bar);
            __builtin_amdgcn_fence(__ATOMIC_ACQUIRE, "agent");
            xb_add(&bar[XB_XGEN(b.x)], 1u);
            asm volatile("s_waitcnt vmcnt(0)" ::: "memory");
        } else {
            XB_SPIN(xb_ld(&bar[XB_XGEN(b.x)]) == gen, bar);
            __builtin_amdgcn_fence(__ATOMIC_ACQUIRE, "agent");
            asm volatile("s_waitcnt vmcnt(0)" ::: "memory");
        }
    }
    __syncthreads();
}

__device__ __forceinline__ void transpose_item(const float* src, int ldw, int nvalid, int k0, h16* dst, int K, LAS float* scr, int lane) {
    const int c4 = lane & 7, rsub = lane >> 3;
    f32x4 v[8];
#pragma unroll
    for (int i = 0; i < 8; ++i) v[i] = (4 * c4 < nvalid) ? *(const f32x4*)(src + (size_t)(k0 + 8 * i + rsub) * ldw + 4 * c4) : (f32x4){0.f, 0.f, 0.f, 0.f};
#pragma unroll
    for (int i = 0; i < 8; ++i) { LAS float* p = scr + (8 * i + rsub) * 33 + 4 * c4; p[0] = v[i][0]; p[1] = v[i][1]; p[2] = v[i][2]; p[3] = v[i][3]; }
    LDS_WAIT(); asm volatile("" ::: "memory");
    const int c = lane & 7;
#pragma unroll
    for (int j = 0; j < 4; ++j) { const int nn = (lane >> 3) + 8 * j; const LAS float* s = scr + (8 * c) * 33 + nn;
        u32x4 o; o.x = pk2h(s[0 * 33], s[1 * 33]); o.y = pk2h(s[2 * 33], s[3 * 33]); o.z = pk2h(s[4 * 33], s[5 * 33]); o.w = pk2h(s[6 * 33], s[7 * 33]);
        *(u32x4*)(dst + (size_t)nn * K + k0 + 8 * c) = o; }
    LDS_WAIT(); asm volatile("" ::: "memory");
}
__device__ __forceinline__ int win_group_src(int g, int& nvalid) {
    const int tile = g >> 3, p = (g & 7) * 32, bj = p >> 7, wc = (p >> 5) & 3; nvalid = 32;
    if (tile < 8) { const int seg = tile >> 1; return seg * 512 + 64 * (4 * (tile & 1) + wc) + 32 * bj; }
    if (tile == 8) { if (p < 64) return 2048 + p; if (p == 64) { nvalid = 8; return 2112; } nvalid = 0; return 0; }
    if (tile < 11) return 2120 + 256 * (tile - 9) + p;
    return (bj == 0 ? 2632 : 3144) + 128 * (tile - 11) + 32 * wc;
}
__device__ __forceinline__ void p0_prologue(Frame& F) {
    LAS float* scr = (LAS float*)(F.lds + F.wave * 16384);
    const int gw = F.vcu * NWAVES + F.wave, NGW = F.G * NWAVES;
    const float* w_in = F.in[6]; const float* w_out = F.in[12]; const float* w_gate = F.in[18]; const float* w_up = F.in[19]; const float* w_down = F.in[20];
    h16* WINT = (h16*)(F.ws + WS_WINT); h16* WOUTT = (h16*)(F.ws + WS_WOUTT); h16* WGUT = (h16*)(F.ws + WS_WGUT); h16* WDT = (h16*)(F.ws + WS_WDT);
    constexpr int I_IN = 120 * 16, I_OUT = 32 * 16, I_GU = 32 * 16 * 16, I_D = 32 * 32 * 4, I_MOD = 96 * 16;
    constexpr int NITEMS = I_IN + I_OUT + I_GU + I_D + I_MOD;
    for (int it = gw; it < NITEMS; it += NGW) {
        int r = it;
        if (r < I_MOD) {
            const int cc = r % 96, ks = r / 96; const int col = cc * 64 + F.lane, k0 = ks * 64;
            const float* c = F.in[1]; const float* w_ada = F.in[3];
            float ca[8];
#pragma unroll
            for (int b = 0; b < 8; ++b) ca[b] = silu_f(c[b * 1024 + k0 + F.lane]);
            float a[8] = {0.f, 0.f, 0.f, 0.f, 0.f, 0.f, 0.f, 0.f};
#pragma unroll 8
            for (int kk = 0; kk < 64; ++kk) { const float w = w_ada[(size_t)(k0 + kk) * 6144 + col];
#pragma unroll
                for (int b = 0; b < 8; ++b) a[b] += __builtin_bit_cast(float, __builtin_amdgcn_readlane(__builtin_bit_cast(int, ca[b]), kk)) * w; }
            float* mp = (float*)(F.ws + WS_MODP) + (size_t)ks * 8 * 6144;
#pragma unroll
            for (int b = 0; b < 8; ++b) mp[b * 6144 + col] = a[b];
            continue;
        }
        r -= I_MOD;
        if (r < I_IN) { const int g = r >> 4, kb = r & 15; int nv; const int s0 = win_group_src(g, nv); transpose_item(w_in + s0, 3656, nv, kb * 64, WINT + (size_t)g * 32 * 1024, 1024, scr, F.lane); continue; } r -= I_IN;
        if (r < I_OUT) { const int g = r >> 4, kb = r & 15; transpose_item(w_out + g * 32, 1024, 32, kb * 64, WOUTT + (size_t)g * 32 * 1024, 1024, scr, F.lane); continue; } r -= I_OUT;
        if (r < I_GU) { const int e = r >> 8, g = (r >> 4) & 15, kb = r & 15; const int p = g * 32, t2 = p >> 8, bj = (p >> 7) & 1, wc = (p >> 5) & 3; const int f = 128 * t2 + 32 * wc;
            transpose_item((bj == 0 ? w_gate : w_up) + (size_t)e * 1024 * 256 + f, 256, 32, kb * 64, WGUT + ((size_t)e * 512 + p) * 1024, 1024, scr, F.lane); continue; } r -= I_GU;
        { const int e = r >> 7, g = (r >> 2) & 31, kb = r & 3; transpose_item(w_down + (size_t)e * 256 * 1024 + g * 32, 1024, 32, kb * 64, WDT + ((size_t)e * 1024 + g * 32) * 256, 256, scr, F.lane); }
    }
    { const float* wgr = F.in[14]; const float* wer = F.in[16]; h16* WRL = (h16*)(F.ws + WS_WRL);
      for (int idx = F.vcu * NTHR + F.tid; idx < 36 * 1024; idx += F.G * NTHR) { const int o = idx >> 10, rem = idx & 1023, ln = rem >> 4, ji = rem & 15, col = 4 * ln + 256 * (ji >> 2) + (ji & 3);
          WRL[idx] = (h16)(o < 4 ? wgr[col * 4 + o] : wer[col * 32 + (o - 4)]); } }
}

__device__ __forceinline__ void p1_norm1(Frame& F) {
    const float* modp = (const float*)(F.ws + WS_MODP); float* mod = (float*)(F.ws + WS_MOD); const float* b_ada = F.in[4];
    LAS float* sh = (LAS float*)F.lds; LAS float* sc = sh + 1024;
    const int b = F.vcu >> 5;
    for (int i = F.tid; i < 2048; i += NTHR) { float s = b_ada[i];
#pragma unroll
        for (int ks = 0; ks < 16; ++ks) s += modp[((size_t)ks * 8 + b) * 6144 + i];
        sh[i] = s; }
    if (F.tid < 192) { const int idx = F.vcu * 192 + F.tid; const int bb = idx / 6144, cc = idx % 6144; float s = b_ada[cc];
#pragma unroll
        for (int ks = 0; ks < 16; ++ks) s += modp[((size_t)ks * 8 + bb) * 6144 + cc];
        mod[idx] = s; }
    __syncthreads();
    const float* x = F.in[0]; const float* g1 = F.in[5]; h16* H = (h16*)(F.ws + WS_H);
    f32x4 gg[4], s1[4], h1[4];
#pragma unroll
    for (int j = 0; j < 4; ++j) { const int col = 4 * F.lane + 256 * j; gg[j] = *(const f32x4*)(g1 + col); h1[j] = *(const LAS f32x4*)(sh + col); s1[j] = *(const LAS f32x4*)(sc + col);
        gg[j] = gg[j] * (s1[j] + 1.f); }
    f32x4 vn[4];
    { const size_t row = (size_t)F.vcu * 128 + F.wave * 16;
#pragma unroll
      for (int j = 0; j < 4; ++j) vn[j] = *(const f32x4*)(x + row * 1024 + 4 * F.lane + 256 * j); }
    for (int rr = 0; rr < 16; ++rr) {
        const size_t row = (size_t)F.vcu * 128 + F.wave * 16 + rr; const size_t rown = row + (rr < 15 ? 1 : 0);
        f32x4 v[4]; float ss = 0.f;
#pragma unroll
        for (int j = 0; j < 4; ++j) { v[j] = vn[j]; vn[j] = *(const f32x4*)(x + rown * 1024 + 4 * F.lane + 256 * j); ss += (v[j][0] * v[j][0] + v[j][1] * v[j][1]) + (v[j][2] * v[j][2] + v[j][3] * v[j][3]); }
        const float rstd = rsqrtf(dpp_sum_f32(ss) * (1.f / 1024.f) + EPS);
#pragma unroll
        for (int j = 0; j < 4; ++j) { const f32x4 o = v[j] * rstd * gg[j] + h1[j]; u32x2 w; w.x = pk2h(o[0], o[1]); w.y = pk2h(o[2], o[3]); *(u32x2*)(H + row * 1024 + 4 * F.lane + 256 * j) = w; }
    }
}

__device__ __forceinline__ void p3_conv(Frame& F) {
    const h16* Z = (const h16*)(F.ws + WS_Z); const h16* GB = (const h16*)(F.ws + WS_GB); h16* MG = (h16*)(F.ws + WS_MERGED);
    const float* cw = F.in[9]; const float* cn = F.in[11];
    const int gw = F.vcu * NWAVES + F.wave, NGW = F.G * NWAVES; const int ch = 8 * F.lane;
    float w0[8], w1[8], w2[8], gn[8];
#pragma unroll
    for (int i = 0; i < 8; ++i) { w0[i] = cw[ch + i]; w1[i] = cw[512 + ch + i]; w2[i] = cw[1024 + ch + i]; gn[i] = cn[ch + i]; }
    for (int it = gw; it < M / 32; it += NGW) {
        const int t0 = it * 32; const bool first = (t0 & (SEQ - 1)) == 0;
        f16x8 zm2 = {}, zm1 = {};
        if (!first) { zm2 = *(const f16x8*)(Z + (size_t)(t0 - 2) * 512 + ch); zm1 = *(const f16x8*)(Z + (size_t)(t0 - 1) * 512 + ch); }
        for (int tt = 0; tt < 32; ++tt) {
            const size_t t = (size_t)t0 + tt;
            const f16x8 z0 = *(const f16x8*)(Z + t * 512 + ch); const f16x8 gb = *(const f16x8*)(GB + t * 512 + ch);
            float y[8]; float ss = 0.f;
#pragma unroll
            for (int i = 0; i < 8; ++i) { y[i] = (float)gb[i] * (w0[i] * (float)zm2[i] + w1[i] * (float)zm1[i] + w2[i] * (float)z0[i]); ss += y[i] * y[i]; }
            ss += __shfl_xor(ss, 1); ss += __shfl_xor(ss, 2); ss += __shfl_xor(ss, 4);
            const float rstd = rsqrtf(ss * (1.f / 64.f) + EPS);
            u32x4 o; o.x = pk2h(y[0] * rstd * gn[0], y[1] * rstd * gn[1]); o.y = pk2h(y[2] * rstd * gn[2], y[3] * rstd * gn[3]); o.z = pk2h(y[4] * rstd * gn[4], y[5] * rstd * gn[5]); o.w = pk2h(y[6] * rstd * gn[6], y[7] * rstd * gn[7]);
            *(u32x4*)(MG + t * 1024 + 512 + ch) = o;
            zm2 = zm1; zm1 = z0;
        }
    }
}

constexpr int IX_ROW = 4352, IX_NEG = 8 * IX_ROW * 4, IX_BM = IX_NEG + 256, IX_ST = IX_BM + 4096;
__device__ __forceinline__ unsigned fkey(float f) { const unsigned u = __builtin_bit_cast(unsigned, f); return u ^ ((u >> 31) ? 0xFFFFFFFFu : 0x80000000u); }
__device__ __forceinline__ float fkey_inv(unsigned k) { const unsigned u = (k >> 31) ? (k ^ 0x80000000u) : ~k; return __builtin_bit_cast(float, u); }
__device__ __forceinline__ float probit_lo(float p) {
    if (p < 0.02425f) { const float q = sqrtf(-2.f * __logf(p));
        return (((((-7.784894002430293e-03f * q - 3.223964580411365e-01f) * q - 2.400758277161838e+00f) * q - 2.549732539343734e+00f) * q + 4.374664141464968e+00f) * q + 2.938163982698783e+00f) /
               ((((7.784695709041462e-03f * q + 3.224671290700398e-01f) * q + 2.445134137142996e+00f) * q + 3.754408661907416e+00f) * q + 1.f); }
    const float q = p - 0.5f, r = q * q;
    return (((((-3.969683028665376e+01f * r + 2.209460984245205e+02f) * r - 2.759285104469687e+02f) * r + 1.383577518672690e+02f) * r - 3.066479806614716e+01f) * r + 2.506628277459239e+00f) * q /
           (((((-5.447609879822406e+01f * r + 1.615858368580409e+02f) * r - 1.556989798598866e+02f) * r + 6.680131188771972e+01f) * r - 1.328068155288572e+01f) * r + 1.f);
}
__device__ __forceinline__ void row_sum2(float v, float& h0, float& h1) {
    v += __builtin_bit_cast(float, __builtin_amdgcn_update_dpp(0, __builtin_bit_cast(int, v), 0xB1, 0xf, 0xf, false));
    v += __builtin_bit_cast(float, __builtin_amdgcn_update_dpp(0, __builtin_bit_cast(int, v), 0x4E, 0xf, 0xf, false));
    v += __builtin_bit_cast(float, __builtin_amdgcn_update_dpp(0, __builtin_bit_cast(int, v), 0x141, 0xf, 0xf, false));
    v += __builtin_bit_cast(float, __builtin_amdgcn_update_dpp(0, __builtin_bit_cast(int, v), 0x140, 0xf, 0xf, false));
    h0 = __builtin_bit_cast(float, __builtin_amdgcn_readlane(__builtin_bit_cast(int, v), 0)) + __builtin_bit_cast(float, __builtin_amdgcn_readlane(__builtin_bit_cast(int, v), 16));
    h1 = __builtin_bit_cast(float, __builtin_amdgcn_readlane(__builtin_bit_cast(int, v), 32)) + __builtin_bit_cast(float, __builtin_amdgcn_readlane(__builtin_bit_cast(int, v), 48));
}
__device__ __forceinline__ unsigned eval_mask(const float (&v)[64], float x, unsigned& a, unsigned& b) {
    unsigned ma = 0u, mb = 0u;
#pragma unroll
    for (int i = 31; i >= 0; --i) { ma = __builtin_amdgcn_alignbit(ma, __builtin_bit_cast(unsigned, v[i] - x), 31); mb = __builtin_amdgcn_alignbit(mb, __builtin_bit_cast(unsigned, v[32 + i] - x), 31); }
    a = ma; b = mb;
    return dpp_sum_u32(64u - (unsigned)__builtin_popcount(ma) - (unsigned)__builtin_popcount(mb));
}
__device__ __forceinline__ float probit(float p) { return p > 0.5f ? -probit_lo(1.f - p) : probit_lo(p); }
__device__ __forceinline__ unsigned count_ge(const float (&v)[64], float x) {
    unsigned c = 0;
#pragma unroll
    for (int i = 0; i < 64; ++i) c += (v[i] >= x) ? 1u : 0u;
    return dpp_sum_u32(c);
}
__device__ __forceinline__ float relu_i(float x) { const int i = __builtin_bit_cast(int, x); return __builtin_bit_cast(float, i > 0 ? i : 0); }
constexpr int IX_CTR = IX_ST + 512;
__device__ __forceinline__ void p3_indexer(Frame& F) {
    const h16* QI = (const h16*)(F.ws + WS_QI); const h16* KI = (const h16*)(F.ws + WS_KI); const float* WI = (const float*)(F.ws + WS_WI); u64* BM = (u64*)(F.ws + WS_BM);
    LAS float* sc = (LAS float*)F.lds;
    LAS float* st = (LAS float*)(F.lds + IX_ST);
    LAS unsigned* ctr = (LAS unsigned*)(F.lds + IX_CTR);
    const int lane = F.lane, wid = F.wave, r32 = lane & 31, hi = lane >> 5;
    if (F.tid < 64) ((LAS float*)(F.lds + IX_NEG))[F.tid] = -__builtin_inff();
    if (F.tid < 2) ctr[F.tid] = 0u;
    __syncthreads();
    const int hq = (r32 >> 2) & 1, rr = (r32 & 3) + 4 * (r32 >> 3), jq = 2 * hq + (rr >> 3), hh = rr & 7;
    f16x8 af[2][4]; f32x4 wraw[2][2][2];
#define IX_QLOAD(u_) do { const int idx_ = (u_) * 256 + (((u_) & 1) ? (255 - F.vcu) : F.vcu); const size_t rb_ = (size_t)(idx_ & 7) * SEQ + (size_t)(idx_ >> 3) * 8; \
        _Pragma("unroll") for (int rb = 0; rb < 2; ++rb) { const h16* qp = QI + (rb_ + 4 * rb + jq) * 512 + hh * 64 + hi * 8; \
            _Pragma("unroll") for (int ks = 0; ks < 4; ++ks) af[rb][ks] = *(const f16x8*)(qp + ks * 16); \
            _Pragma("unroll") for (int j2 = 0; j2 < 2; ++j2) { const float* wp = WI + (rb_ + 4 * rb + 2 * hi + j2) * 8; wraw[rb][j2][0] = *(const f32x4*)wp; wraw[rb][j2][1] = *(const f32x4*)(wp + 4); } } } while (0)
    IX_QLOAD(0);
    for (int u = 0; u < 16; ++u) {
        const int idx = u * 256 + ((u & 1) ? (255 - F.vcu) : F.vcu);
        const int b = idx & 7, t0 = (idx >> 3) * 8;
        const size_t rowb = (size_t)b * SEQ;
        const int nj = (t0 + 8 + 63) >> 6;
        {
            float wv[2][16];
#pragma unroll
            for (int rb = 0; rb < 2; ++rb)
#pragma unroll
                for (int j2 = 0; j2 < 2; ++j2)
#pragma unroll
                    for (int i = 0; i < 4; ++i) { wv[rb][8 * j2 + i] = wraw[rb][j2][0][i] * IDX_SCALE; wv[rb][8 * j2 + 4 + i] = wraw[rb][j2][1][i] * IDX_SCALE; }
            float ssum[2][2] = {{0.f, 0.f}, {0.f, 0.f}}, ssq[2][2] = {{0.f, 0.f}, {0.f, 0.f}};
            const h16* kbase = KI + (size_t)b * (128 * 2048) + lane * 8;
#define IX_TICKET(t_) do { asm volatile("ds_add_rtn_u32 %0, %1, %2" : "=v"(t_) : "v"(ctr_addr + 4u * (unsigned)(u & 1)), "v"(1u) : "memory"); } while (0)
#define IX_TGET(t_) ({ int g_; asm volatile("s_waitcnt lgkmcnt(0)\n\tv_readfirstlane_b32 %0, %1" : "=s"(g_) : "v"(t_) : "memory"); g_ >> 6; })
#define IX_LOAD(dst, g_) do { const int gg_ = (g_) < nj ? (g_) : nj - 1; _Pragma("unroll") for (int q = 0; q < 2; ++q) { const h16* kp = kbase + (size_t)(2 * gg_ + q) * 2048; \
                _Pragma("unroll") for (int ks = 0; ks < 4; ++ks) dst[q][ks] = *(const f16x8*)(kp + ks * 512); } } while (0)
#define IX_MMA(x0, x1, kt) do { x0 = f32x16{}; x1 = f32x16{}; \
                _Pragma("unroll") for (int ks = 0; ks < 4; ++ks) { x0 = __builtin_amdgcn_mfma_f32_32x32x16_f16(af[0][ks], kt[ks], x0, 0, 0, 0); x1 = __builtin_amdgcn_mfma_f32_32x32x16_f16(af[1][ks], kt[ks], x1, 0, 0, 0); } } while (0)
#define IX_VAL(x0, x1, tile_, DIAG) do { const int tile = (tile_); const int key = tile * 32 + r32; const int pos = key + 4 * (key >> 6); \
                _Pragma("unroll") for (int rb = 0; rb < 2; ++rb) { float s0 = 0.f, s1 = 0.f; \
                    _Pragma("unroll") for (int r = 0; r < 8; ++r) { const float d0 = rb ? x1[r] : x0[r], d1 = rb ? x1[8 + r] : x0[8 + r]; \
                        s0 = __builtin_fmaf(relu_i(d0), wv[rb][r], s0); s1 = __builtin_fmaf(relu_i(d1), wv[rb][8 + r], s1); } \
                    float z0 = s0, z1 = s1; \
                    if (DIAG) { if (tile * 32 + 31 > t0) { const int tq = t0 + 4 * rb + 2 * hi; const bool v0 = key <= tq, v1 = key <= tq + 1; z0 = v0 ? s0 : 0.f; z1 = v1 ? s1 : 0.f; s0 = v0 ? s0 : -__builtin_inff(); s1 = v1 ? s1 : -__builtin_inff(); } } \
                    ssum[rb][0] += z0; ssq[rb][0] = __builtin_fmaf(z0, z0, ssq[rb][0]); ssum[rb][1] += z1; ssq[rb][1] = __builtin_fmaf(z1, z1, ssq[rb][1]); \
                    sc[(4 * rb + 2 * hi) * IX_ROW + pos] = s0; sc[(4 * rb + 2 * hi + 1) * IX_ROW + pos] = s1; } } while (0)
            const int nf = nj - 1;
            const unsigned ctr_addr = (unsigned)(size_t)ctr;
            f16x8 kA[2][4], kB[2][4]; f32x16 a0, a1, b0, b1;
            unsigned tk; IX_TICKET(tk); int g0 = IX_TGET(tk), g1, gl = g0; bool lastInA = true;
            IX_LOAD(kA, g0);
            if (g0 < nf) {
                IX_TICKET(tk); g1 = IX_TGET(tk); IX_LOAD(kB, g1);
                IX_MMA(a0, a1, kA[0]);
                for (;;) {
                    IX_TICKET(tk);
                    IX_MMA(b0, b1, kA[1]); IX_VAL(a0, a1, 2 * g0, false);
                    IX_MMA(a0, a1, kB[0]); IX_VAL(b0, b1, 2 * g0 + 1, false);
                    const int g2 = IX_TGET(tk);
                    if (g1 >= nf) { gl = g1; lastInA = false; break; }
                    IX_LOAD(kA, g2);
                    IX_TICKET(tk);
                    IX_MMA(b0, b1, kB[1]); IX_VAL(a0, a1, 2 * g1, false);
                    IX_MMA(a0, a1, kA[0]); IX_VAL(b0, b1, 2 * g1 + 1, false);
                    g0 = g2; g1 = IX_TGET(tk);
                    if (g0 >= nf) { gl = g0; lastInA = true; break; }
                    IX_LOAD(kB, g1);
                }
            }
            if (gl == nf) {
                if (lastInA) { IX_MMA(a0, a1, kA[0]); IX_VAL(a0, a1, 2 * nf, true); IX_MMA(b0, b1, kA[1]); IX_VAL(b0, b1, 2 * nf + 1, true); }
                else         { IX_MMA(a0, a1, kB[0]); IX_VAL(a0, a1, 2 * nf, true); IX_MMA(b0, b1, kB[1]); IX_VAL(b0, b1, 2 * nf + 1, true); }
            }
#undef IX_TICKET
#undef IX_TGET
#undef IX_LOAD
#undef IX_MMA
#undef IX_VAL
#pragma unroll
            for (int rb = 0; rb < 2; ++rb)
#pragma unroll
                for (int j2 = 0; j2 < 2; ++j2) { float s0_, s1_, q0_, q1_; row_sum2(ssum[rb][j2], s0_, s1_); row_sum2(ssq[rb][j2], q0_, q1_);
                    if (lane == 0) { LAS float* sp = st + wid * 16 + (4 * rb + j2) * 2; sp[0] = s0_; sp[1] = q0_; sp[4] = s1_; sp[5] = q1_; } }
            IX_QLOAD(u < 15 ? u + 1 : 15);
        }
        __syncthreads();
        if (F.tid == 0) ctr[(u + 1) & 1] = 0u;
        const int t = t0 + wid, n = t + 1;
        float v[64]; float ssum_ = 0.f, ssq_ = 0.f;
        if (n > 256) {
            const LAS float* cp = (lane < nj) ? (sc + wid * IX_ROW + lane * 68) : (const LAS float*)(F.lds + IX_NEG);
#pragma unroll
            for (int i = 0; i < 16; ++i) { const f32x4 x = *(const LAS f32x4*)(cp + 4 * i); v[4 * i] = x[0]; v[4 * i + 1] = x[1]; v[4 * i + 2] = x[2]; v[4 * i + 3] = x[3]; }
#pragma unroll
            for (int w = 0; w < NWAVES; ++w) { ssum_ += st[w * 16 + wid * 2]; ssq_ += st[w * 16 + wid * 2 + 1]; }
        } else {
#pragma unroll
            for (int i = 0; i < 64; ++i) v[i] = 0.f;
        }
        __syncthreads();
        unsigned mlo = 0u, mhi = 0u;
        if (n <= 256) {
            const int rem = n - 64 * lane;
            if (rem > 0) { mlo = rem >= 32 ? 0xFFFFFFFFu : ((1u << rem) - 1u); mhi = rem >= 64 ? 0xFFFFFFFFu : (rem > 32 ? ((1u << (rem - 32)) - 1u) : 0u); }
        } else {
            const float fn = (float)n, mean = ssum_ / fn; const float var = fmaxf(ssq_ / fn - mean * mean, 1e-20f), sd = sqrtf(var);
            const float zq = -probit(256.f / fn);
            const float dens = fmaxf(fn * 0.3989423f * __expf(-0.5f * zq * zq) / sd, 1e-3f);
            float xl = -3.0e38f, xh = __builtin_inff(), cl = fn, ch = 0.f; bool hasL = false, hasH = false; int side = 0, zst = 0;
            float x = mean + fminf(fmaxf(zq, -6.f), 6.f) * sd, step = 0.f; unsigned na = 0u, nb = 0u;
            float tie_v = 0.f; int tie_need = 0;
            const float DMIN = __builtin_bit_cast(float, 1u);
            int it = 0;
            for (;;) {
                ++it;
                unsigned kx = fkey(x); const unsigned kl = fkey(xl), kh = fkey(xh);
                if (!(kx > kl && kx < kh)) kx = kl + ((kh - kl) >> 1);
                x = fkey_inv(kx);
                const unsigned c = eval_mask(v, x, na, nb);
                if (c == 256u) break;
                if (c > 256u) { xl = x; cl = (float)c; hasL = true; if (side == 1) ch = 256.f + 0.5f * (ch - 256.f); side = 1; }
                else          { xh = x; ch = (float)c; hasH = true; if (side == 2) cl = 256.f + 0.5f * (cl - 256.f); side = 2; }
                const unsigned kl2 = fkey(xl), kh2 = fkey(xh);
                if (kh2 - kl2 <= 1u) {
                    const unsigned chx = eval_mask(v, xh, na, nb); tie_v = xl; tie_need = 256 - (int)chx; break; }
                if (!(hasL && hasH)) { step = (step == 0.f) ? fminf(fabsf((float)c - 256.5f) / dens * 1.25f + 0.02f * sd, 2.f * sd) : 2.f * step; x = (c > 256u) ? x + step : x - step; }
                else if (zst == 0 && it >= 2 && xl <= 0.f && xh > DMIN) { zst = 1; x = DMIN; }
                else if (zst == 1 && xh == DMIN && xl < 0.f) { zst = 2; x = 0.f; }
                else if (it >= 8 && (it & 1)) x = fkey_inv(kl2 + ((kh2 - kl2) >> 1));
                else x = xl + (xh - xl) * ((cl - 256.5f) / (cl - ch));
            }
            mlo = ~na; mhi = ~nb;
            if (tie_need > 0) {
                unsigned ce = 0;
#pragma unroll
                for (int i = 0; i < 64; ++i) ce += (v[i] == tie_v) ? 1u : 0u;
                unsigned pre = ce;
#pragma unroll
                for (int o = 1; o < 64; o <<= 1) { const unsigned y = __shfl_up(pre, o); pre += (lane >= o) ? y : 0u; }
                int allow = tie_need - (int)(pre - ce); allow = allow < 0 ? 0 : allow;
#pragma unroll
                for (int i = 0; i < 64; ++i) { if (v[i] == tie_v && allow > 0) { if (i < 32) mlo |= 1u << i; else mhi |= 1u << (i - 32); --allow; } }
            }
        }
        if (lane <= 4 * (t0 >> 8) + 3) BM[((size_t)b * 64 + lane) * 4096 + t] = ((u64)mhi << 32) | mlo;
    }
    __syncthreads();
}

constexpr int AL_K = 0, AL_V = 16384, AL_M = 32768, AL_LUT = 36864, AL_WS = 37888, AL_OST = 40960;
constexpr int OST_STRIDE = 68;
__device__ __forceinline__ float sel_bfi(unsigned m, unsigned a, unsigned b) { unsigned d; asm("v_bfi_b32 %0, %1, %2, %3" : "=v"(d) : "v"(m), "v"(a), "s"(b)); return __builtin_bit_cast(float, d); }
__device__ __forceinline__ int crow(int r, int hi) { return (r & 3) + 8 * (r >> 2) + 4 * hi; }
__device__ __forceinline__ void attn_unit(Frame& F, int b, int h, int qb) {
    const h16* Q = (const h16*)(F.ws + WS_Q); const h16* Kg = (const h16*)(F.ws + WS_K); const h16* Vg = (const h16*)(F.ws + WS_V); const u64* BM = (const u64*)(F.ws + WS_BM);
    h16* MG = (h16*)(F.ws + WS_MERGED);
    const int tid = F.tid, lane = F.lane, wid = F.wave, r32 = lane & 31, hi = lane >> 5, grp = wid >> 2;
    const size_t rowb = (size_t)b * SEQ; const int q0 = qb * 256;
    LAS unsigned char* L = F.lds;
    LAS float* lut = (LAS float*)(L + AL_LUT); LAS float* wsf = (LAS float*)(L + AL_WS) + wid * 64; LAS float* ost = (LAS float*)(L + AL_OST) + wid * (32 * OST_STRIDE);
    if (tid < 129) lut[tid] = F.in[2][T5_BKT[tid] * 8 + h] * LOG2E;
    const float cfar = F.in[2][31 * 8 + h] * LOG2E;
    const int NT = (q0 + 256) / 64;
    const h16* ksrc = Kg + (size_t)(b * 8 + h) * 64 * 4096 + wid * 512 + lane * 8;
    const h16* vsrc = Vg + (size_t)(b * 8 + h) * 64 * 4096 + wid * 512 + lane * 8;
    const u64* msrc = BM + (size_t)b * 64 * 4096 + q0 + wid * 32 + r32;
    u32x4 kreg, vreg;
#define A_LOAD(t) do { kreg = *(const u32x4*)(ksrc + (size_t)(t) * 4096); vreg = *(const u32x4*)(vsrc + (size_t)(t) * 4096); } while (0)
#define A_STORE(buf) do { *(LAS u32x4*)(L + AL_K + (buf) * 8192 + wid * 1024 + lane * 16) = kreg; *(LAS u32x4*)(L + AL_V + (buf) * 8192 + wid * 1024 + lane * 16) = vreg; } while (0)
#define A_BAR() asm volatile("s_barrier" ::: "memory")
    const int qpos = q0 + wid * 32 + r32;
    const int qmin = q0 + wid * 32;
    const unsigned NEGINF = 0xFF800000u;
    float mref = 0.f, lrun = 0.f; bool hasmass = false; f32x16 o[2]; o[0] = f32x16{}; o[1] = f32x16{};
    f32x16 p0, p1;
#define A_COP(t_, mw_) do { const unsigned wl = (unsigned)(mw_) >> (4 * hi), wh = (unsigned)((mw_) >> 32) >> (4 * hi); \
        if ((qmin - (64 * (t_) + 63)) >= 128) { const unsigned cb = __builtin_bit_cast(unsigned, cfar - mref); \
            _Pragma("unroll") for (int r = 0; r < 16; ++r) { const int c = (r & 3) + 8 * (r >> 2); const unsigned s0 = (unsigned)__builtin_amdgcn_sbfe((int)wl, c, 1), s1 = (unsigned)__builtin_amdgcn_sbfe((int)wh, c, 1); \
                p0[r] = sel_bfi(s0, cb, NEGINF); p1[r] = sel_bfi(s1, cb, NEGINF); } \
        } else { const int base = qpos - 64 * (t_) - 4 * hi; \
            _Pragma("unroll") for (int r = 0; r < 16; ++r) { const int c = (r & 3) + 8 * (r >> 2); int i0 = base - c, i1 = base - c - 32; i0 = i0 < 0 ? 0 : (i0 > 128 ? 128 : i0); i1 = i1 < 0 ? 0 : (i1 > 128 ? 128 : i1); \
                const unsigned s0 = (unsigned)__builtin_amdgcn_sbfe((int)wl, c, 1), s1 = (unsigned)__builtin_amdgcn_sbfe((int)wh, c, 1); \
                const unsigned c0 = __builtin_bit_cast(unsigned, lut[i0] - mref), c1 = __builtin_bit_cast(unsigned, lut[i1] - mref); \
                p0[r] = sel_bfi(s0, c0, NEGINF); p1[r] = sel_bfi(s1, c1, NEGINF); } } } while (0)
    u64 mw, mwn;
    { const u32x4 k0r = *(const u32x4*)ksrc, v0r = *(const u32x4*)vsrc;
      A_LOAD(1); mw = msrc[0]; mwn = msrc[4096];
      *(LAS u32x4*)(L + AL_K + wid * 1024 + lane * 16) = k0r; *(LAS u32x4*)(L + AL_V + wid * 1024 + lane * 16) = v0r; }
    f16x8 qr[4];
    { const h16* qp = Q + (rowb + q0 + wid * 32 + r32) * 512 + h * 64 + hi * 8;
#pragma unroll
      for (int d0 = 0; d0 < 4; ++d0) qr[d0] = *(const f16x8*)(qp + d0 * 16); }
    __syncthreads();
    if (grp == 1) A_BAR();
    A_COP(0, mw); mw = mwn;
    const int vboff = ((lane >> 4) & 1) * 32 + (lane & 3) * 8 + (4 * hi + ((lane & 15) >> 2)) * 64;
    for (int t = 0; t < NT; ++t) {
        const int cur = t & 1;
        f16x8 kfr[8];
        { const LAS unsigned char* kb = L + AL_K + cur * 8192 + hi * 1024 + r32 * 16;
#pragma unroll
          for (int d0 = 0; d0 < 4; ++d0) { kfr[2 * d0] = *(const LAS f16x8*)(kb + d0 * 2048); kfr[2 * d0 + 1] = *(const LAS f16x8*)(kb + d0 * 2048 + 512); } }
        A_STORE(cur ^ 1);
        { const int tl = (t + 2 < NT) ? t + 2 : NT - 1; A_LOAD(tl); mwn = msrc[(size_t)tl * 4096]; }
        s16x4 vlo[8], vhi[8];
        { LAS unsigned char* vb = L + AL_V + cur * 8192 + vboff;
#pragma unroll
          for (int i = 0; i < 8; ++i) { vlo[i] = __builtin_amdgcn_ds_read_tr16_b64_v4i16((LAS s16x4*)(vb + (i >> 2) * 4096 + (i & 3) * 1024)); vhi[i] = __builtin_amdgcn_ds_read_tr16_b64_v4i16((LAS s16x4*)(vb + (i >> 2) * 4096 + (i & 3) * 1024 + 512)); } }
        __builtin_amdgcn_sched_barrier(0);
#pragma unroll
        for (int d0 = 0; d0 < 4; ++d0) { p0 = __builtin_amdgcn_mfma_f32_32x32x16_f16(kfr[2 * d0], qr[d0], p0, 0, 0, 0); p1 = __builtin_amdgcn_mfma_f32_32x32x16_f16(kfr[2 * d0 + 1], qr[d0], p1, 0, 0, 0); }
        __builtin_amdgcn_sched_barrier(0);
        asm volatile("s_waitcnt lgkmcnt(0)\n\ts_barrier" ::: "memory");
        __builtin_amdgcn_sched_barrier(0);
        float rs = 0.f;
#pragma unroll
        for (int r = 0; r < 16; ++r) { p0[r] = __builtin_amdgcn_exp2f(p0[r]); p1[r] = __builtin_amdgcn_exp2f(p1[r]); rs += p0[r] + p1[r]; }
        const float pm = rs + __shfl_xor(rs, 32);
        const bool need = (pm > 256.f) || (!hasmass && pm > 0.f);
        if (__any(need)) {
            const float f = need ? 1.f / pm : 1.f;
            mref += need ? __builtin_amdgcn_logf(pm) : 0.f;
            rs *= f; lrun *= f;
#pragma unroll
            for (int r = 0; r < 16; ++r) { float a_ = p0[r], b_ = p1[r]; asm("v_mul_f32 %0, %0, %1" : "+v"(a_) : "v"(f)); asm("v_mul_f32 %0, %0, %1" : "+v"(b_) : "v"(f)); p0[r] = a_; p1[r] = b_; }
            if (hi == 0) wsf[r32] = f;
            LDS_WAIT();
#pragma unroll
            for (int r = 0; r < 16; ++r) { const float a = wsf[crow(r, hi)]; o[0][r] *= a; o[1][r] *= a; }
        }
        hasmass = hasmass || (pm > 0.f);
        lrun += rs;
        u32x4 pw[4];
        pw[0] = (u32x4){pk2h(p0[0], p0[1]), pk2h(p0[2], p0[3]), pk2h(p0[4], p0[5]), pk2h(p0[6], p0[7])};
        pw[1] = (u32x4){pk2h(p0[8], p0[9]), pk2h(p0[10], p0[11]), pk2h(p0[12], p0[13]), pk2h(p0[14], p0[15])};
        pw[2] = (u32x4){pk2h(p1[0], p1[1]), pk2h(p1[2], p1[3]), pk2h(p1[4], p1[5]), pk2h(p1[6], p1[7])};
        pw[3] = (u32x4){pk2h(p1[8], p1[9]), pk2h(p1[10], p1[11]), pk2h(p1[12], p1[13]), pk2h(p1[14], p1[15])};
        __builtin_amdgcn_sched_barrier(0);
#pragma unroll
        for (int d0 = 0; d0 < 2; ++d0)
#pragma unroll
            for (int ks = 0; ks < 4; ++ks) { const int i = d0 * 4 + ks;
                typedef short s16x8 __attribute__((ext_vector_type(8)));
                const s16x8 vv = {vlo[i][0], vlo[i][1], vlo[i][2], vlo[i][3], vhi[i][0], vhi[i][1], vhi[i][2], vhi[i][3]};
                o[d0] = __builtin_amdgcn_mfma_f32_32x32x16_f16(__builtin_bit_cast(f16x8, pw[ks]), __builtin_bit_cast(f16x8, vv), o[d0], 0, 0, 0); }
        A_COP(t + 1, mw); mw = mwn;
        A_BAR();
    }
    if (grp == 0) A_BAR();
#undef A_LOAD
#undef A_STORE
#undef A_BAR
#undef A_COP
    lrun += __shfl_xor(lrun, 32);
    if (hi == 0) wsf[r32] = 1.f / lrun;
    LDS_WAIT();
#pragma unroll
    for (int r = 0; r < 16; ++r) { const float rl = wsf[crow(r, hi)]; const int qrow = crow(r, hi);
        ost[qrow * OST_STRIDE + r32] = o[0][r] * rl; ost[qrow * OST_STRIDE + 32 + r32] = o[1][r] * rl; }
    LDS_WAIT();
    { const int row = lane >> 1, hf = lane & 1; const LAS float* rp = ost + row * OST_STRIDE + hf * 32;
      f32x4 xv[8]; float ss = 0.f;
#pragma unroll
      for (int i = 0; i < 8; ++i) { xv[i] = *(const LAS f32x4*)(rp + 4 * i); ss += (xv[i][0] * xv[i][0] + xv[i][1] * xv[i][1]) + (xv[i][2] * xv[i][2] + xv[i][3] * xv[i][3]); }
      ss += __shfl_xor(ss, 1);
      const float rstd = rsqrtf(ss * (1.f / 64.f) + EPS);
      const float* gn = F.in[10] + h * 64 + hf * 32;
      h16* op = MG + (rowb + q0 + wid * 32 + row) * 1024 + h * 64 + hf * 32;
#pragma unroll
      for (int i = 0; i < 4; ++i) { const f32x4 g0 = *(const f32x4*)(gn + 8 * i), g1 = *(const f32x4*)(gn + 8 * i + 4);
          *(u32x4*)(op + 8 * i) = pk8h(xv[2 * i] * rstd * g0, xv[2 * i + 1] * rstd * g1); } }
    __syncthreads();
}
__device__ __forceinline__ void p4_attention(Frame& F) {
    const int bh = F.vcu >> 2, c = F.vcu & 3;
    for (int i = 0; i < 4; ++i) { const int qb = (i == 0) ? 2 * c : (i == 1) ? 15 - 2 * c : (i == 2) ? 2 * c + 1 : 14 - 2 * c; attn_unit(F, bh >> 3, bh & 7, qb); }
}

__device__ __forceinline__ void p6_norm2_route(Frame& F) {
    const float* mod = (const float*)(F.ws + WS_MOD); const float* g2 = F.in[13]; h16* H2 = (h16*)(F.ws + WS_H); const float* x1 = F.out;
    const h16* WRLg = (const h16*)(F.ws + WS_WRL);
    LAS h16* wrl = (LAS h16*)F.lds;
    LAS unsigned* lcnt = (LAS unsigned*)(F.lds + 73728);
    LAS unsigned* lbase = lcnt + 32;
    LAS unsigned* rinfo = (LAS unsigned*)(F.lds + 73728 + 256);
    for (int i = F.tid; i < 36 * 1024 / 8; i += NTHR) *(LAS u32x4*)(wrl + i * 8) = *(const u32x4*)(WRLg + i * 8);
    if (F.tid < 32) lcnt[F.tid] = 0u;
    __syncthreads();
    const int b = F.vcu >> 5;
    const float* bgr = F.in[15]; const float* ber = F.in[17];
    f32x4 gg[4], hh[4];
#pragma unroll
    for (int j = 0; j < 4; ++j) { const int col = 4 * F.lane + 256 * j; gg[j] = *(const f32x4*)(g2 + col) * (*(const f32x4*)(mod + (size_t)b * 6144 + 4096 + col) + 1.f); hh[j] = *(const f32x4*)(mod + (size_t)b * 6144 + 3072 + col); }
    f32x4 vn[4];
    { const size_t row = (size_t)F.vcu * 128 + F.wave * 16;
#pragma unroll
      for (int j = 0; j < 4; ++j) vn[j] = *(const f32x4*)(x1 + row * 1024 + 4 * F.lane + 256 * j); }
    for (int rr = 0; rr < 16; ++rr) {
        const int lrow = F.wave * 16 + rr; const size_t row = (size_t)F.vcu * 128 + lrow; const size_t rown = row + (rr < 15 ? 1 : 0);
        f32x4 v[4]; float ss = 0.f;
#pragma unroll
        for (int j = 0; j < 4; ++j) { v[j] = vn[j]; vn[j] = *(const f32x4*)(x1 + rown * 1024 + 4 * F.lane + 256 * j); ss += (v[j][0] * v[j][0] + v[j][1] * v[j][1]) + (v[j][2] * v[j][2] + v[j][3] * v[j][3]); }
        const float rstd = rsqrtf(dpp_sum_f32(ss) * (1.f / 1024.f) + EPS);
#pragma unroll
        for (int j = 0; j < 4; ++j) { v[j] = v[j] * rstd * gg[j] + hh[j]; u32x2 w; w.x = pk2h(v[j][0], v[j][1]); w.y = pk2h(v[j][2], v[j][3]); *(u32x2*)(H2 + row * 1024 + 4 * F.lane + 256 * j) = w; }
        float lg[4];
#pragma unroll
        for (int o = 0; o < 4; ++o) { const f16x8 wa = *(const LAS f16x8*)(wrl + (o * 64 + F.lane) * 16), wb = *(const LAS f16x8*)(wrl + (o * 64 + F.lane) * 16 + 8);
            float s = 0.f;
#pragma unroll
            for (int i = 0; i < 4; ++i) { s += v[0][i] * (float)wa[i]; s += v[1][i] * (float)wa[4 + i]; s += v[2][i] * (float)wb[i]; s += v[3][i] * (float)wb[4 + i]; }
            lg[o] = dpp_sum_f32(s) + bgr[o]; }
        int gs = 0; float gm = lg[0];
#pragma unroll
        for (int g = 1; g < 4; ++g) if (lg[g] > gm) { gm = lg[g]; gs = g; }
        float gden = 0.f;
#pragma unroll
        for (int g = 0; g < 4; ++g) gden += __expf(lg[g] - gm);
        const float pg = 1.f / gden;
        gs = __builtin_amdgcn_readfirstlane(gs);
        float el[8];
        { const LAS h16* wsel = wrl + ((4 + 8 * gs) * 64 + F.lane) * 16; const float* bsel = ber + 8 * gs;
#pragma unroll
          for (int e = 0; e < 8; ++e) { const f16x8 wa = *(const LAS f16x8*)(wsel + e * 1024), wb = *(const LAS f16x8*)(wsel + e * 1024 + 8);
            float s = 0.f;
#pragma unroll
            for (int i = 0; i < 4; ++i) { s += v[0][i] * (float)wa[i]; s += v[1][i] * (float)wa[4 + i]; s += v[2][i] * (float)wb[i]; s += v[3][i] * (float)wb[4 + i]; }
            el[e] = dpp_sum_f32(s) + bsel[e]; } }
        int e0 = 0; float m0 = el[0];
#pragma unroll
        for (int e = 1; e < 8; ++e) if (el[e] > m0) { m0 = el[e]; e0 = e; }
        int e1 = -1; float m1 = -__builtin_inff();
#pragma unroll
        for (int e = 0; e < 8; ++e) if (e != e0 && el[e] > m1) { m1 = el[e]; e1 = e; }
        const float p1 = __expf(m1 - m0); const float w0 = pg / (1.f + p1), w1 = pg * p1 / (1.f + p1);
        if (F.lane == 0) {
            const unsigned E0 = (unsigned)(gs * 8 + e0), E1 = (unsigned)(gs * 8 + e1);
            const unsigned r0 = atomicAdd((unsigned*)(lcnt + E0), 1u), r1 = atomicAdd((unsigned*)(lcnt + E1), 1u);
            rinfo[lrow * 8 + 0] = E0; rinfo[lrow * 8 + 1] = r0; rinfo[lrow * 8 + 2] = __builtin_bit_cast(unsigned, w0);
            rinfo[lrow * 8 + 3] = E1; rinfo[lrow * 8 + 4] = r1; rinfo[lrow * 8 + 5] = __builtin_bit_cast(unsigned, w1);
        }
    }
    __syncthreads();
    unsigned* gcnt = (unsigned*)(F.ws + WS_CTL) + CW_GCNT;
    if (F.tid < 32) lbase[F.tid] = atomicAdd(gcnt + F.tid, lcnt[F.tid]);
    __syncthreads();
    if (F.tid < 128) { unsigned* ro = (unsigned*)(F.ws + WS_ROUTE) + ((size_t)F.vcu * 128 + F.tid) * 8;
        const unsigned E0 = rinfo[F.tid * 8 + 0], E1 = rinfo[F.tid * 8 + 3];
        ro[0] = E0; ro[1] = lbase[E0] + rinfo[F.tid * 8 + 1]; ro[2] = rinfo[F.tid * 8 + 2]; ro[3] = E1; ro[4] = lbase[E1] + rinfo[F.tid * 8 + 4]; ro[5] = rinfo[F.tid * 8 + 5]; }
    __syncthreads();
}
__device__ __forceinline__ void expert_offsets(Frame& F, LAS unsigned* off) {
    const unsigned* gcnt = (const unsigned*)(F.ws + WS_CTL) + CW_GCNT;
    if (F.tid == 0) { unsigned a = 0; for (int e = 0; e < 32; ++e) { off[e] = a; a += (__hip_atomic_load(gcnt + e, RLX_AGENT) + 255u) & ~255u; } off[32] = a; }
    __syncthreads();
}
__device__ __forceinline__ void p7_rowmap(Frame& F) {
    LAS unsigned* off = (LAS unsigned*)F.lds;
    expert_offsets(F, off);
    int* rowmap = (int*)(F.ws + WS_ROWMAP); const unsigned* gcnt = (const unsigned*)(F.ws + WS_CTL) + CW_GCNT; int* tile_e = (int*)(F.ws + WS_CTL) + 1024;
    if (F.tid < 128) { const size_t tok = (size_t)F.vcu * 128 + F.tid; const unsigned* ro = (const unsigned*)(F.ws + WS_ROUTE) + tok * 8;
        rowmap[off[ro[0]] + ro[1]] = (int)tok; rowmap[off[ro[3]] + ro[4]] = (int)tok; }
    if (F.vcu < 32) { const int e = F.vcu; const unsigned c = __hip_atomic_load(gcnt + e, RLX_AGENT); for (unsigned r = off[e] + c + F.tid; r < off[e + 1]; r += NTHR) rowmap[r] = -1;
        for (unsigned t = off[e] / 256 + F.tid; t < off[e + 1] / 256; t += NTHR) tile_e[t] = e; }
    __syncthreads();
}
__device__ __forceinline__ void p10_combine(Frame& F) {
    LAS unsigned* off = (LAS unsigned*)F.lds;
    expert_offsets(F, off);
    const float* mod = (const float*)(F.ws + WS_MOD); const h16* Y = (const h16*)(F.ws + WS_Y); float* out = F.out;
    const int b = F.vcu >> 5;
    f32x4 g2[4];
#pragma unroll
    for (int j = 0; j < 4; ++j) g2[j] = *(const f32x4*)(mod + (size_t)b * 6144 + 5120 + 4 * F.lane + 256 * j);
    const size_t rowbase = (size_t)F.vcu * 128 + F.wave * 16;
    unsigned P0l = 0u, P1l = 0u; float C0l = 0.f, C1l = 0.f;
    if (F.lane < 16) { const unsigned* ro = (const unsigned*)(F.ws + WS_ROUTE) + (rowbase + F.lane) * 8; P0l = off[ro[0]] + ro[1]; P1l = off[ro[3]] + ro[4]; C0l = __builtin_bit_cast(float, ro[2]); C1l = __builtin_bit_cast(float, ro[5]); }
    f16x4 y0n[4], y1n[4]; f32x4 xn[4];
    { const size_t p0 = (unsigned)__shfl((int)P0l, 0), p1 = (unsigned)__shfl((int)P1l, 0);
#pragma unroll
      for (int j = 0; j < 4; ++j) { const int col = 4 * F.lane + 256 * j; y0n[j] = *(const f16x4*)(Y + p0 * 1024 + col); y1n[j] = *(const f16x4*)(Y + p1 * 1024 + col); xn[j] = *(const f32x4*)(out + rowbase * 1024 + col); } }
    for (int rr = 0; rr < 16; ++rr) {
        const size_t row = rowbase + rr; const int rn = rr < 15 ? rr + 1 : rr;
        const float c0 = __shfl(C0l, rr), c1 = __shfl(C1l, rr);
        const size_t p0n = (unsigned)__shfl((int)P0l, rn), p1n = (unsigned)__shfl((int)P1l, rn);
#pragma unroll
        for (int j = 0; j < 4; ++j) { const int col = 4 * F.lane + 256 * j;
            const f16x4 y0 = y0n[j], y1 = y1n[j]; f32x4 xv = xn[j];
            y0n[j] = *(const f16x4*)(Y + p0n * 1024 + col); y1n[j] = *(const f16x4*)(Y + p1n * 1024 + col); xn[j] = *(const f32x4*)(out + (rowbase + rn) * 1024 + col);
#pragma unroll
            for (int i = 0; i < 4; ++i) xv[i] += g2[j][i] * (c0 * (float)y0[i] + c1 * (float)y1[i]);
            *(f32x4*)(out + row * 1024 + col) = xv; }
    }
}
constexpr int N_PHASES = 12;
__global__ void __launch_bounds__(NTHR, 2) mega_fwd(Args args) {
    extern __shared__ __attribute__((aligned(16))) unsigned char lds_raw[];
    Frame F;
    F.lds = (LAS unsigned char*)lds_raw; F.ldsg = lds_raw;
    F.tid = threadIdx.x; F.lane = F.tid & 63; F.wave = __builtin_amdgcn_readfirstlane(F.tid >> 6);
    F.G = gridDim.x; { const int bx = blockIdx.x; F.vcu = (F.G % 8 == 0) ? (bx % 8) * (F.G / 8) + bx / 8 : bx; }
    F.in = (const float* const __attribute__((address_space(4)))*)__builtin_amdgcn_kernarg_segment_ptr();
    F.out = args.out; F.ws = args.ws;
    volatile LAS unsigned* MISC = (volatile LAS unsigned*)(F.lds + MISC_OFF);
    if (F.tid < 16) MISC[F.tid] = 0u;
    __syncthreads();
    const int lo = args.ph_lo, hi = args.ph_hi;
    XcdBarrier bar; bar.bar = (unsigned*)(F.ws + WS_CTL) + CW_BAR; bar.x = 0; bar.st = nullptr;
    if (hi - lo > 1) bar = xcd_barrier_post((unsigned*)(F.ws + WS_CTL) + CW_BAR, MISC + 8);
#define IN(k) (lo <= (k) && (k) < hi)
#define STAMP(k) do {} while (0)
#define SEAM(k) do { if (IN(k) && IN((k) + 1)) xcd_barrier(bar); STAMP((k) + 1); } while (0)
    STAMP(0);
    if (IN(0)) { p0_prologue(F); }
    if (lo < 0) { cg::this_grid().sync(); }
    SEAM(0);
    if (IN(1)) { p1_norm1(F); }
    SEAM(1);
    if (IN(2)) {
        pg8::Gemm g{(const h16*)(F.ws + WS_H), (const h16*)(F.ws + WS_WINT), M, NINP, DM, 0, nullptr}; pg8::StaticOrder S; S.init(M, NINP, F.G, (int)blockIdx.x);
        EpiInProj E{(h16*)(F.ws + WS_Q), (h16*)(F.ws + WS_K), (h16*)(F.ws + WS_V), (h16*)(F.ws + WS_QI), (h16*)(F.ws + WS_KI), (h16*)(F.ws + WS_GB), (h16*)(F.ws + WS_Z), (float*)(F.ws + WS_WI), F.in[7], F.in[8]};
        pg8::gemm_phase<EpiInProj, pg8::StaticOrder, false>(F.lds, g, S, E);
    }
    SEAM(2);
    if (IN(3)) { p3_conv(F); p3_indexer(F); }
    SEAM(3);
    if (IN(4)) { p4_attention(F); }
    SEAM(4);
    if (IN(5)) {
        pg8::Gemm g{(const h16*)(F.ws + WS_MERGED), (const h16*)(F.ws + WS_WOUTT), M, DM, DM, 0, nullptr}; pg8::StaticOrder S; S.init(M, DM, F.G, (int)blockIdx.x);
        EpiOutProj E{F.in[0], F.out, (const float*)(F.ws + WS_MOD)};
        pg8::gemm_phase<EpiOutProj, pg8::StaticOrder, false>(F.lds, g, S, E);
    }
    SEAM(5);
    if (IN(6)) { p6_norm2_route(F); }
    SEAM(6);
    if (IN(7)) { p7_rowmap(F); }
    SEAM(7);
    if (IN(8) || IN(9) || IN(10)) {
        LAS unsigned* off = (LAS unsigned*)(F.lds + RING_BYTES); expert_offsets(F, off); const int ntiles = (int)(off[32] / 256u); __syncthreads();
        const int* tile_e = (const int*)(F.ws + WS_CTL) + 1024;
        const int n8 = 2 * ntiles, R8 = n8 / F.G, rem8 = n8 - R8 * F.G;
        const int pmA = (R8 * F.G) / 2;
        const int n9 = 4 * ntiles; constexpr int PB = 4, PA = 2;
        int nB = PB * (F.G - rem8) + PA * rem8; nB = nB < 4 * pmA ? nB : 4 * pmA; nB = nB < n9 ? nB : n9;
        const pg8::Gemm gU{(const h16*)(F.ws + WS_H), (const h16*)(F.ws + WS_WGUT), 0, 512, DM, (size_t)512 * 1024 * 2, (const int*)(F.ws + WS_ROWMAP)};
        const pg8::Gemm gD{(const h16*)(F.ws + WS_HID), (const h16*)(F.ws + WS_WDT), 0, 1024, EFF, (size_t)1024 * 256 * 2, nullptr};
        const EpiMoeUp EU{(h16*)(F.ws + WS_HID)}; const EpiMoeDown ED{(h16*)(F.ws + WS_Y)};
        if (IN(8)) { pg8::GroupedOrder S{tile_e, 2, F.vcu, F.G, R8}; pg8::gemm_phase<EpiMoeUp, pg8::GroupedOrder, true>(F.lds, gU, S, EU); }
        SEAM(8);
        if (IN(9)) {
            if (F.vcu < rem8) { pg8::GroupedOrder S{tile_e, 2, R8 * F.G + F.vcu, F.G, 1}; pg8::gemm_phase<EpiMoeUp, pg8::GroupedOrder, true>(F.lds, gU, S, EU); }
            { const bool up = F.vcu < rem8; const int f = up ? PB * (F.G - rem8) + PA * F.vcu : PB * (F.vcu - rem8); const int cap = up ? PA : PB; int n = nB - f; n = n < 0 ? 0 : (n > cap ? cap : n);
              pg8::GroupedOrder S{tile_e, 4, f, 1, n}; pg8::gemm_phase<EpiMoeDown, pg8::GroupedOrder, false>(F.lds, gD, S, ED); }
        }
        SEAM(9);
        if (IN(10)) { const int f = nB + F.vcu; const int n = f < n9 ? (n9 - f + F.G - 1) / F.G : 0;
            pg8::GroupedOrder S{tile_e, 4, f, F.G, n}; pg8::gemm_phase<EpiMoeDown, pg8::GroupedOrder, false>(F.lds, gD, S, ED); }
    }
    SEAM(10);
    if (IN(11)) { p10_combine(F); }

#undef IN
#undef SEAM
}

extern "C" void kernel_launch(void* const* d_in, const int* in_sizes, int n_in, void* d_out, int out_size, void* d_ws, size_t ws_size, hipStream_t stream) {
    static int grid = 0;
    if (grid == 0) {
        if (n_in != 21 || out_size != M * DM || ws_size < WS_END) { fprintf(stderr, "kernel_launch: unexpected shapes (n_in %d out %d ws %zu)\n", n_in, out_size, ws_size); grid = -1; return; }
        int dev = 0, cus = 0, per_cu = 0;
        (void)hipGetDevice(&dev); (void)hipDeviceGetAttribute(&cus, hipDeviceAttributeMultiprocessorCount, dev);
        if (hipFuncSetAttribute((const void*)mega_fwd, hipFuncAttributeMaxDynamicSharedMemorySize, LDS_BYTES) != hipSuccess) { fprintf(stderr, "kernel_launch: hipFuncSetAttribute failed\n"); grid = -1; return; }
        if (hipOccupancyMaxActiveBlocksPerMultiprocessor(&per_cu, (const void*)mega_fwd, NTHR, LDS_BYTES) != hipSuccess || per_cu < 1) { fprintf(stderr, "kernel_launch: occupancy query says %d\n", per_cu); per_cu = 1; }
        (void)hipGetLastError();
        grid = cus;
        if (grid != 256) { fprintf(stderr, "kernel_launch: built for 256 CUs, got %d\n", grid); }
    }
    if (grid < 0) return;
    (void)hipMemsetAsync((char*)d_ws + WS_CTL, 0, CTL_ZERO_BYTES, stream);
    Args a{};
    for (int i = 0; i < 21; ++i) a.in[i] = (const float*)d_in[i];
    a.out = (float*)d_out; a.ws = (unsigned char*)d_ws;
#if MK_N_LAUNCHES == 1
    a.ph_lo = 0; a.ph_hi = N_PHASES;
    void* kargs[] = {&a};
    hipError_t e = hipLaunchCooperativeKernel((const void*)mega_fwd, dim3(grid), dim3(NTHR), kargs, LDS_BYTES, stream);
    if (e != hipSuccess) fprintf(stderr, "cooperative launch failed: %s\n", hipGetErrorString(e));
#else
    for (int p = 0; p < N_PHASES; ++p) { a.ph_lo = p; a.ph_hi = p + 1; hipLaunchKernelGGL(mega_fwd, dim3(grid), dim3(NTHR), LDS_BYTES, stream, a); }
#endif
}
```

```cpp
#include <hip/hip_runtime.h>
#include <hip/hip_cooperative_groups.h>
#include <cstdio>
#include <cstdint>
namespace cg = cooperative_groups;

#ifndef MK_N_LAUNCHES

#define MK_N_LAUNCHES 1
#endif

#define LAS __attribute__((address_space(3)))
#define GAS __attribute__((address_space(1)))
typedef _Float16 h16;
typedef _Float16 f16x8 __attribute__((ext_vector_type(8)));
typedef _Float16 f16x4 __attribute__((ext_vector_type(4)));
typedef _Float16 f16x2 __attribute__((ext_vector_type(2)));
typedef short s16x4 __attribute__((ext_vector_type(4)));
typedef float f32x2 __attribute__((ext_vector_type(2)));
typedef float f32x4 __attribute__((ext_vector_type(4)));
typedef float f32x16 __attribute__((ext_vector_type(16)));
typedef unsigned u32x2 __attribute__((ext_vector_type(2)));
typedef unsigned u32x4 __attribute__((ext_vector_type(4)));
typedef unsigned long long u64;

constexpr int BATCH = 8, SEQ = 4096, DM = 1024, M = BATCH * SEQ;
constexpr int NINP = 3840;
constexpr int NEXP = 32, EFF = 256;
constexpr int MAXROWS = 2 * M + NEXP * 256;
constexpr float EPS = 1e-6f;
constexpr float LOG2E = 1.4426950408889634f;
constexpr float QSCALE = 0.125f * LOG2E;
constexpr float IDX_SCALE = 0.125f * 0.35355339059327373f;
constexpr int NWAVES = 8, NTHR = 512;

constexpr size_t MiB = 1u << 20;
constexpr size_t WS_CTL = 0, CTL_ZERO_BYTES = 64 * 1024;
constexpr size_t WS_MODP = 1 * MiB;
constexpr size_t WS_MOD = 4 * MiB;
constexpr size_t WS_ROUTE = 5 * MiB;
constexpr size_t WS_ROWMAP = 6 * MiB + 512 * 1024;
constexpr size_t WS_WINT = 8 * MiB;
constexpr size_t WS_WOUTT = 16 * MiB;
constexpr size_t WS_WRL = 18 * MiB;
constexpr size_t WS_WGUT = 20 * MiB;
constexpr size_t WS_WDT = 52 * MiB;
constexpr size_t WS_H = 72 * MiB;
constexpr size_t WS_Q = 136 * MiB, WS_K = 168 * MiB, WS_V = 200 * MiB, WS_QI = 232 * MiB;
constexpr size_t WS_KI = 264 * MiB;
constexpr size_t WS_WI = 268 * MiB;
constexpr size_t WS_GB = 270 * MiB, WS_Z = 302 * MiB;
constexpr size_t WS_BM = 334 * MiB;
constexpr size_t WS_MERGED = 350 * MiB;
constexpr size_t WS_HID = 416 * MiB;
constexpr size_t WS_Y = 136 * MiB;
constexpr size_t WS_END = 456 * MiB;
static_assert(WS_Y + (size_t)MAXROWS * 1024 * 2 <= WS_Z + 32 * MiB, "Y overlay");
static_assert(WS_HID + (size_t)MAXROWS * 256 * 2 <= WS_END, "HID");
constexpr int CW_GCNT = 64;
constexpr int CW_BAR = 4096;

constexpr int LDS_BYTES = 147456;
constexpr int RING_BYTES = 131072;
constexpr int MISC_OFF = 147456 - 256;

__device__ const unsigned char T5_BKT[129] = {0, 1, 2, 3, 4, 5, 6, 7, 8, 9, 10, 11, 12, 13, 14, 15, 16, 16, 16, 17, 17, 18, 18, 18, 19, 19, 19, 20, 20, 20, 20, 21, 21, 21, 21, 22, 22, 22, 22, 22, 23, 23, 23, 23, 23, 23, 24, 24, 24, 24, 24, 24, 25, 25, 25, 25, 25, 25, 25, 26, 26, 26, 26, 26, 26, 26, 26, 27, 27, 27, 27, 27, 27, 27, 27, 27, 27, 28, 28, 28, 28, 28, 28, 28, 28, 28, 28, 29, 29, 29, 29, 29, 29, 29, 29, 29, 29, 29, 29, 30, 30, 30, 30, 30, 30, 30, 30, 30, 30, 30, 30, 30, 30, 31, 31, 31, 31, 31, 31, 31, 31, 31, 31, 31, 31, 31, 31, 31, 31};

#define LDS_WAIT() asm volatile("s_waitcnt lgkmcnt(0)" ::: "memory")
#define VM_WAIT() asm volatile("s_waitcnt vmcnt(0)" ::: "memory")
#define RLX_AGENT __ATOMIC_RELAXED, __HIP_MEMORY_SCOPE_AGENT
__device__ __forceinline__ unsigned pk2h(float lo, float hi) { f32x2 v = {lo, hi}; f16x2 h = __builtin_convertvector(v, f16x2); return __builtin_bit_cast(unsigned, h); }
__device__ __forceinline__ u32x4 pk8h(f32x4 a, f32x4 b) { u32x4 w; w.x = pk2h(a[0], a[1]); w.y = pk2h(a[2], a[3]); w.z = pk2h(b[0], b[1]); w.w = pk2h(b[2], b[3]); return w; }
__device__ __forceinline__ float wave_sum(float v) {
#pragma unroll
    for (int o = 1; o < 64; o <<= 1) v += __shfl_xor(v, o);
    return v;
}
__device__ __forceinline__ unsigned dpp_sum_u32(unsigned v) {
    v += (unsigned)__builtin_amdgcn_update_dpp(0, (int)v, 0xB1, 0xf, 0xf, false);
    v += (unsigned)__builtin_amdgcn_update_dpp(0, (int)v, 0x4E, 0xf, 0xf, false);
    v += (unsigned)__builtin_amdgcn_update_dpp(0, (int)v, 0x141, 0xf, 0xf, false);
    v += (unsigned)__builtin_amdgcn_update_dpp(0, (int)v, 0x140, 0xf, 0xf, false);
    return __builtin_amdgcn_readlane(v, 0) + __builtin_amdgcn_readlane(v, 16) + __builtin_amdgcn_readlane(v, 32) + __builtin_amdgcn_readlane(v, 48);
}
__device__ __forceinline__ float dpp_sum_f32(float v) {
    v += __builtin_bit_cast(float, __builtin_amdgcn_update_dpp(0, __builtin_bit_cast(int, v), 0xB1, 0xf, 0xf, false));
    v += __builtin_bit_cast(float, __builtin_amdgcn_update_dpp(0, __builtin_bit_cast(int, v), 0x4E, 0xf, 0xf, false));
    v += __builtin_bit_cast(float, __builtin_amdgcn_update_dpp(0, __builtin_bit_cast(int, v), 0x141, 0xf, 0xf, false));
    v += __builtin_bit_cast(float, __builtin_amdgcn_update_dpp(0, __builtin_bit_cast(int, v), 0x140, 0xf, 0xf, false));
    return __builtin_bit_cast(float, __builtin_amdgcn_readlane(__builtin_bit_cast(int, v), 0)) + __builtin_bit_cast(float, __builtin_amdgcn_readlane(__builtin_bit_cast(int, v), 16)) +
           __builtin_bit_cast(float, __builtin_amdgcn_readlane(__builtin_bit_cast(int, v), 32)) + __builtin_bit_cast(float, __builtin_amdgcn_readlane(__builtin_bit_cast(int, v), 48));
}
__device__ __forceinline__ float dpp_max_f32(float v) {
    v = fmaxf(v, __builtin_bit_cast(float, __builtin_amdgcn_update_dpp(__builtin_bit_cast(int, v), __builtin_bit_cast(int, v), 0xB1, 0xf, 0xf, false)));
    v = fmaxf(v, __builtin_bit_cast(float, __builtin_amdgcn_update_dpp(__builtin_bit_cast(int, v), __builtin_bit_cast(int, v), 0x4E, 0xf, 0xf, false)));
    v = fmaxf(v, __builtin_bit_cast(float, __builtin_amdgcn_update_dpp(__builtin_bit_cast(int, v), __builtin_bit_cast(int, v), 0x141, 0xf, 0xf, false)));
    v = fmaxf(v, __builtin_bit_cast(float, __builtin_amdgcn_update_dpp(__builtin_bit_cast(int, v), __builtin_bit_cast(int, v), 0x140, 0xf, 0xf, false)));
    float a = __builtin_bit_cast(float, __builtin_amdgcn_readlane(__builtin_bit_cast(int, v), 0)), b = __builtin_bit_cast(float, __builtin_amdgcn_readlane(__builtin_bit_cast(int, v), 16));
    float c = __builtin_bit_cast(float, __builtin_amdgcn_readlane(__builtin_bit_cast(int, v), 32)), d = __builtin_bit_cast(float, __builtin_amdgcn_readlane(__builtin_bit_cast(int, v), 48));
    return fmaxf(fmaxf(a, b), fmaxf(c, d));
}
__device__ __forceinline__ float dpp_min_f32(float v) { return -dpp_max_f32(-v); }
__device__ __forceinline__ float silu_f(float v) { return v / (1.f + __expf(-v)); }

namespace pg8 {
#define PG8_LAS __attribute__((address_space(3)))
constexpr int BM = 256, BK = 64, HALF = 128, HTB = HALF * BK * 2, STAGE_BYTES = 8 * HTB, NXCD = 8, WGM = 8;
__host__ __device__ __forceinline__ int lds_byte(int r, int c) { const int st = (r >> 4) * 2 + (c >> 5), rr = r & 15, cc = c & 31, ob = rr * 64 + cc * 2; return st * 1024 + (ob ^ (((ob >> 9) & 1) << 5)); }
__host__ __device__ __forceinline__ void stage_rc(int b, int& R, int& C) { const int st = b / 1024, sb = b % 1024, swz = sb ^ (((sb >> 9) & 1) << 5); R = (st >> 1) * 16 + swz / 64; C = (st & 1) * 32 + (swz % 64) / 2; }
__host__ __device__ __forceinline__ int perm32(int rho) { const int n = rho >> 4, i = rho & 15; return 8 * (i >> 2) + 4 * n + (i & 3); }

struct Unit { int pm, pn, eb; };
struct Gemm { const h16* A; const h16* Bt; int M, N, K; size_t bstride; const int* rowmap; };

struct StaticOrder {
    int nM, nN, nwg, G, c, skip;
    __device__ void init(int M_, int N_, int G_, int c_, int skip_ = 1 << 30) { nM = M_ / BM; nN = N_ / BM; nwg = nM * nN; G = G_; c = c_; skip = skip_; }
    __device__ bool next(int i, Unit& u) const {
        const long L = (long)i * G + c; if (L >= nwg) return false;
        int wgid = (int)L; { const int q = nwg / NXCD, r = nwg % NXCD, xcd = wgid % NXCD, off = wgid / NXCD; wgid = (xcd < r ? xcd * (q + 1) : r * (q + 1) + (xcd - r) * q) + off; }
        const int nig = WGM * nN, gid = wgid / nig, fm = gid * WGM, gsz = (nM - fm) < WGM ? (nM - fm) : WGM;
        u.pm = fm + ((wgid % nig) % gsz); u.pn = (wgid % nig) / gsz; u.pn += (u.pn >= skip) ? 1 : 0; u.eb = 0; return true;
    }
};
struct ColumnOrder {
    int pn, nM, G, c;
    __device__ bool next(int i, Unit& u) const { const int L = i * G + c; if (L >= nM) return false; u.pm = L; u.pn = pn; u.eb = 0; return true; }
};
struct GroupedOrder {
    const int* tile_e; int nN, first, step, n;
    __device__ bool next(int i, Unit& u) const {
        if (i >= n) return false;
        const int L = first + i * step;
        u.pm = L / nN; u.pn = L % nN; u.eb = tile_e[u.pm]; return true;
    }
};

template <class Epi, class Sched, bool GATHER, bool HALFB = false>
__device__ __forceinline__ void gemm_phase(PG8_LAS unsigned char* lds, const Gemm g, const Sched& S, const Epi& E) {
    const int tid = threadIdx.x, wid = __builtin_amdgcn_readfirstlane(tid >> 6), lane = tid & 63, wr = wid >> 2, wc = wid & 3, fr = lane & 15, fq = lane >> 4;
    int K_ = g.K; asm volatile("" : "+s"(K_));
    const int K = K_, nt = K / BK;
    unsigned voffB[2]; unsigned cC[2]; int cR[2];
    unsigned vA0[2], vA1[2];
#pragma unroll
    for (int i = 0; i < 2; ++i) { int R, C; stage_rc(tid * 16 + i * 8192, R, C); const int Rb = Epi::PERM ? ((R & ~31) + perm32(R & 31)) : R;
        cR[i] = R; cC[i] = (unsigned)C * 2u; voffB[i] = (unsigned)(Rb * K + C) * 2u; vA0[i] = (unsigned)(R * K + C) * 2u; vA1[i] = vA0[i]; }
    const size_t kstep = (size_t)(BK * 2);
    const size_t hstep = (size_t)HALF * K * 2;
    const size_t tstep = 2 * hstep;
    const unsigned ldsw = (unsigned)wid * 1024u;
    const int aoff = lds_byte(wr * 64 + fr, fq * 8), boff = lds_byte(wc * 32 + fr, fq * 8);
#define PG8_SA(b, h) (((b) * 2 + (h)) * HTB)
#define PG8_SB(b, h) ((4 + (b) * 2 + (h)) * HTB)
#define PG8_STAGE(bufoff, gbase, voff) do { _Pragma("unroll") for (int _i = 0; _i < 2; ++_i) \
        __builtin_amdgcn_global_load_lds((const unsigned*)((const char*)(gbase) + (voff)[_i]), (PG8_LAS unsigned*)(lds + (bufoff) + ldsw + _i * 8192), 16, 0, 0); } while (0)
#define PG8_LDA(dst, b, h) do { _Pragma("unroll") for (int m = 0; m < 4; ++m) _Pragma("unroll") for (int k = 0; k < 2; ++k) dst[m][k] = *(const PG8_LAS f16x8*)(lds + PG8_SA(b, h) + aoff + m * 2048 + k * 1024); } while (0)
#define PG8_LDB(dst, b, h) do { _Pragma("unroll") for (int n = 0; n < 2; ++n) _Pragma("unroll") for (int k = 0; k < 2; ++k) dst[n][k] = *(const PG8_LAS f16x8*)(lds + PG8_SB(b, h) + boff + n * 2048 + k * 1024); } while (0)
#define PG8_MMA(ai, bj, At, Bt) do { __builtin_amdgcn_s_setprio(1); _Pragma("unroll") for (int m = 0; m < 4; ++m) _Pragma("unroll") for (int n = 0; n < 2; ++n) _Pragma("unroll") for (int k = 0; k < 2; ++k) \
        acc[ai][bj][m][n] = __builtin_amdgcn_mfma_f32_16x16x32_f16(Bt[n][k], At[m][k], acc[ai][bj][m][n], 0, 0, 0); __builtin_amdgcn_s_setprio(0); } while (0)
#define PG8_WAIT_V(n) asm volatile("s_waitcnt vmcnt(" #n ")" ::: "memory")
#define PG8_WAIT_L(n) asm volatile("s_waitcnt lgkmcnt(" #n ")" ::: "memory")
#define PG8_BAR __builtin_amdgcn_s_barrier()
#define PG8_SCHED __builtin_amdgcn_sched_barrier(0)
#define PG8_ABASE(u_) (GATHER ? (const char*)g.A : (const char*)g.A + (size_t)(u_).pm * tstep)
#define PG8_AH1 (GATHER ? (size_t)0 : hstep)
#define PG8_GATHER_OFF(u_, d0, d1) do { if (GATHER) { _Pragma("unroll") for (int _i = 0; _i < 2; ++_i) { \
        int r0_ = g.rowmap[(u_).pm * BM + cR[_i]], r1_ = g.rowmap[(u_).pm * BM + HALF + cR[_i]]; r0_ = r0_ < 0 ? 0 : r0_; r1_ = r1_ < 0 ? 0 : r1_; \
        d0[_i] = (unsigned)r0_ * (unsigned)(K * 2) + cC[_i]; d1[_i] = (unsigned)r1_ * (unsigned)(K * 2) + cC[_i]; } } } while (0)
    Unit cur, nxt; int ui = 0;
    if (!S.next(0, cur)) return;
    f32x4 acc[2][2][4][2];
#pragma unroll
    for (int a = 0; a < 2; ++a)
#pragma unroll
        for (int b = 0; b < 2; ++b)
#pragma unroll
            for (int m = 0; m < 4; ++m)
#pragma unroll
                for (int n = 0; n < 2; ++n) acc[a][b][m][n] = (f32x4){0.f, 0.f, 0.f, 0.f};
    f16x8 At[4][2], B0[2][2], B1[2][2];
    PG8_GATHER_OFF(cur, vA0, vA1);
    const char* cA = PG8_ABASE(cur); const char* cB = (const char*)g.Bt + (size_t)cur.eb * g.bstride + (size_t)cur.pn * tstep;
    PG8_STAGE(PG8_SB(0, 0), cB, voffB); PG8_STAGE(PG8_SB(0, 1), cB + hstep, voffB); PG8_STAGE(PG8_SA(0, 0), cA, vA0); PG8_STAGE(PG8_SA(0, 1), cA + PG8_AH1, vA1);
    if (wr == 1) PG8_BAR;
    PG8_WAIT_V(2); PG8_BAR;
    PG8_STAGE(PG8_SB(1, 0), cB + kstep, voffB); PG8_STAGE(PG8_SA(1, 0), cA + kstep, vA0); PG8_STAGE(PG8_SB(1, 1), cB + hstep + kstep, voffB);
    PG8_WAIT_V(6); PG8_BAR;
    for (;;) {
        const bool has_next = S.next(ui + 1, nxt);
        unsigned nA0[2] = {vA0[0], vA0[1]}, nA1[2] = {vA1[0], vA1[1]};
        if (has_next) PG8_GATHER_OFF(nxt, nA0, nA1);
        const char* nA = has_next ? PG8_ABASE(nxt) : cA; const char* nB = has_next ? (const char*)g.Bt + (size_t)nxt.eb * g.bstride + (size_t)nxt.pn * tstep : cB;
        for (int t = 0; t < nt; t += 2) {
            const bool last = (t == nt - 2);
            const char* a1 = cA + (size_t)(t + 1) * kstep;
            const char* a2 = last ? nA : cA + (size_t)(t + 2) * kstep; const char* b2 = last ? nB : cB + (size_t)(t + 2) * kstep;
            const char* a3 = a2 + kstep; const char* b3 = b2 + kstep;
            unsigned w0[2], w1[2];
#pragma unroll
            for (int i = 0; i < 2; ++i) { w0[i] = last ? nA0[i] : vA0[i]; w1[i] = last ? nA1[i] : vA1[i]; }
            PG8_LDB(B0, 0, 0); if constexpr (!HALFB) PG8_LDB(B1, 0, 1); PG8_SCHED; PG8_LDA(At, 0, 0); PG8_STAGE(PG8_SA(1, 1), a1 + PG8_AH1, vA1);
            PG8_WAIT_V(8); PG8_WAIT_L(0); PG8_BAR; PG8_MMA(0, 0, At, B0); if constexpr (!HALFB) PG8_MMA(0, 1, At, B1); PG8_BAR; PG8_SCHED;
            PG8_LDA(At, 0, 1); PG8_STAGE(PG8_SB(0, 0), b2, voffB); PG8_STAGE(PG8_SB(0, 1), b2 + hstep, voffB); PG8_STAGE(PG8_SA(0, 0), a2, w0);
            PG8_WAIT_V(8); PG8_WAIT_L(0); PG8_BAR; PG8_MMA(1, 0, At, B0); if constexpr (!HALFB) PG8_MMA(1, 1, At, B1); PG8_BAR; PG8_SCHED;
            PG8_LDB(B0, 1, 0); if constexpr (!HALFB) PG8_LDB(B1, 1, 1); PG8_SCHED; PG8_LDA(At, 1, 0); PG8_STAGE(PG8_SA(0, 1), a2 + PG8_AH1, w1);
            PG8_WAIT_V(8); PG8_WAIT_L(0); PG8_BAR; PG8_MMA(0, 0, At, B0); if constexpr (!HALFB) PG8_MMA(0, 1, At, B1); PG8_BAR; PG8_SCHED;
            PG8_LDA(At, 1, 1); PG8_STAGE(PG8_SB(1, 0), b3, voffB); PG8_STAGE(PG8_SB(1, 1), b3 + hstep, voffB); PG8_STAGE(PG8_SA(1, 0), a3, w0);
            PG8_WAIT_V(8); PG8_WAIT_L(0); PG8_BAR; PG8_MMA(1, 0, At, B0); if constexpr (!HALFB) PG8_MMA(1, 1, At, B1); PG8_BAR; PG8_SCHED;
        }
        if (wr == 0) PG8_BAR;
        E(acc, cur, wr, wc, fr, fq);
        if (!has_next) break;
#pragma unroll
        for (int a = 0; a < 2; ++a)
#pragma unroll
            for (int b = 0; b < 2; ++b)
#pragma unroll
                for (int m = 0; m < 4; ++m)
#pragma unroll
                    for (int n = 0; n < 2; ++n) acc[a][b][m][n] = (f32x4){0.f, 0.f, 0.f, 0.f};
        cur = nxt; cA = nA; cB = nB; ++ui;
#pragma unroll
        for (int i = 0; i < 2; ++i) { vA0[i] = nA0[i]; vA1[i] = nA1[i]; }
        if (wr == 1) PG8_BAR;
    }
    PG8_WAIT_V(0);
    PG8_BAR;
#undef PG8_SA
#undef PG8_SB
#undef PG8_STAGE
#undef PG8_LDA
#undef PG8_LDB
#undef PG8_MMA
#undef PG8_WAIT_V
#undef PG8_WAIT_L
#undef PG8_BAR
#undef PG8_SCHED
#undef PG8_ABASE
#undef PG8_AH1
#undef PG8_GATHER_OFF
}
}

struct EpiInProj {
    static constexpr bool PERM = true;
    h16 *Q, *K, *V, *QI, *KI, *GB, *Z; float* WI; const float *qn, *kn;
    __device__ __forceinline__ void operator()(const f32x4 (&acc)[2][2][4][2], const pg8::Unit& u, int wr, int wc, int fr, int fq) const {
        const int row0 = u.pm * 256 + wr * 64 + fr; const int pn = u.pn;
        if (pn < 4) {
            const bool isq = pn < 2; const float* g = isq ? qn : kn; h16* O = isq ? Q : K; const int head = 4 * (pn & 1) + wc; const float sc = isq ? QSCALE : 1.f;
            f32x4 gv[2][2];
#pragma unroll
            for (int bj = 0; bj < 2; ++bj)
#pragma unroll
                for (int n = 0; n < 2; ++n) gv[bj][n] = *(const f32x4*)(g + 32 * bj + 8 * fq + 4 * n) * sc;
#pragma unroll
            for (int ai = 0; ai < 2; ++ai)
#pragma unroll
                for (int m = 0; m < 4; ++m) {
                    float ss = 0.f;
#pragma unroll
                    for (int bj = 0; bj < 2; ++bj)
#pragma unroll
                        for (int n = 0; n < 2; ++n) { const f32x4 v = acc[ai][bj][m][n]; ss += (v[0] * v[0] + v[1] * v[1]) + (v[2] * v[2] + v[3] * v[3]); }
                    ss += __shfl_xor(ss, 16); ss += __shfl_xor(ss, 32);
                    const float rstd = rsqrtf(ss * (1.f / 64.f) + EPS);
                    const int R = row0 + ai * 128 + m * 16;
                    if (isq) { h16* rowp = O + (size_t)R * 512 + head * 64 + 8 * fq;
#pragma unroll
                        for (int bj = 0; bj < 2; ++bj) *(u32x4*)(rowp + 32 * bj) = pk8h(acc[ai][bj][m][0] * rstd * gv[bj][0], acc[ai][bj][m][1] * rstd * gv[bj][1]); }
                    else {
                        h16* tp = O + ((size_t)((R >> 12) * 8 + head) * 64 + ((R & 4095) >> 6)) * 4096 + (R & 63) * 8;
#pragma unroll
                        for (int bj = 0; bj < 2; ++bj) *(u32x4*)(tp + (4 * bj + fq) * 512) = pk8h(acc[ai][bj][m][0] * rstd * gv[bj][0], acc[ai][bj][m][1] * rstd * gv[bj][1]); }
                }
        } else if (pn < 8) {
            h16* O = pn < 6 ? V : QI; const int head = 4 * (pn & 1) + wc;
#pragma unroll
            for (int ai = 0; ai < 2; ++ai)
#pragma unroll
                for (int m = 0; m < 4; ++m) { const int R = row0 + ai * 128 + m * 16;
                    if (pn >= 6) { h16* rowp = O + (size_t)R * 512 + head * 64 + 8 * fq;
#pragma unroll
                        for (int bj = 0; bj < 2; ++bj) *(u32x4*)(rowp + 32 * bj) = pk8h(acc[ai][bj][m][0], acc[ai][bj][m][1]); }
                    else {
                        const int kv = R & 63; h16* tp = O + ((size_t)((R >> 12) * 8 + head) * 64 + ((R & 4095) >> 6)) * 4096 + ((kv >> 4) * 64 + (kv & 15) * 4 + fq) * 8;
#pragma unroll
                        for (int bj = 0; bj < 2; ++bj) *(u32x4*)(tp + bj * 2048) = pk8h(acc[ai][bj][m][0], acc[ai][bj][m][1]); } }
        } else if (pn == 8) {
#pragma unroll
            for (int ai = 0; ai < 2; ++ai)
#pragma unroll
                for (int m = 0; m < 4; ++m) { const size_t row = (size_t)(row0 + ai * 128 + m * 16);
                    if (wc < 2) { const int R = (int)row, c8 = 4 * wc + fq;
                        *(u32x4*)(KI + ((((size_t)(R >> 12) * 128 + ((R & 4095) >> 5)) * 4 + (c8 >> 1)) * 64 + (R & 31) + 32 * (c8 & 1)) * 8) = pk8h(acc[ai][0][m][0], acc[ai][0][m][1]); }
                    else if (wc == 2 && fq == 0) { *(f32x4*)(WI + row * 8) = acc[ai][0][m][0]; *(f32x4*)(WI + row * 8 + 4) = acc[ai][0][m][1]; } }
        } else if (pn < 11) {
            const int colb = 256 * (pn - 9) + 32 * wc + 8 * fq;
#pragma unroll
            for (int ai = 0; ai < 2; ++ai)
#pragma unroll
                for (int m = 0; m < 4; ++m) { h16* rowp = GB + (size_t)(row0 + ai * 128 + m * 16) * 512 + colb;
#pragma unroll
                    for (int bj = 0; bj < 2; ++bj) *(u32x4*)(rowp + 128 * bj) = pk8h(acc[ai][bj][m][0], acc[ai][bj][m][1]); }
        } else {
            const int ch = 128 * (pn - 11) + 32 * wc + 8 * fq;
#pragma unroll
            for (int ai = 0; ai < 2; ++ai)
#pragma unroll
                for (int m = 0; m < 4; ++m) *(u32x4*)(Z + (size_t)(row0 + ai * 128 + m * 16) * 512 + ch) = pk8h(acc[ai][0][m][0] * acc[ai][1][m][0], acc[ai][0][m][1] * acc[ai][1][m][1]);
        }
    }
};
struct EpiOutProj {
    static constexpr bool PERM = false;
    const float* x; float* out; const float* mod;
    __device__ __forceinline__ void operator()(const f32x4 (&acc)[2][2][4][2], const pg8::Unit& u, int wr, int wc, int fr, int fq) const {
        const int row0 = u.pm * 256 + wr * 64 + fr; const int b = (u.pm * 256) >> 12; const int col0 = u.pn * 256 + wc * 32 + 4 * fq;
        f32x4 gv[2][2];
#pragma unroll
        for (int bj = 0; bj < 2; ++bj)
#pragma unroll
            for (int n = 0; n < 2; ++n) gv[bj][n] = *(const f32x4*)(mod + (size_t)b * 6144 + 2048 + col0 + bj * 128 + n * 16);
#pragma unroll
        for (int ai = 0; ai < 2; ++ai)
#pragma unroll
            for (int m = 0; m < 4; ++m) { const size_t off = (size_t)(row0 + ai * 128 + m * 16) * 1024 + col0;
#pragma unroll
                for (int bj = 0; bj < 2; ++bj)
#pragma unroll
                    for (int n = 0; n < 2; ++n) { const f32x4 xv = *(const f32x4*)(x + off + bj * 128 + n * 16); *(f32x4*)(out + off + bj * 128 + n * 16) = xv + gv[bj][n] * acc[ai][bj][m][n]; } }
    }
};
struct EpiMoeUp {
    static constexpr bool PERM = true;
    h16* HID;
    __device__ __forceinline__ void operator()(const f32x4 (&acc)[2][2][4][2], const pg8::Unit& u, int wr, int wc, int fr, int fq) const {
        const int row0 = u.pm * 256 + wr * 64 + fr; const int f0 = 128 * u.pn + 32 * wc + 8 * fq;
#pragma unroll
        for (int ai = 0; ai < 2; ++ai)
#pragma unroll
            for (int m = 0; m < 4; ++m) { f32x4 hv[2];
#pragma unroll
                for (int n = 0; n < 2; ++n) { const f32x4 a = acc[ai][0][m][n], bb = acc[ai][1][m][n];
#pragma unroll
                    for (int i = 0; i < 4; ++i) hv[n][i] = silu_f(a[i]) * bb[i]; }
                *(u32x4*)(HID + (size_t)(row0 + ai * 128 + m * 16) * 256 + f0) = pk8h(hv[0], hv[1]); }
    }
};
struct EpiMoeDown {
    static constexpr bool PERM = true;
    h16* Y;
    __device__ __forceinline__ void operator()(const f32x4 (&acc)[2][2][4][2], const pg8::Unit& u, int wr, int wc, int fr, int fq) const {
        const int row0 = u.pm * 256 + wr * 64 + fr; const int c0 = 256 * u.pn + 32 * wc + 8 * fq;
#pragma unroll
        for (int ai = 0; ai < 2; ++ai)
#pragma unroll
            for (int m = 0; m < 4; ++m) { h16* rowp = Y + (size_t)(row0 + ai * 128 + m * 16) * 1024 + c0;
#pragma unroll
                for (int bj = 0; bj < 2; ++bj) *(u32x4*)(rowp + 128 * bj) = pk8h(acc[ai][bj][m][0], acc[ai][bj][m][1]); }
    }
};

struct Args { const float* in[21]; float* out; unsigned char* ws; int ph_lo, ph_hi; };
struct Frame {
    LAS unsigned char* lds; unsigned char* ldsg;
    int tid, lane, wave, vcu, G;
    const float* const __attribute__((address_space(4)))* in; float* out; unsigned char* ws;
};

#define XB_TMO      128
#define XB_XCNT(j)  (256  + 64 * (j))
#define XB_XSUB(j)  (1280 + 64 * (j))
#define XB_XGEN(j)  (2304 + 64 * (j))
#define XB_TOP      3328
#define XB_TOPGEN   3392
#define XCD_BAR_WORDS 3456
#define XB_SPIN_CAP (1u << 20)
__device__ __forceinline__ unsigned xb_ld(unsigned* p)              { return __hip_atomic_load(p, __ATOMIC_RELAXED, __HIP_MEMORY_SCOPE_AGENT); }
__device__ __forceinline__ unsigned xb_add(unsigned* p, unsigned v) { return __hip_atomic_fetch_add(p, v, __ATOMIC_RELAXED, __HIP_MEMORY_SCOPE_AGENT); }
__device__ __forceinline__ unsigned xb_xcc_id() { return (unsigned)__builtin_amdgcn_s_getreg((3 << 11) | 20) & 0xFu; }
#define XB_SPIN(cond, bar) do { unsigned _sp = 0; while (cond) { __builtin_amdgcn_s_sleep(1); \
    if ((++_sp & 255u) == 0u) { if (xb_ld(&(bar)[XB_TMO])) break; if (_sp > XB_SPIN_CAP) { atomicAdd(&(bar)[XB_TMO], 1u); break; } } } } while (0)
struct XcdBarrier { unsigned* bar; unsigned x; volatile LAS unsigned* st; };
__device__ __forceinline__ XcdBarrier xcd_barrier_post(unsigned* bar, volatile LAS unsigned* st) {
    XcdBarrier b; b.bar = bar; b.x = xb_xcc_id(); b.st = st;
    if (threadIdx.x == 0) (void)xb_add(&bar[XB_XCNT(b.x)], 1u);
    return b;
}
__device__ __forceinline__ void xcd_barrier_complete(unsigned* bar, unsigned x, unsigned& nloc, unsigned& nx) {
    const unsigned G = gridDim.x * gridDim.y * gridDim.z;
    unsigned sum, cnt, mine, sp = 0u;
    for (;;) {
        sum = 0u; cnt = 0u; mine = 0u;
#pragma unroll
        for (unsigned j = 0; j < 16; ++j) { const unsigned c = xb_ld(&bar[XB_XCNT(j)]); sum += c; cnt += (c > 0u) ? 1u : 0u; mine = (j == x) ? c : mine; }
        if (sum == G) break;
        __builtin_amdgcn_s_sleep(1);
        if ((++sp & 255u) == 0u) { if (xb_ld(&bar[XB_TMO])) break; if (sp > XB_SPIN_CAP) { atomicAdd(&bar[XB_TMO], 1u); break; } }
    }
    nloc = mine > 0u ? mine : 1u; nx = cnt > 0u ? cnt : 1u;
}
__device__ __forceinline__ void xcd_barrier(const XcdBarrier& b) {
    asm volatile("s_waitcnt vmcnt(0)" ::: "memory");
    __syncthreads();
    if (threadIdx.x == 0) {
        unsigned* bar = b.bar;
        __builtin_amdgcn_s_waitcnt(0);
        unsigned nloc = b.st[0], nx = b.st[1];
        if (nloc == 0u) { xcd_barrier_complete(bar, b.x, nloc, nx); b.st[0] = nloc; b.st[1] = nx; }
        const unsigned old = xb_add(&bar[XB_XSUB(b.x)], 1u);
        const unsigned gen = old / nloc;
        if (old + 1u == (gen + 1u) * nloc) {
            __builtin_amdgcn_fence(__ATOMIC_RELEASE, "agent");
            asm volatile("s_waitcnt vmcnt(0)" ::: "memory");
            const unsigned og = xb_add(&bar[XB_TOP], 1u);
            const unsigned tg = og / nx;
            if (og + 1u == (tg + 1u) * nx) xb_add(&bar[XB_TOPGEN], 1u);
            else XB_SPIN(xb_ld(&bar[XB_TOPGEN]) == tg, bar);
            __builtin_amdgcn_fence(__ATOMIC_ACQUIRE, "agent");
            xb_add(&bar[XB_XGEN(b.x)], 1u);
            asm volatile("s_waitcnt vmcnt(0)" ::: "memory");
        } else {
            XB_SPIN(xb_ld(&bar[XB_XGEN(b.x)]) == gen, bar);
            __builtin_amdgcn_fence(__ATOMIC_ACQUIRE, "agent");
            asm volatile("s_waitcnt vmcnt(0)" ::: "memory");
        }
    }
    __syncthreads();
}

__device__ __forceinline__ void transpose_item(const float* src, int ldw, int nvalid, int k0, h16* dst, int K, LAS float* scr, int lane) {
    const int c4 = lane & 7, rsub = lane >> 3;
    f32x4 v[8];
#pragma unroll
    for (int i = 0; i < 8; ++i) v[i] = (4 * c4 < nvalid) ? *(const f32x4*)(src + (size_t)(k0 + 8 * i + rsub) * ldw + 4 * c4) : (f32x4){0.f, 0.f, 0.f, 0.f};
#pragma unroll
    for (int i = 0; i < 8; ++i) { LAS float* p = scr + (8 * i + rsub) * 33 + 4 * c4; p[0] = v[i][0]; p[1] = v[i][1]; p[2] = v[i][2]; p[3] = v[i][3]; }
    LDS_WAIT(); asm volatile("" ::: "memory");
    const int c = lane & 7;
#pragma unroll
    for (int j = 0; j < 4; ++j) { const int nn = (lane >> 3) + 8 * j; const LAS float* s = scr + (8 * c) * 33 + nn;
        u32x4 o; o.x = pk2h(s[0 * 33], s[1 * 33]); o.y = pk2h(s[2 * 33], s[3 * 33]); o.z = pk2h(s[4 * 33], s[5 * 33]); o.w = pk2h(s[6 * 33], s[7 * 33]);
        *(u32x4*)(dst + (size_t)nn * K + k0 + 8 * c) = o; }
    LDS_WAIT(); asm volatile("" ::: "memory");
}
__device__ __forceinline__ int win_group_src(int g, int& nvalid) {
    const int tile = g >> 3, p = (g & 7) * 32, bj = p >> 7, wc = (p >> 5) & 3; nvalid = 32;
    if (tile < 8) { const int seg = tile >> 1; return seg * 512 + 64 * (4 * (tile & 1) + wc) + 32 * bj; }
    if (tile == 8) { if (p < 64) return 2048 + p; if (p == 64) { nvalid = 8; return 2112; } nvalid = 0; return 0; }
    if (tile < 11) return 2120 + 256 * (tile - 9) + p;
    return (bj == 0 ? 2632 : 3144) + 128 * (tile - 11) + 32 * wc;
}
__device__ __forceinline__ void p0_prologue(Frame& F) {
    LAS float* scr = (LAS float*)(F.lds + F.wave * 16384);
    const int gw = F.vcu * NWAVES + F.wave, NGW = F.G * NWAVES;
    const float* w_in = F.in[6]; const float* w_out = F.in[12]; const float* w_gate = F.in[18]; const float* w_up = F.in[19]; const float* w_down = F.in[20];
    h16* WINT = (h16*)(F.ws + WS_WINT); h16* WOUTT = (h16*)(F.ws + WS_WOUTT); h16* WGUT = (h16*)(F.ws + WS_WGUT); h16* WDT = (h16*)(F.ws + WS_WDT);
    constexpr int I_IN = 120 * 16, I_OUT = 32 * 16, I_GU = 32 * 16 * 16, I_D = 32 * 32 * 4, I_MOD = 96 * 16;
    constexpr int NITEMS = I_IN + I_OUT + I_GU + I_D + I_MOD;
    for (int it = gw; it < NITEMS; it += NGW) {
        int r = it;
        if (r < I_MOD) {
            const int cc = r % 96, ks = r / 96; const int col = cc * 64 + F.lane, k0 = ks * 64;
            const float* c = F.in[1]; const float* w_ada = F.in[3];
            float ca[8];
#pragma unroll
            for (int b = 0; b < 8; ++b) ca[b] = silu_f(c[b * 1024 + k0 + F.lane]);
            float a[8] = {0.f, 0.f, 0.f, 0.f, 0.f, 0.f, 0.f, 0.f};
#pragma unroll 8
            for (int kk = 0; kk < 64; ++kk) { const float w = w_ada[(size_t)(k0 + kk) * 6144 + col];
#pragma unroll
                for (int b = 0; b < 8; ++b) a[b] += __builtin_bit_cast(float, __builtin_amdgcn_readlane(__builtin_bit_cast(int, ca[b]), kk)) * w; }
            float* mp = (float*)(F.ws + WS_MODP) + (size_t)ks * 8 * 6144;
#pragma unroll
            for (int b = 0; b < 8; ++b) mp[b * 6144 + col] = a[b];
            continue;
        }
        r -= I_MOD;
        if (r < I_IN) { const int g = r >> 4, kb = r & 15; int nv; const int s0 = win_group_src(g, nv); transpose_item(w_in + s0, 3656, nv, kb * 64, WINT + (size_t)g * 32 * 1024, 1024, scr, F.lane); continue; } r -= I_IN;
        if (r < I_OUT) { const int g = r >> 4, kb = r & 15; transpose_item(w_out + g * 32, 1024, 32, kb * 64, WOUTT + (size_t)g * 32 * 1024, 1024, scr, F.lane); continue; } r -= I_OUT;
        if (r < I_GU) { const int e = r >> 8, g = (r >> 4) & 15, kb = r & 15; const int p = g * 32, t2 = p >> 8, bj = (p >> 7) & 1, wc = (p >> 5) & 3; const int f = 128 * t2 + 32 * wc;
            transpose_item((bj == 0 ? w_gate : w_up) + (size_t)e * 1024 * 256 + f, 256, 32, kb * 64, WGUT + ((size_t)e * 512 + p) * 1024, 1024, scr, F.lane); continue; } r -= I_GU;
        { const int e = r >> 7, g = (r >> 2) & 31, kb = r & 3; transpose_item(w_down + (size_t)e * 256 * 1024 + g * 32, 1024, 32, kb * 64, WDT + ((size_t)e * 1024 + g * 32) * 256, 256, scr, F.lane); }
    }
    { const float* wgr = F.in[14]; const float* wer = F.in[16]; h16* WRL = (h16*)(F.ws + WS_WRL);
      for (int idx = F.vcu * NTHR + F.tid; idx < 36 * 1024; idx += F.G * NTHR) { const int o = idx >> 10, rem = idx & 1023, ln = rem >> 4, ji = rem & 15, col = 4 * ln + 256 * (ji >> 2) + (ji & 3);
          WRL[idx] = (h16)(o < 4 ? wgr[col * 4 + o] : wer[col * 32 + (o - 4)]); } }
}

__device__ __forceinline__ void p1_norm1(Frame& F) {
    const float* modp = (const float*)(F.ws + WS_MODP); float* mod = (float*)(F.ws + WS_MOD); const float* b_ada = F.in[4];
    LAS float* sh = (LAS float*)F.lds; LAS float* sc = sh + 1024;
    const int b = F.vcu >> 5;
    for (int i = F.tid; i < 2048; i += NTHR) { float s = b_ada[i];
#pragma unroll
        for (int ks = 0; ks < 16; ++ks) s += modp[((size_t)ks * 8 + b) * 6144 + i];
        sh[i] = s; }
    if (F.tid < 192) { const int idx = F.vcu * 192 + F.tid; const int bb = idx / 6144, cc = idx % 6144; float s = b_ada[cc];
#pragma unroll
        for (int ks = 0; ks < 16; ++ks) s += modp[((size_t)ks * 8 + bb) * 6144 + cc];
        mod[idx] = s; }
    __syncthreads();
    const float* x = F.in[0]; const float* g1 = F.in[5]; h16* H = (h16*)(F.ws + WS_H);
    f32x4 gg[4], s1[4], h1[4];
#pragma unroll
    for (int j = 0; j < 4; ++j) { const int col = 4 * F.lane + 256 * j; gg[j] = *(const f32x4*)(g1 + col); h1[j] = *(const LAS f32x4*)(sh + col); s1[j] = *(const LAS f32x4*)(sc + col);
        gg[j] = gg[j] * (s1[j] + 1.f); }
    f32x4 vn[4];
    { const size_t row = (size_t)F.vcu * 128 + F.wave * 16;
#pragma unroll
      for (int j = 0; j < 4; ++j) vn[j] = *(const f32x4*)(x + row * 1024 + 4 * F.lane + 256 * j); }
    for (int rr = 0; rr < 16; ++rr) {
        const size_t row = (size_t)F.vcu * 128 + F.wave * 16 + rr; const size_t rown = row + (rr < 15 ? 1 : 0);
        f32x4 v[4]; float ss = 0.f;
#pragma unroll
        for (int j = 0; j < 4; ++j) { v[j] = vn[j]; vn[j] = *(const f32x4*)(x + rown * 1024 + 4 * F.lane + 256 * j); ss += (v[j][0] * v[j][0] + v[j][1] * v[j][1]) + (v[j][2] * v[j][2] + v[j][3] * v[j][3]); }
        const float rstd = rsqrtf(dpp_sum_f32(ss) * (1.f / 1024.f) + EPS);
#pragma unroll
        for (int j = 0; j < 4; ++j) { const f32x4 o = v[j] * rstd * gg[j] + h1[j]; u32x2 w; w.x = pk2h(o[0], o[1]); w.y = pk2h(o[2], o[3]); *(u32x2*)(H + row * 1024 + 4 * F.lane + 256 * j) = w; }
    }
}

__device__ __forceinline__ void p3_conv(Frame& F) {
    const h16* Z = (const h16*)(F.ws + WS_Z); const h16* GB = (const h16*)(F.ws + WS_GB); h16* MG = (h16*)(F.ws + WS_MERGED);
    const float* cw = F.in[9]; const float* cn = F.in[11];
    const int gw = F.vcu * NWAVES + F.wave, NGW = F.G * NWAVES; const int ch = 8 * F.lane;
    float w0[8], w1[8], w2[8], gn[8];
#pragma unroll
    for (int i = 0; i < 8; ++i) { w0[i] = cw[ch + i]; w1[i] = cw[512 + ch + i]; w2[i] = cw[1024 + ch + i]; gn[i] = cn[ch + i]; }
    for (int it = gw; it < M / 32; it += NGW) {
        const int t0 = it * 32; const bool first = (t0 & (SEQ - 1)) == 0;
        f16x8 zm2 = {}, zm1 = {};
        if (!first) { zm2 = *(const f16x8*)(Z + (size_t)(t0 - 2) * 512 + ch); zm1 = *(const f16x8*)(Z + (size_t)(t0 - 1) * 512 + ch); }
        for (int tt = 0; tt < 32; ++tt) {
            const size_t t = (size_t)t0 + tt;
            const f16x8 z0 = *(const f16x8*)(Z + t * 512 + ch); const f16x8 gb = *(const f16x8*)(GB + t * 512 + ch);
            float y[8]; float ss = 0.f;
#pragma unroll
            for (int i = 0; i < 8; ++i) { y[i] = (float)gb[i] * (w0[i] * (float)zm2[i] + w1[i] * (float)zm1[i] + w2[i] * (float)z0[i]); ss += y[i] * y[i]; }
            ss += __shfl_xor(ss, 1); ss += __shfl_xor(ss, 2); ss += __shfl_xor(ss, 4);
            const float rstd = rsqrtf(ss * (1.f / 64.f) + EPS);
            u32x4 o; o.x = pk2h(y[0] * rstd * gn[0], y[1] * rstd * gn[1]); o.y = pk2h(y[2] * rstd * gn[2], y[3] * rstd * gn[3]); o.z = pk2h(y[4] * rstd * gn[4], y[5] * rstd * gn[5]); o.w = pk2h(y[6] * rstd * gn[6], y[7] * rstd * gn[7]);
            *(u32x4*)(MG + t * 1024 + 512 + ch) = o;
            zm2 = zm1; zm1 = z0;
        }
    }
}

constexpr int IX_ROW = 4352, IX_NEG = 8 * IX_ROW * 4, IX_BM = IX_NEG + 256, IX_ST = IX_BM + 4096;
__device__ __forceinline__ unsigned fkey(float f) { const unsigned u = __builtin_bit_cast(unsigned, f); return u ^ ((u >> 31) ? 0xFFFFFFFFu : 0x80000000u); }
__device__ __forceinline__ float fkey_inv(unsigned k) { const unsigned u = (k >> 31) ? (k ^ 0x80000000u) : ~k; return __builtin_bit_cast(float, u); }
__device__ __forceinline__ float probit_lo(float p) {
    if (p < 0.02425f) { const float q = sqrtf(-2.f * __logf(p));
        return (((((-7.784894002430293e-03f * q - 3.223964580411365e-01f) * q - 2.400758277161838e+00f) * q - 2.549732539343734e+00f) * q + 4.374664141464968e+00f) * q + 2.938163982698783e+00f) /
               ((((7.784695709041462e-03f * q + 3.224671290700398e-01f) * q + 2.445134137142996e+00f) * q + 3.754408661907416e+00f) * q + 1.f); }
    const float q = p - 0.5f, r = q * q;
    return (((((-3.969683028665376e+01f * r + 2.209460984245205e+02f) * r - 2.759285104469687e+02f) * r + 1.383577518672690e+02f) * r - 3.066479806614716e+01f) * r + 2.506628277459239e+00f) * q /
           (((((-5.447609879822406e+01f * r + 1.615858368580409e+02f) * r - 1.556989798598866e+02f) * r + 6.680131188771972e+01f) * r - 1.328068155288572e+01f) * r + 1.f);
}
__device__ __forceinline__ void row_sum2(float v, float& h0, float& h1) {
    v += __builtin_bit_cast(float, __builtin_amdgcn_update_dpp(0, __builtin_bit_cast(int, v), 0xB1, 0xf, 0xf, false));
    v += __builtin_bit_cast(float, __builtin_amdgcn_update_dpp(0, __builtin_bit_cast(int, v), 0x4E, 0xf, 0xf, false));
    v += __builtin_bit_cast(float, __builtin_amdgcn_update_dpp(0, __builtin_bit_cast(int, v), 0x141, 0xf, 0xf, false));
    v += __builtin_bit_cast(float, __builtin_amdgcn_update_dpp(0, __builtin_bit_cast(int, v), 0x140, 0xf, 0xf, false));
    h0 = __builtin_bit_cast(float, __builtin_amdgcn_readlane(__builtin_bit_cast(int, v), 0)) + __builtin_bit_cast(float, __builtin_amdgcn_readlane(__builtin_bit_cast(int, v), 16));
    h1 = __builtin_bit_cast(float, __builtin_amdgcn_readlane(__builtin_bit_cast(int, v), 32)) + __builtin_bit_cast(float, __builtin_amdgcn_readlane(__builtin_bit_cast(int, v), 48));
}
__device__ __forceinline__ unsigned eval_mask(const float (&v)[64], float x, unsigned& a, unsigned& b) {
    unsigned ma = 0u, mb = 0u;
#pragma unroll
    for (int i = 31; i >= 0; --i) { ma = __builtin_amdgcn_alignbit(ma, __builtin_bit_cast(unsigned, v[i] - x), 31); mb = __builtin_amdgcn_alignbit(mb, __builtin_bit_cast(unsigned, v[32 + i] - x), 31); }
    a = ma; b = mb;
    return dpp_sum_u32(64u - (unsigned)__builtin_popcount(ma) - (unsigned)__builtin_popcount(mb));
}
__device__ __forceinline__ float probit(float p) { return p > 0.5f ? -probit_lo(1.f - p) : probit_lo(p); }
__device__ __forceinline__ unsigned count_ge(const float (&v)[64], float x) {
    unsigned c = 0;
#pragma unroll
    for (int i = 0; i < 64; ++i) c += (v[i] >= x) ? 1u : 0u;
    return dpp_sum_u32(c);
}
__device__ __forceinline__ float relu_i(float x) { const int i = __builtin_bit_cast(int, x); return __builtin_bit_cast(float, i > 0 ? i : 0); }
constexpr int IX_CTR = IX_ST + 512;
__device__ __forceinline__ void p3_indexer(Frame& F) {
    const h16* QI = (const h16*)(F.ws + WS_QI); const h16* KI = (const h16*)(F.ws + WS_KI); const float* WI = (const float*)(F.ws + WS_WI); u64* BM = (u64*)(F.ws + WS_BM);
    LAS float* sc = (LAS float*)F.lds;
    LAS float* st = (LAS float*)(F.lds + IX_ST);
    LAS unsigned* ctr = (LAS unsigned*)(F.lds + IX_CTR);
    const int lane = F.lane, wid = F.wave, r32 = lane & 31, hi = lane >> 5;
    if (F.tid < 64) ((LAS float*)(F.lds + IX_NEG))[F.tid] = -__builtin_inff();
    if (F.tid < 2) ctr[F.tid] = 0u;
    __syncthreads();
    const int hq = (r32 >> 2) & 1, rr = (r32 & 3) + 4 * (r32 >> 3), jq = 2 * hq + (rr >> 3), hh = rr & 7;
    f16x8 af[2][4]; f32x4 wraw[2][2][2];
#define IX_QLOAD(u_) do { const int idx_ = (u_) * 256 + (((u_) & 1) ? (255 - F.vcu) : F.vcu); const size_t rb_ = (size_t)(idx_ & 7) * SEQ + (size_t)(idx_ >> 3) * 8; \
        _Pragma("unroll") for (int rb = 0; rb < 2; ++rb) { const h16* qp = QI + (rb_ + 4 * rb + jq) * 512 + hh * 64 + hi * 8; \
            _Pragma("unroll") for (int ks = 0; ks < 4; ++ks) af[rb][ks] = *(const f16x8*)(qp + ks * 16); \
            _Pragma("unroll") for (int j2 = 0; j2 < 2; ++j2) { const float* wp = WI + (rb_ + 4 * rb + 2 * hi + j2) * 8; wraw[rb][j2][0] = *(const f32x4*)wp; wraw[rb][j2][1] = *(const f32x4*)(wp + 4); } } } while (0)
    IX_QLOAD(0);
    for (int u = 0; u < 16; ++u) {
        const int idx = u * 256 + ((u & 1) ? (255 - F.vcu) : F.vcu);
        const int b = idx & 7, t0 = (idx >> 3) * 8;
        const size_t rowb = (size_t)b * SEQ;
        const int nj = (t0 + 8 + 63) >> 6;
        {
            float wv[2][16];
#pragma unroll
            for (int rb = 0; rb < 2; ++rb)
#pragma unroll
                for (int j2 = 0; j2 < 2; ++j2)
#pragma unroll
                    for (int i = 0; i < 4; ++i) { wv[rb][8 * j2 + i] = wraw[rb][j2][0][i] * IDX_SCALE; wv[rb][8 * j2 + 4 + i] = wraw[rb][j2][1][i] * IDX_SCALE; }
            float ssum[2][2] = {{0.f, 0.f}, {0.f, 0.f}}, ssq[2][2] = {{0.f, 0.f}, {0.f, 0.f}};
            const h16* kbase = KI + (size_t)b * (128 * 2048) + lane * 8;
#define IX_TICKET(t_) do { asm volatile("ds_add_rtn_u32 %0, %1, %2" : "=v"(t_) : "v"(ctr_addr + 4u * (unsigned)(u & 1)), "v"(1u) : "memory"); } while (0)
#define IX_TGET(t_) ({ int g_; asm volatile("s_waitcnt lgkmcnt(0)\n\tv_readfirstlane_b32 %0, %1" : "=s"(g_) : "v"(t_) : "memory"); g_ >> 6; })
#define IX_LOAD(dst, g_) do { const int gg_ = (g_) < nj ? (g_) : nj - 1; _Pragma("unroll") for (int q = 0; q < 2; ++q) { const h16* kp = kbase + (size_t)(2 * gg_ + q) * 2048; \
                _Pragma("unroll") for (int ks = 0; ks < 4; ++ks) dst[q][ks] = *(const f16x8*)(kp + ks * 512); } } while (0)
#define IX_MMA(x0, x1, kt) do { x0 = f32x16{}; x1 = f32x16{}; \
                _Pragma("unroll") for (int ks = 0; ks < 4; ++ks) { x0 = __builtin_amdgcn_mfma_f32_32x32x16_f16(af[0][ks], kt[ks], x0, 0, 0, 0); x1 = __builtin_amdgcn_mfma_f32_32x32x16_f16(af[1][ks], kt[ks], x1, 0, 0, 0); } } while (0)
#define IX_VAL(x0, x1, tile_, DIAG) do { const int tile = (tile_); const int key = tile * 32 + r32; const int pos = key + 4 * (key >> 6); \
                _Pragma("unroll") for (int rb = 0; rb < 2; ++rb) { float s0 = 0.f, s1 = 0.f; \
                    _Pragma("unroll") for (int r = 0; r < 8; ++r) { const float d0 = rb ? x1[r] : x0[r], d1 = rb ? x1[8 + r] : x0[8 + r]; \
                        s0 = __builtin_fmaf(relu_i(d0), wv[rb][r], s0); s1 = __builtin_fmaf(relu_i(d1), wv[rb][8 + r], s1); } \
                    float z0 = s0, z1 = s1; \
                    if (DIAG) { if (tile * 32 + 31 > t0) { const int tq = t0 + 4 * rb + 2 * hi; const bool v0 = key <= tq, v1 = key <= tq + 1; z0 = v0 ? s0 : 0.f; z1 = v1 ? s1 : 0.f; s0 = v0 ? s0 : -__builtin_inff(); s1 = v1 ? s1 : -__builtin_inff(); } } \
                    ssum[rb][0] += z0; ssq[rb][0] = __builtin_fmaf(z0, z0, ssq[rb][0]); ssum[rb][1] += z1; ssq[rb][1] = __builtin_fmaf(z1, z1, ssq[rb][1]); \
                    sc[(4 * rb + 2 * hi) * IX_ROW + pos] = s0; sc[(4 * rb + 2 * hi + 1) * IX_ROW + pos] = s1; } } while (0)
            const int nf = nj - 1;
            const unsigned ctr_addr = (unsigned)(size_t)ctr;
            f16x8 kA[2][4], kB[2][4]; f32x16 a0, a1, b0, b1;
            unsigned tk; IX_TICKET(tk); int g0 = IX_TGET(tk), g1, gl = g0; bool lastInA = true;
            IX_LOAD(kA, g0);
            if (g0 < nf) {
                IX_TICKET(tk); g1 = IX_TGET(tk); IX_LOAD(kB, g1);
                IX_MMA(a0, a1, kA[0]);
                for (;;) {
                    IX_TICKET(tk);
                    IX_MMA(b0, b1, kA[1]); IX_VAL(a0, a1, 2 * g0, false);
                    IX_MMA(a0, a1, kB[0]); IX_VAL(b0, b1, 2 * g0 + 1, false);
                    const int g2 = IX_TGET(tk);
                    if (g1 >= nf) { gl = g1; lastInA = false; break; }
                    IX_LOAD(kA, g2);
                    IX_TICKET(tk);
                    IX_MMA(b0, b1, kB[1]); IX_VAL(a0, a1, 2 * g1, false);
                    IX_MMA(a0, a1, kA[0]); IX_VAL(b0, b1, 2 * g1 + 1, false);
                    g0 = g2; g1 = IX_TGET(tk);
                    if (g0 >= nf) { gl = g0; lastInA = true; break; }
                    IX_LOAD(kB, g1);
                }
            }
            if (gl == nf) {
                if (lastInA) { IX_MMA(a0, a1, kA[0]); IX_VAL(a0, a1, 2 * nf, true); IX_MMA(b0, b1, kA[1]); IX_VAL(b0, b1, 2 * nf + 1, true); }
                else         { IX_MMA(a0, a1, kB[0]); IX_VAL(a0, a1, 2 * nf, true); IX_MMA(b0, b1, kB[1]); IX_VAL(b0, b1, 2 * nf + 1, true); }
            }
#undef IX_TICKET
#undef IX_TGET
#undef IX_LOAD
#undef IX_MMA
#undef IX_VAL
#pragma unroll
            for (int rb = 0; rb < 2; ++rb)
#pragma unroll
                for (int j2 = 0; j2 < 2; ++j2) { float s0_, s1_, q0_, q1_; row_sum2(ssum[rb][j2], s0_, s1_); row_sum2(ssq[rb][j2], q0_, q1_);
                    if (lane == 0) { LAS float* sp = st + wid * 16 + (4 * rb + j2) * 2; sp[0] = s0_; sp[1] = q0_; sp[4] = s1_; sp[5] = q1_; } }
            IX_QLOAD(u < 15 ? u + 1 : 15);
        }
        __syncthreads();
        if (F.tid == 0) ctr[(u + 1) & 1] = 0u;
        const int t = t0 + wid, n = t + 1;
        float v[64]; float ssum_ = 0.f, ssq_ = 0.f;
        if (n > 256) {
            const LAS float* cp = (lane < nj) ? (sc + wid * IX_ROW + lane * 68) : (const LAS float*)(F.lds + IX_NEG);
#pragma unroll
            for (int i = 0; i < 16; ++i) { const f32x4 x = *(const LAS f32x4*)(cp + 4 * i); v[4 * i] = x[0]; v[4 * i + 1] = x[1]; v[4 * i + 2] = x[2]; v[4 * i + 3] = x[3]; }
#pragma unroll
            for (int w = 0; w < NWAVES; ++w) { ssum_ += st[w * 16 + wid * 2]; ssq_ += st[w * 16 + wid * 2 + 1]; }
        } else {
#pragma unroll
            for (int i = 0; i < 64; ++i) v[i] = 0.f;
        }
        __syncthreads();
        unsigned mlo = 0u, mhi = 0u;
        if (n <= 256) {
            const int rem = n - 64 * lane;
            if (rem > 0) { mlo = rem >= 32 ? 0xFFFFFFFFu : ((1u << rem) - 1u); mhi = rem >= 64 ? 0xFFFFFFFFu : (rem > 32 ? ((1u << (rem - 32)) - 1u) : 0u); }
        } else {
            const float fn = (float)n, mean = ssum_ / fn; const float var = fmaxf(ssq_ / fn - mean * mean, 1e-20f), sd = sqrtf(var);
            const float zq = -probit(256.f / fn);
            const float dens = fmaxf(fn * 0.3989423f * __expf(-0.5f * zq * zq) / sd, 1e-3f);
            float xl = -3.0e38f, xh = __builtin_inff(), cl = fn, ch = 0.f; bool hasL = false, hasH = false; int side = 0, zst = 0;
            float x = mean + fminf(fmaxf(zq, -6.f), 6.f) * sd, step = 0.f; unsigned na = 0u, nb = 0u;
            float tie_v = 0.f; int tie_need = 0;
            const float DMIN = __builtin_bit_cast(float, 1u);
            int it = 0;
            for (;;) {
                ++it;
                unsigned kx = fkey(x); const unsigned kl = fkey(xl), kh = fkey(xh);
                if (!(kx > kl && kx < kh)) kx = kl + ((kh - kl) >> 1);
                x = fkey_inv(kx);
                const unsigned c = eval_mask(v, x, na, nb);
                if (c == 256u) break;
                if (c > 256u) { xl = x; cl = (float)c; hasL = true; if (side == 1) ch = 256.f + 0.5f * (ch - 256.f); side = 1; }
                else          { xh = x; ch = (float)c; hasH = true; if (side == 2) cl = 256.f + 0.5f * (cl - 256.f); side = 2; }
                const unsigned kl2 = fkey(xl), kh2 = fkey(xh);
                if (kh2 - kl2 <= 1u) {
                    const unsigned chx = eval_mask(v, xh, na, nb); tie_v = xl; tie_need = 256 - (int)chx; break; }
                if (!(hasL && hasH)) { step = (step == 0.f) ? fminf(fabsf((float)c - 256.5f) / dens * 1.25f + 0.02f * sd, 2.f * sd) : 2.f * step; x = (c > 256u) ? x + step : x - step; }
                else if (zst == 0 && it >= 2 && xl <= 0.f && xh > DMIN) { zst = 1; x = DMIN; }
                else if (zst == 1 && xh == DMIN && xl < 0.f) { zst = 2; x = 0.f; }
                else if (it >= 8 && (it & 1)) x = fkey_inv(kl2 + ((kh2 - kl2) >> 1));
                else x = xl + (xh - xl) * ((cl - 256.5f) / (cl - ch));
            }
            mlo = ~na; mhi = ~nb;
            if (tie_need > 0) {
                unsigned ce = 0;
#pragma unroll
                for (int i = 0; i < 64; ++i) ce += (v[i] == tie_v) ? 1u : 0u;
                unsigned pre = ce;
#pragma unroll
                for (int o = 1; o < 64; o <<= 1) { const unsigned y = __shfl_up(pre, o); pre += (lane >= o) ? y : 0u; }
                int allow = tie_need - (int)(pre - ce); allow = allow < 0 ? 0 : allow;
#pragma unroll
                for (int i = 0; i < 64; ++i) { if (v[i] == tie_v && allow > 0) { if (i < 32) mlo |= 1u << i; else mhi |= 1u << (i - 32); --allow; } }
            }
        }
        if (lane <= 4 * (t0 >> 8) + 3) BM[((size_t)b * 64 + lane) * 4096 + t] = ((u64)mhi << 32) | mlo;
    }
    __syncthreads();
}

constexpr int AL_K = 0, AL_V = 16384, AL_M = 32768, AL_LUT = 36864, AL_WS = 37888, AL_OST = 40960;
constexpr int OST_STRIDE = 68;
__device__ __forceinline__ float sel_bfi(unsigned m, unsigned a, unsigned b) { unsigned d; asm("v_bfi_b32 %0, %1, %2, %3" : "=v"(d) : "v"(m), "v"(a), "s"(b)); return __builtin_bit_cast(float, d); }
__device__ __forceinline__ int crow(int r, int hi) { return (r & 3) + 8 * (r >> 2) + 4 * hi; }
__device__ __forceinline__ void attn_unit(Frame& F, int b, int h, int qb) {
    const h16* Q = (const h16*)(F.ws + WS_Q); const h16* Kg = (const h16*)(F.ws + WS_K); const h16* Vg = (const h16*)(F.ws + WS_V); const u64* BM = (const u64*)(F.ws + WS_BM);
    h16* MG = (h16*)(F.ws + WS_MERGED);
    const int tid = F.tid, lane = F.lane, wid = F.wave, r32 = lane & 31, hi = lane >> 5, grp = wid >> 2;
    const size_t rowb = (size_t)b * SEQ; const int q0 = qb * 256;
    LAS unsigned char* L = F.lds;
    LAS float* lut = (LAS float*)(L + AL_LUT); LAS float* wsf = (LAS float*)(L + AL_WS) + wid * 64; LAS float* ost = (LAS float*)(L + AL_OST) + wid * (32 * OST_STRIDE);
    if (tid < 129) lut[tid] = F.in[2][T5_BKT[tid] * 8 + h] * LOG2E;
    const float cfar = F.in[2][31 * 8 + h] * LOG2E;
    const int NT = (q0 + 256) / 64;
    const h16* ksrc = Kg + (size_t)(b * 8 + h) * 64 * 4096 + wid * 512 + lane * 8;
    const h16* vsrc = Vg + (size_t)(b * 8 + h) * 64 * 4096 + wid * 512 + lane * 8;
    const u64* msrc = BM + (size_t)b * 64 * 4096 + q0 + wid * 32 + r32;
    u32x4 kreg, vreg;
#define A_LOAD(t) do { kreg = *(const u32x4*)(ksrc + (size_t)(t) * 4096); vreg = *(const u32x4*)(vsrc + (size_t)(t) * 4096); } while (0)
#define A_STORE(buf) do { *(LAS u32x4*)(L + AL_K + (buf) * 8192 + wid * 1024 + lane * 16) = kreg; *(LAS u32x4*)(L + AL_V + (buf) * 8192 + wid * 1024 + lane * 16) = vreg; } while (0)
#define A_BAR() asm volatile("s_barrier" ::: "memory")
    const int qpos = q0 + wid * 32 + r32;
    const int qmin = q0 + wid * 32;
    const unsigned NEGINF = 0xFF800000u;
    float mref = 0.f, lrun = 0.f; bool hasmass = false; f32x16 o[2]; o[0] = f32x16{}; o[1] = f32x16{};
    f32x16 p0, p1;
#define A_COP(t_, mw_) do { const unsigned wl = (unsigned)(mw_) >> (4 * hi), wh = (unsigned)((mw_) >> 32) >> (4 * hi); \
        if ((qmin - (64 * (t_) + 63)) >= 128) { const unsigned cb = __builtin_bit_cast(unsigned, cfar - mref); \
            _Pragma("unroll") for (int r = 0; r < 16; ++r) { const int c = (r & 3) + 8 * (r >> 2); const unsigned s0 = (unsigned)__builtin_amdgcn_sbfe((int)wl, c, 1), s1 = (unsigned)__builtin_amdgcn_sbfe((int)wh, c, 1); \
                p0[r] = sel_bfi(s0, cb, NEGINF); p1[r] = sel_bfi(s1, cb, NEGINF); } \
        } else { const int base = qpos - 64 * (t_) - 4 * hi; \
            _Pragma("unroll") for (int r = 0; r < 16; ++r) { const int c = (r & 3) + 8 * (r >> 2); int i0 = base - c, i1 = base - c - 32; i0 = i0 < 0 ? 0 : (i0 > 128 ? 128 : i0); i1 = i1 < 0 ? 0 : (i1 > 128 ? 128 : i1); \
                const unsigned s0 = (unsigned)__builtin_amdgcn_sbfe((int)wl, c, 1), s1 = (unsigned)__builtin_amdgcn_sbfe((int)wh, c, 1); \
                const unsigned c0 = __builtin_bit_cast(unsigned, lut[i0] - mref), c1 = __builtin_bit_cast(unsigned, lut[i1] - mref); \
                p0[r] = sel_bfi(s0, c0, NEGINF); p1[r] = sel_bfi(s1, c1, NEGINF); } } } while (0)
    u64 mw, mwn;
    { const u32x4 k0r = *(const u32x4*)ksrc, v0r = *(const u32x4*)vsrc;
      A_LOAD(1); mw = msrc[0]; mwn = msrc[4096];
      *(LAS u32x4*)(L + AL_K + wid * 1024 + lane * 16) = k0r; *(LAS u32x4*)(L + AL_V + wid * 1024 + lane * 16) = v0r; }
    f16x8 qr[4];
    { const h16* qp = Q + (rowb + q0 + wid * 32 + r32) * 512 + h * 64 + hi * 8;
#pragma unroll
      for (int d0 = 0; d0 < 4; ++d0) qr[d0] = *(const f16x8*)(qp + d0 * 16); }
    __syncthreads();
    if (grp == 1) A_BAR();
    A_COP(0, mw); mw = mwn;
    const int vboff = ((lane >> 4) & 1) * 32 + (lane & 3) * 8 + (4 * hi + ((lane & 15) >> 2)) * 64;
    for (int t = 0; t < NT; ++t) {
        const int cur = t & 1;
        f16x8 kfr[8];
        { const LAS unsigned char* kb = L + AL_K + cur * 8192 + hi * 1024 + r32 * 16;
#pragma unroll
          for (int d0 = 0; d0 < 4; ++d0) { kfr[2 * d0] = *(const LAS f16x8*)(kb + d0 * 2048); kfr[2 * d0 + 1] = *(const LAS f16x8*)(kb + d0 * 2048 + 512); } }
        A_STORE(cur ^ 1);
        { const int tl = (t + 2 < NT) ? t + 2 : NT - 1; A_LOAD(tl); mwn = msrc[(size_t)tl * 4096]; }
        s16x4 vlo[8], vhi[8];
        { LAS unsigned char* vb = L + AL_V + cur * 8192 + vboff;
#pragma unroll
          for (int i = 0; i < 8; ++i) { vlo[i] = __builtin_amdgcn_ds_read_tr16_b64_v4i16((LAS s16x4*)(vb + (i >> 2) * 4096 + (i & 3) * 1024)); vhi[i] = __builtin_amdgcn_ds_read_tr16_b64_v4i16((LAS s16x4*)(vb + (i >> 2) * 4096 + (i & 3) * 1024 + 512)); } }
        __builtin_amdgcn_sched_barrier(0);
#pragma unroll
        for (int d0 = 0; d0 < 4; ++d0) { p0 = __builtin_amdgcn_mfma_f32_32x32x16_f16(kfr[2 * d0], qr[d0], p0, 0, 0, 0); p1 = __builtin_amdgcn_mfma_f32_32x32x16_f16(kfr[2 * d0 + 1], qr[d0], p1, 0, 0, 0); }
        __builtin_amdgcn_sched_barrier(0);
        asm volatile("s_waitcnt lgkmcnt(0)\n\ts_barrier" ::: "memory");
        __builtin_amdgcn_sched_barrier(0);
        float rs = 0.f;
#pragma unroll
        for (int r = 0; r < 16; ++r) { p0[r] = __builtin_amdgcn_exp2f(p0[r]); p1[r] = __builtin_amdgcn_exp2f(p1[r]); rs += p0[r] + p1[r]; }
        const float pm = rs + __shfl_xor(rs, 32);
        const bool need = (pm > 256.f) || (!hasmass && pm > 0.f);
        if (__any(need)) {
            const float f = need ? 1.f / pm : 1.f;
            mref += need ? __builtin_amdgcn_logf(pm) : 0.f;
            rs *= f; lrun *= f;
#pragma unroll
            for (int r = 0; r < 16; ++r) { float a_ = p0[r], b_ = p1[r]; asm("v_mul_f32 %0, %0, %1" : "+v"(a_) : "v"(f)); asm("v_mul_f32 %0, %0, %1" : "+v"(b_) : "v"(f)); p0[r] = a_; p1[r] = b_; }
            if (hi == 0) wsf[r32] = f;
            LDS_WAIT();
#pragma unroll
            for (int r = 0; r < 16; ++r) { const float a = wsf[crow(r, hi)]; o[0][r] *= a; o[1][r] *= a; }
        }
        hasmass = hasmass || (pm > 0.f);
        lrun += rs;
        u32x4 pw[4];
        pw[0] = (u32x4){pk2h(p0[0], p0[1]), pk2h(p0[2], p0[3]), pk2h(p0[4], p0[5]), pk2h(p0[6], p0[7])};
        pw[1] = (u32x4){pk2h(p0[8], p0[9]), pk2h(p0[10], p0[11]), pk2h(p0[12], p0[13]), pk2h(p0[14], p0[15])};
        pw[2] = (u32x4){pk2h(p1[0], p1[1]), pk2h(p1[2], p1[3]), pk2h(p1[4], p1[5]), pk2h(p1[6], p1[7])};
        pw[3] = (u32x4){pk2h(p1[8], p1[9]), pk2h(p1[10], p1[11]), pk2h(p1[12], p1[13]), pk2h(p1[14], p1[15])};
        __builtin_amdgcn_sched_barrier(0);
#pragma unroll
        for (int d0 = 0; d0 < 2; ++d0)
#pragma unroll
            for (int ks = 0; ks < 4; ++ks) { const int i = d0 * 4 + ks;
                typedef short s16x8 __attribute__((ext_vector_type(8)));
                const s16x8 vv = {vlo[i][0], vlo[i][1], vlo[i][2], vlo[i][3], vhi[i][0], vhi[i][1], vhi[i][2], vhi[i][3]};
                o[d0] = __builtin_amdgcn_mfma_f32_32x32x16_f16(__builtin_bit_cast(f16x8, pw[ks]), __builtin_bit_cast(f16x8, vv), o[d0], 0, 0, 0); }
        A_COP(t + 1, mw); mw = mwn;
        A_BAR();
    }
    if (grp == 0) A_BAR();
#undef A_LOAD
#undef A_STORE
#undef A_BAR
#undef A_COP
    lrun += __shfl_xor(lrun, 32);
    if (hi == 0) wsf[r32] = 1.f / lrun;
    LDS_WAIT();
#pragma unroll
    for (int r = 0; r < 16; ++r) { const float rl = wsf[crow(r, hi)]; const int qrow = crow(r, hi);
        ost[qrow * OST_STRIDE + r32] = o[0][r] * rl; ost[qrow * OST_STRIDE + 32 + r32] = o[1][r] * rl; }
    LDS_WAIT();
    { const int row = lane >> 1, hf = lane & 1; const LAS float* rp = ost + row * OST_STRIDE + hf * 32;
      f32x4 xv[8]; float ss = 0.f;
#pragma unroll
      for (int i = 0; i < 8; ++i) { xv[i] = *(const LAS f32x4*)(rp + 4 * i); ss += (xv[i][0] * xv[i][0] + xv[i][1] * xv[i][1]) + (xv[i][2] * xv[i][2] + xv[i][3] * xv[i][3]); }
      ss += __shfl_xor(ss, 1);
      const float rstd = rsqrtf(ss * (1.f / 64.f) + EPS);
      const float* gn = F.in[10] + h * 64 + hf * 32;
      h16* op = MG + (rowb + q0 + wid * 32 + row) * 1024 + h * 64 + hf * 32;
#pragma unroll
      for (int i = 0; i < 4; ++i) { const f32x4 g0 = *(const f32x4*)(gn + 8 * i), g1 = *(const f32x4*)(gn + 8 * i + 4);
          *(u32x4*)(op + 8 * i) = pk8h(xv[2 * i] * rstd * g0, xv[2 * i + 1] * rstd * g1); } }
    __syncthreads();
}
__device__ __forceinline__ void p4_attention(Frame& F) {
    const int bh = F.vcu >> 2, c = F.vcu & 3;
    for (int i = 0; i < 4; ++i) { const int qb = (i == 0) ? 2 * c : (i == 1) ? 15 - 2 * c : (i == 2) ? 2 * c + 1 : 14 - 2 * c; attn_unit(F, bh >> 3, bh & 7, qb); }
}

__device__ __forceinline__ void p6_norm2_route(Frame& F) {
    const float* mod = (const float*)(F.ws + WS_MOD); const float* g2 = F.in[13]; h16* H2 = (h16*)(F.ws + WS_H); const float* x1 = F.out;
    const h16* WRLg = (const h16*)(F.ws + WS_WRL);
    LAS h16* wrl = (LAS h16*)F.lds;
    LAS unsigned* lcnt = (LAS unsigned*)(F.lds + 73728);
    LAS unsigned* lbase = lcnt + 32;
    LAS unsigned* rinfo = (LAS unsigned*)(F.lds + 73728 + 256);
    for (int i = F.tid; i < 36 * 1024 / 8; i += NTHR) *(LAS u32x4*)(wrl + i * 8) = *(const u32x4*)(WRLg + i * 8);
    if (F.tid < 32) lcnt[F.tid] = 0u;
    __syncthreads();
    const int b = F.vcu >> 5;
    const float* bgr = F.in[15]; const float* ber = F.in[17];
    f32x4 gg[4], hh[4];
#pragma unroll
    for (int j = 0; j < 4; ++j) { const int col = 4 * F.lane + 256 * j; gg[j] = *(const f32x4*)(g2 + col) * (*(const f32x4*)(mod + (size_t)b * 6144 + 4096 + col) + 1.f); hh[j] = *(const f32x4*)(mod + (size_t)b * 6144 + 3072 + col); }
    f32x4 vn[4];
    { const size_t row = (size_t)F.vcu * 128 + F.wave * 16;
#pragma unroll
      for (int j = 0; j < 4; ++j) vn[j] = *(const f32x4*)(x1 + row * 1024 + 4 * F.lane + 256 * j); }
    for (int rr = 0; rr < 16; ++rr) {
        const int lrow = F.wave * 16 + rr; const size_t row = (size_t)F.vcu * 128 + lrow; const size_t rown = row + (rr < 15 ? 1 : 0);
        f32x4 v[4]; float ss = 0.f;
#pragma unroll
        for (int j = 0; j < 4; ++j) { v[j] = vn[j]; vn[j] = *(const f32x4*)(x1 + rown * 1024 + 4 * F.lane + 256 * j); ss += (v[j][0] * v[j][0] + v[j][1] * v[j][1]) + (v[j][2] * v[j][2] + v[j][3] * v[j][3]); }
        const float rstd = rsqrtf(dpp_sum_f32(ss) * (1.f / 1024.f) + EPS);
#pragma unroll
        for (int j = 0; j < 4; ++j) { v[j] = v[j] * rstd * gg[j] + hh[j]; u32x2 w; w.x = pk2h(v[j][0], v[j][1]); w.y = pk2h(v[j][2], v[j][3]); *(u32x2*)(H2 + row * 1024 + 4 * F.lane + 256 * j) = w; }
        float lg[4];
#pragma unroll
        for (int o = 0; o < 4; ++o) { const f16x8 wa = *(const LAS f16x8*)(wrl + (o * 64 + F.lane) * 16), wb = *(const LAS f16x8*)(wrl + (o * 64 + F.lane) * 16 + 8);
            float s = 0.f;
#pragma unroll
            for (int i = 0; i < 4; ++i) { s += v[0][i] * (float)wa[i]; s += v[1][i] * (float)wa[4 + i]; s += v[2][i] * (float)wb[i]; s += v[3][i] * (float)wb[4 + i]; }
            lg[o] = dpp_sum_f32(s) + bgr[o]; }
        int gs = 0; float gm = lg[0];
#pragma unroll
        for (int g = 1; g < 4; ++g) if (lg[g] > gm) { gm = lg[g]; gs = g; }
        float gden = 0.f;
#pragma unroll
        for (int g = 0; g < 4; ++g) gden += __expf(lg[g] - gm);
        const float pg = 1.f / gden;
        gs = __builtin_amdgcn_readfirstlane(gs);
        float el[8];
        { const LAS h16* wsel = wrl + ((4 + 8 * gs) * 64 + F.lane) * 16; const float* bsel = ber + 8 * gs;
#pragma unroll
          for (int e = 0; e < 8; ++e) { const f16x8 wa = *(const LAS f16x8*)(wsel + e * 1024), wb = *(const LAS f16x8*)(wsel + e * 1024 + 8);
            float s = 0.f;
#pragma unroll
            for (int i = 0; i < 4; ++i) { s += v[0][i] * (float)wa[i]; s += v[1][i] * (float)wa[4 + i]; s += v[2][i] * (float)wb[i]; s += v[3][i] * (float)wb[4 + i]; }
            el[e] = dpp_sum_f32(s) + bsel[e]; } }
        int e0 = 0; float m0 = el[0];
#pragma unroll
        for (int e = 1; e < 8; ++e) if (el[e] > m0) { m0 = el[e]; e0 = e; }
        int e1 = -1; float m1 = -__builtin_inff();
#pragma unroll
        for (int e = 0; e < 8; ++e) if (e != e0 && el[e] > m1) { m1 = el[e]; e1 = e; }
        const float p1 = __expf(m1 - m0); const float w0 = pg / (1.f + p1), w1 = pg * p1 / (1.f + p1);
        if (F.lane == 0) {
            const unsigned E0 = (unsigned)(gs * 8 + e0), E1 = (unsigned)(gs * 8 + e1);
            const unsigned r0 = atomicAdd((unsigned*)(lcnt + E0), 1u), r1 = atomicAdd((unsigned*)(lcnt + E1), 1u);
            rinfo[lrow * 8 + 0] = E0; rinfo[lrow * 8 + 1] = r0; rinfo[lrow * 8 + 2] = __builtin_bit_cast(unsigned, w0);
            rinfo[lrow * 8 + 3] = E1; rinfo[lrow * 8 + 4] = r1; rinfo[lrow * 8 + 5] = __builtin_bit_cast(unsigned, w1);
        }
    }
    __syncthreads();
    unsigned* gcnt = (unsigned*)(F.ws + WS_CTL) + CW_GCNT;
    if (F.tid < 32) lbase[F.tid] = atomicAdd(gcnt + F.tid, lcnt[F.tid]);
    __syncthreads();
    if (F.tid < 128) { unsigned* ro = (unsigned*)(F.ws + WS_ROUTE) + ((size_t)F.vcu * 128 + F.tid) * 8;
        const unsigned E0 = rinfo[F.tid * 8 + 0], E1 = rinfo[F.tid * 8 + 3];
        ro[0] = E0; ro[1] = lbase[E0] + rinfo[F.tid * 8 + 1]; ro[2] = rinfo[F.tid * 8 + 2]; ro[3] = E1; ro[4] = lbase[E1] + rinfo[F.tid * 8 + 4]; ro[5] = rinfo[F.tid * 8 + 5]; }
    __syncthreads();
}
__device__ __forceinline__ void expert_offsets(Frame& F, LAS unsigned* off) {
    const unsigned* gcnt = (const unsigned*)(F.ws + WS_CTL) + CW_GCNT;
    if (F.tid == 0) { unsigned a = 0; for (int e = 0; e < 32; ++e) { off[e] = a; a += (__hip_atomic_load(gcnt + e, RLX_AGENT) + 255u) & ~255u; } off[32] = a; }
    __syncthreads();
}
__device__ __forceinline__ void p7_rowmap(Frame& F) {
    LAS unsigned* off = (LAS unsigned*)F.lds;
    expert_offsets(F, off);
    int* rowmap = (int*)(F.ws + WS_ROWMAP); const unsigned* gcnt = (const unsigned*)(F.ws + WS_CTL) + CW_GCNT; int* tile_e = (int*)(F.ws + WS_CTL) + 1024;
    if (F.tid < 128) { const size_t tok = (size_t)F.vcu * 128 + F.tid; const unsigned* ro = (const unsigned*)(F.ws + WS_ROUTE) + tok * 8;
        rowmap[off[ro[0]] + ro[1]] = (int)tok; rowmap[off[ro[3]] + ro[4]] = (int)tok; }
    if (F.vcu < 32) { const int e = F.vcu; const unsigned c = __hip_atomic_load(gcnt + e, RLX_AGENT); for (unsigned r = off[e] + c + F.tid; r < off[e + 1]; r += NTHR) rowmap[r] = -1;
        for (unsigned t = off[e] / 256 + F.tid; t < off[e + 1] / 256; t += NTHR) tile_e[t] = e; }
    __syncthreads();
}
__device__ __forceinline__ void p10_combine(Frame& F) {
    LAS unsigned* off = (LAS unsigned*)F.lds;
    expert_offsets(F, off);
    const float* mod = (const float*)(F.ws + WS_MOD); const h16* Y = (const h16*)(F.ws + WS_Y); float* out = F.out;
    const int b = F.vcu >> 5;
    f32x4 g2[4];
#pragma unroll
    for (int j = 0; j < 4; ++j) g2[j] = *(const f32x4*)(mod + (size_t)b * 6144 + 5120 + 4 * F.lane + 256 * j);
    const size_t rowbase = (size_t)F.vcu * 128 + F.wave * 16;
    unsigned P0l = 0u, P1l = 0u; float C0l = 0.f, C1l = 0.f;
    if (F.lane < 16) { const unsigned* ro = (const unsigned*)(F.ws + WS_ROUTE) + (rowbase + F.lane) * 8; P0l = off[ro[0]] + ro[1]; P1l = off[ro[3]] + ro[4]; C0l = __builtin_bit_cast(float, ro[2]); C1l = __builtin_bit_cast(float, ro[5]); }
    f16x4 y0n[4], y1n[4]; f32x4 xn[4];
    { const size_t p0 = (unsigned)__shfl((int)P0l, 0), p1 = (unsigned)__shfl((int)P1l, 0);
#pragma unroll
      for (int j = 0; j < 4; ++j) { const int col = 4 * F.lane + 256 * j; y0n[j] = *(const f16x4*)(Y + p0 * 1024 + col); y1n[j] = *(const f16x4*)(Y + p1 * 1024 + col); xn[j] = *(const f32x4*)(out + rowbase * 1024 + col); } }
    for (int rr = 0; rr < 16; ++rr) {
        const size_t row = rowbase + rr; const int rn = rr < 15 ? rr + 1 : rr;
        const float c0 = __shfl(C0l, rr), c1 = __shfl(C1l, rr);
        const size_t p0n = (unsigned)__shfl((int)P0l, rn), p1n = (unsigned)__shfl((int)P1l, rn);
#pragma unroll
        for (int j = 0; j < 4; ++j) { const int col = 4 * F.lane + 256 * j;
            const f16x4 y0 = y0n[j], y1 = y1n[j]; f32x4 xv = xn[j];
            y0n[j] = *(const f16x4*)(Y + p0n * 1024 + col); y1n[j] = *(const f16x4*)(Y + p1n * 1024 + col); xn[j] = *(const f32x4*)(out + (rowbase + rn) * 1024 + col);
#pragma unroll
            for (int i = 0; i < 4; ++i) xv[i] += g2[j][i] * (c0 * (float)y0[i] + c1 * (float)y1[i]);
            *(f32x4*)(out + row * 1024 + col) = xv; }
    }
}
constexpr int N_PHASES = 12;
__global__ void __launch_bounds__(NTHR, 2) mega_fwd(Args args) {
    extern __shared__ __attribute__((aligned(16))) unsigned char lds_raw[];
    Frame F;
    F.lds = (LAS unsigned char*)lds_raw; F.ldsg = lds_raw;
    F.tid = threadIdx.x; F.lane = F.tid & 63; F.wave = __builtin_amdgcn_readfirstlane(F.tid >> 6);
    F.G = gridDim.x; { const int bx = blockIdx.x; F.vcu = (F.G % 8 == 0) ? (bx % 8) * (F.G / 8) + bx / 8 : bx; }
    F.in = (const float* const __attribute__((address_space(4)))*)__builtin_amdgcn_kernarg_segment_ptr();
    F.out = args.out; F.ws = args.ws;
    volatile LAS unsigned* MISC = (volatile LAS unsigned*)(F.lds + MISC_OFF);
    if (F.tid < 16) MISC[F.tid] = 0u;
    __syncthreads();
    const int lo = args.ph_lo, hi = args.ph_hi;
    XcdBarrier bar; bar.bar = (unsigned*)(F.ws + WS_CTL) + CW_BAR; bar.x = 0; bar.st = nullptr;
    if (hi - lo > 1) bar = xcd_barrier_post((unsigned*)(F.ws + WS_CTL) + CW_BAR, MISC + 8);
#define IN(k) (lo <= (k) && (k) < hi)
#define STAMP(k) do {} while (0)
#define SEAM(k) do { if (IN(k) && IN((k) + 1)) xcd_barrier(bar); STAMP((k) + 1); } while (0)
    STAMP(0);
    if (IN(0)) { p0_prologue(F); }
    if (lo < 0) { cg::this_grid().sync(); }
    SEAM(0);
    if (IN(1)) { p1_norm1(F); }
    SEAM(1);
    if (IN(2)) {
        pg8::Gemm g{(const h16*)(F.ws + WS_H), (const h16*)(F.ws + WS_WINT), M, NINP, DM, 0, nullptr}; pg8::StaticOrder S; S.init(M, NINP - 256, F.G, (int)blockIdx.x, 8);
        EpiInProj E{(h16*)(F.ws + WS_Q), (h16*)(F.ws + WS_K), (h16*)(F.ws + WS_V), (h16*)(F.ws + WS_QI), (h16*)(F.ws + WS_KI), (h16*)(F.ws + WS_GB), (h16*)(F.ws + WS_Z), (float*)(F.ws + WS_WI), F.in[7], F.in[8]};
        pg8::gemm_phase<EpiInProj, pg8::StaticOrder, false>(F.lds, g, S, E);
        pg8::ColumnOrder S8{8, M / 256, F.G, F.vcu};
        pg8::gemm_phase<EpiInProj, pg8::ColumnOrder, false, true>(F.lds, g, S8, E);
    }
    SEAM(2);
    if (IN(3)) { p3_conv(F); p3_indexer(F); }
    SEAM(3);
    if (IN(4)) { p4_attention(F); }
    SEAM(4);
    if (IN(5)) {
        pg8::Gemm g{(const h16*)(F.ws + WS_MERGED), (const h16*)(F.ws + WS_WOUTT), M, DM, DM, 0, nullptr}; pg8::StaticOrder S; S.init(M, DM, F.G, (int)blockIdx.x);
        EpiOutProj E{F.in[0], F.out, (const float*)(F.ws + WS_MOD)};
        pg8::gemm_phase<EpiOutProj, pg8::StaticOrder, false>(F.lds, g, S, E);
    }
    SEAM(5);
    if (IN(6)) { p6_norm2_route(F); }
    SEAM(6);
    if (IN(7)) { p7_rowmap(F); }
    SEAM(7);
    if (IN(8) || IN(9) || IN(10)) {
        LAS unsigned* off = (LAS unsigned*)(F.lds + RING_BYTES); expert_offsets(F, off); const int ntiles = (int)(off[32] / 256u); __syncthreads();
        const int* tile_e = (const int*)(F.ws + WS_CTL) + 1024;
        const int n8 = 2 * ntiles, R8 = n8 / F.G, rem8 = n8 - R8 * F.G;
        const int pmA = (R8 * F.G) / 2;
        const int n9 = 4 * ntiles; constexpr int PB = 4, PA = 2;
        int nB = PB * (F.G - rem8) + PA * rem8; nB = nB < 4 * pmA ? nB : 4 * pmA; nB = nB < n9 ? nB : n9;
        const pg8::Gemm gU{(const h16*)(F.ws + WS_H), (const h16*)(F.ws + WS_WGUT), 0, 512, DM, (size_t)512 * 1024 * 2, (const int*)(F.ws + WS_ROWMAP)};
        const pg8::Gemm gD{(const h16*)(F.ws + WS_HID), (const h16*)(F.ws + WS_WDT), 0, 1024, EFF, (size_t)1024 * 256 * 2, nullptr};
        const EpiMoeUp EU{(h16*)(F.ws + WS_HID)}; const EpiMoeDown ED{(h16*)(F.ws + WS_Y)};
        if (IN(8)) { pg8::GroupedOrder S{tile_e, 2, F.vcu, F.G, R8}; pg8::gemm_phase<EpiMoeUp, pg8::GroupedOrder, true>(F.lds, gU, S, EU); }
        SEAM(8);
        if (IN(9)) {
            if (F.vcu < rem8) { pg8::GroupedOrder S{tile_e, 2, R8 * F.G + F.vcu, F.G, 1}; pg8::gemm_phase<EpiMoeUp, pg8::GroupedOrder, true>(F.lds, gU, S, EU); }
            { const bool up = F.vcu < rem8; const int f = up ? PB * (F.G - rem8) + PA * F.vcu : PB * (F.vcu - rem8); const int cap = up ? PA : PB; int n = nB - f; n = n < 0 ? 0 : (n > cap ? cap : n);
              pg8::GroupedOrder S{tile_e, 4, f, 1, n}; pg8::gemm_phase<EpiMoeDown, pg8::GroupedOrder, false>(F.lds, gD, S, ED); }
        }
        SEAM(9);
        if (IN(10)) { const int f = nB + F.vcu; const int n = f < n9 ? (n9 - f + F.G - 1) / F.G : 0;
            pg8::GroupedOrder S{tile_e, 4, f, F.G, n}; pg8::gemm_phase<EpiMoeDown, pg8::GroupedOrder, false>(F.lds, gD, S, ED); }
    }
    SEAM(10);
    if (IN(11)) { p10_combine(F); }

#undef IN
#undef SEAM
}

extern "C" void kernel_launch(void* const* d_in, const int* in_sizes, int n_in, void* d_out, int out_size, void* d_ws, size_t ws_size, hipStream_t stream) {
    static int grid = 0;
    if (grid == 0) {
        if (n_in != 21 || out_size != M * DM || ws_size < WS_END) { fprintf(stderr, "kernel_launch: unexpected shapes (n_in %d out %d ws %zu)\n", n_in, out_size, ws_size); grid = -1; return; }
        int dev = 0, cus = 0, per_cu = 0;
        (void)hipGetDevice(&dev); (void)hipDeviceGetAttribute(&cus, hipDeviceAttributeMultiprocessorCount, dev);
        if (hipFuncSetAttribute((const void*)mega_fwd, hipFuncAttributeMaxDynamicSharedMemorySize, LDS_BYTES) != hipSuccess) { fprintf(stderr, "kernel_launch: hipFuncSetAttribute failed\n"); grid = -1; return; }
        if (hipOccupancyMaxActiveBlocksPerMultiprocessor(&per_cu, (const void*)mega_fwd, NTHR, LDS_BYTES) != hipSuccess || per_cu < 1) { fprintf(stderr, "kernel_launch: occupancy query says %d\n", per_cu); per_cu = 1; }
        (void)hipGetLastError();
        grid = cus;
        if (grid != 256) { fprintf(stderr, "kernel_launch: built for 256 CUs, got %d\n", grid); }
    }
    if (grid < 0) return;
    (void)hipMemsetAsync((char*)d_ws + WS_CTL, 0, CTL_ZERO_BYTES, stream);
    Args a{};
    for (int i = 0; i < 21; ++i) a.in[i] = (const float*)d_in[i];
    a.out = (float*)d_out; a.ws = (unsigned char*)d_ws;
#if MK_N_LAUNCHES == 1
    a.ph_lo = 0; a.ph_hi = N_PHASES;
    void* kargs[] = {&a};
    hipError_t e = hipLaunchCooperativeKernel((const void*)mega_fwd, dim3(grid), dim3(NTHR), kargs, LDS_BYTES, stream);
    if (e != hipSuccess) fprintf(stderr, "cooperative launch failed: %s\n", hipGetErrorString(e));
#else
    for (int p = 0; p < N_PHASES; ++p) { a.ph_lo = p; a.ph_hi = p + 1; hipLaunchKernelGGL(mega_fwd, dim3(grid), dim3(NTHR), LDS_BYTES, stream, a); }
#endif
}
```

```cpp
#include <hip/hip_runtime.h>
#include <hip/hip_cooperative_groups.h>
#include <cstdio>
#include <cstdint>
namespace cg = cooperative_groups;

#ifndef MK_N_LAUNCHES

#define MK_N_LAUNCHES 1
#endif

#define LAS __attribute__((address_space(3)))
#define GAS __attribute__((address_space(1)))
typedef _Float16 h16;
typedef _Float16 f16x8 __attribute__((ext_vector_type(8)));
typedef _Float16 f16x4 __attribute__((ext_vector_type(4)));
typedef _Float16 f16x2 __attribute__((ext_vector_type(2)));
typedef short s16x4 __attribute__((ext_vector_type(4)));
typedef float f32x2 __attribute__((ext_vector_type(2)));
typedef float f32x4 __attribute__((ext_vector_type(4)));
typedef float f32x16 __attribute__((ext_vector_type(16)));
typedef unsigned u32x2 __attribute__((ext_vector_type(2)));
typedef unsigned u32x4 __attribute__((ext_vector_type(4)));
typedef unsigned long long u64;

constexpr int BATCH = 8, SEQ = 4096, DM = 1024, M = BATCH * SEQ;
constexpr int NINP = 3840;
constexpr int NEXP = 32, EFF = 256;
constexpr int MAXROWS = 2 * M + NEXP * 256;
constexpr float EPS = 1e-6f;
constexpr float LOG2E = 1.4426950408889634f;
constexpr float QSCALE = 0.125f * LOG2E;
constexpr float IDX_SCALE = 0.125f * 0.35355339059327373f;
constexpr int NWAVES = 8, NTHR = 512;

constexpr size_t MiB = 1u << 20;
constexpr size_t WS_CTL = 0, CTL_ZERO_BYTES = 64 * 1024;
constexpr size_t WS_MODP = 1 * MiB;
constexpr size_t WS_MOD = 4 * MiB;
constexpr size_t WS_ROUTE = 5 * MiB;
constexpr size_t WS_ROWMAP = 6 * MiB + 512 * 1024;
constexpr size_t WS_WINT = 8 * MiB;
constexpr size_t WS_WOUTT = 16 * MiB;
constexpr size_t WS_WRL = 18 * MiB;
constexpr size_t WS_WGUT = 20 * MiB;
constexpr size_t WS_WDT = 52 * MiB;
constexpr size_t WS_H = 72 * MiB;
constexpr size_t WS_Q = 136 * MiB, WS_K = 168 * MiB, WS_V = 200 * MiB, WS_QI = 232 * MiB;
constexpr size_t WS_KI = 264 * MiB;
constexpr size_t WS_WI = 268 * MiB;
constexpr size_t WS_GB = 270 * MiB, WS_Z = 302 * MiB;
constexpr size_t WS_BM = 334 * MiB;
constexpr size_t WS_MERGED = 350 * MiB;
constexpr size_t WS_HID = 416 * MiB;
constexpr size_t WS_AO = 136 * MiB;
constexpr size_t WS_Y = 200 * MiB;
constexpr size_t WS_END = 456 * MiB;
static_assert(WS_Y + (size_t)MAXROWS * 1024 * 2 <= WS_MERGED, "Y overlay");
static_assert(WS_HID + (size_t)MAXROWS * 256 * 2 <= WS_END, "HID");
constexpr int CW_GCNT = 64;
constexpr int CW_BAR = 4096;

constexpr int LDS_BYTES = 147456;
constexpr int RING_BYTES = 131072;
constexpr int MISC_OFF = 147456 - 256;

__device__ const unsigned char T5_BKT[129] = {0, 1, 2, 3, 4, 5, 6, 7, 8, 9, 10, 11, 12, 13, 14, 15, 16, 16, 16, 17, 17, 18, 18, 18, 19, 19, 19, 20, 20, 20, 20, 21, 21, 21, 21, 22, 22, 22, 22, 22, 23, 23, 23, 23, 23, 23, 24, 24, 24, 24, 24, 24, 25, 25, 25, 25, 25, 25, 25, 26, 26, 26, 26, 26, 26, 26, 26, 27, 27, 27, 27, 27, 27, 27, 27, 27, 27, 28, 28, 28, 28, 28, 28, 28, 28, 28, 28, 29, 29, 29, 29, 29, 29, 29, 29, 29, 29, 29, 29, 30, 30, 30, 30, 30, 30, 30, 30, 30, 30, 30, 30, 30, 30, 31, 31, 31, 31, 31, 31, 31, 31, 31, 31, 31, 31, 31, 31, 31, 31};

#define LDS_WAIT() asm volatile("s_waitcnt lgkmcnt(0)" ::: "memory")
#define NT_LD(T, p) __builtin_nontemporal_load((const T*)(p))
#define NT_ST(T, p, v) __builtin_nontemporal_store((v), (T*)(p))
#define VM_WAIT() asm volatile("s_waitcnt vmcnt(0)" ::: "memory")
#define RLX_AGENT __ATOMIC_RELAXED, __HIP_MEMORY_SCOPE_AGENT
__device__ __forceinline__ unsigned pk2h(float lo, float hi) { f32x2 v = {lo, hi}; f16x2 h = __builtin_convertvector(v, f16x2); return __builtin_bit_cast(unsigned, h); }
__device__ __forceinline__ u32x4 pk8h(f32x4 a, f32x4 b) { u32x4 w; w.x = pk2h(a[0], a[1]); w.y = pk2h(a[2], a[3]); w.z = pk2h(b[0], b[1]); w.w = pk2h(b[2], b[3]); return w; }
__device__ __forceinline__ float wave_sum(float v) {
#pragma unroll
    for (int o = 1; o < 64; o <<= 1) v += __shfl_xor(v, o);
    return v;
}
__device__ __forceinline__ unsigned dpp_sum_u32(unsigned v) {
    v += (unsigned)__builtin_amdgcn_update_dpp(0, (int)v, 0xB1, 0xf, 0xf, false);
    v += (unsigned)__builtin_amdgcn_update_dpp(0, (int)v, 0x4E, 0xf, 0xf, false);
    v += (unsigned)__builtin_amdgcn_update_dpp(0, (int)v, 0x141, 0xf, 0xf, false);
    v += (unsigned)__builtin_amdgcn_update_dpp(0, (int)v, 0x140, 0xf, 0xf, false);
    return __builtin_amdgcn_readlane(v, 0) + __builtin_amdgcn_readlane(v, 16) + __builtin_amdgcn_readlane(v, 32) + __builtin_amdgcn_readlane(v, 48);
}
__device__ __forceinline__ float dpp_sum_f32(float v) {
    v += __builtin_bit_cast(float, __builtin_amdgcn_update_dpp(0, __builtin_bit_cast(int, v), 0xB1, 0xf, 0xf, false));
    v += __builtin_bit_cast(float, __builtin_amdgcn_update_dpp(0, __builtin_bit_cast(int, v), 0x4E, 0xf, 0xf, false));
    v += __builtin_bit_cast(float, __builtin_amdgcn_update_dpp(0, __builtin_bit_cast(int, v), 0x141, 0xf, 0xf, false));
    v += __builtin_bit_cast(float, __builtin_amdgcn_update_dpp(0, __builtin_bit_cast(int, v), 0x140, 0xf, 0xf, false));
    return __builtin_bit_cast(float, __builtin_amdgcn_readlane(__builtin_bit_cast(int, v), 0)) + __builtin_bit_cast(float, __builtin_amdgcn_readlane(__builtin_bit_cast(int, v), 16)) +
           __builtin_bit_cast(float, __builtin_amdgcn_readlane(__builtin_bit_cast(int, v), 32)) + __builtin_bit_cast(float, __builtin_amdgcn_readlane(__builtin_bit_cast(int, v), 48));
}
__device__ __forceinline__ float dpp_max_f32(float v) {
    v = fmaxf(v, __builtin_bit_cast(float, __builtin_amdgcn_update_dpp(__builtin_bit_cast(int, v), __builtin_bit_cast(int, v), 0xB1, 0xf, 0xf, false)));
    v = fmaxf(v, __builtin_bit_cast(float, __builtin_amdgcn_update_dpp(__builtin_bit_cast(int, v), __builtin_bit_cast(int, v), 0x4E, 0xf, 0xf, false)));
    v = fmaxf(v, __builtin_bit_cast(float, __builtin_amdgcn_update_dpp(__builtin_bit_cast(int, v), __builtin_bit_cast(int, v), 0x141, 0xf, 0xf, false)));
    v = fmaxf(v, __builtin_bit_cast(float, __builtin_amdgcn_update_dpp(__builtin_bit_cast(int, v), __builtin_bit_cast(int, v), 0x140, 0xf, 0xf, false)));
    float a = __builtin_bit_cast(float, __builtin_amdgcn_readlane(__builtin_bit_cast(int, v), 0)), b = __builtin_bit_cast(float, __builtin_amdgcn_readlane(__builtin_bit_cast(int, v), 16));
    float c = __builtin_bit_cast(float, __builtin_amdgcn_readlane(__builtin_bit_cast(int, v), 32)), d = __builtin_bit_cast(float, __builtin_amdgcn_readlane(__builtin_bit_cast(int, v), 48));
    return fmaxf(fmaxf(a, b), fmaxf(c, d));
}
__device__ __forceinline__ float dpp_min_f32(float v) { return -dpp_max_f32(-v); }
__device__ __forceinline__ float silu_f(float v) { return v * __builtin_amdgcn_rcpf(1.f + __expf(-v)); }

namespace pg8 {
#define PG8_LAS __attribute__((address_space(3)))
constexpr int BM = 256, BK = 64, HALF = 128, HTB = HALF * BK * 2, STAGE_BYTES = 8 * HTB, NXCD = 8, WGM = 8;
__host__ __device__ __forceinline__ int lds_byte(int r, int c) { const int st = (r >> 4) * 2 + (c >> 5), rr = r & 15, cc = c & 31, ob = rr * 64 + cc * 2; return st * 1024 + (ob ^ (((ob >> 9) & 1) << 5)); }
__host__ __device__ __forceinline__ void stage_rc(int b, int& R, int& C) { const int st = b / 1024, sb = b % 1024, swz = sb ^ (((sb >> 9) & 1) << 5); R = (st >> 1) * 16 + swz / 64; C = (st & 1) * 32 + (swz % 64) / 2; }
__host__ __device__ __forceinline__ int perm32(int rho) { const int n = rho >> 4, i = rho & 15; return 8 * (i >> 2) + 4 * n + (i & 3); }

struct Unit { int pm, pn, eb; };
struct Gemm { const h16* A; const h16* Bt; int M, N, K; size_t bstride; const int* rowmap; };

struct StaticOrder {
    int nM, nN, nwg, G, c, skip;
    __device__ void init(int M_, int N_, int G_, int c_, int skip_ = 1 << 30) { nM = M_ / BM; nN = N_ / BM; nwg = nM * nN; G = G_; c = c_; skip = skip_; }
    __device__ bool next(int i, Unit& u) const {
        const long L = (long)i * G + c; if (L >= nwg) return false;
        int wgid = (int)L; { const int q = nwg / NXCD, r = nwg % NXCD, xcd = wgid % NXCD, off = wgid / NXCD; wgid = (xcd < r ? xcd * (q + 1) : r * (q + 1) + (xcd - r) * q) + off; }
        const int nig = WGM * nN, gid = wgid / nig, fm = gid * WGM, gsz = (nM - fm) < WGM ? (nM - fm) : WGM;
        u.pm = fm + ((wgid % nig) % gsz); u.pn = (wgid % nig) / gsz; u.pn += (u.pn >= skip) ? 1 : 0; u.eb = 0; return true;
    }
};
struct ColumnOrder {
    int pn, nM, G, c;
    __device__ bool next(int i, Unit& u) const { const int L = i * G + c; if (L >= nM) return false; u.pm = L; u.pn = pn; u.eb = 0; return true; }
};
struct GroupedOrder {
    const int* tile_e; int nN, first, step, n;
    __device__ bool next(int i, Unit& u) const {
        if (i >= n) return false;
        const int L = first + i * step;
        u.pm = L / nN; u.pn = L % nN; u.eb = tile_e[u.pm]; return true;
    }
};

template <class Epi, class Sched, bool GATHER, bool HALFB = false>
__device__ __forceinline__ void gemm_phase(PG8_LAS unsigned char* lds, const Gemm g, const Sched& S, const Epi& E) {
    const int tid = threadIdx.x, wid = __builtin_amdgcn_readfirstlane(tid >> 6), lane = tid & 63, wr = wid >> 2, wc = wid & 3, fr = lane & 15, fq = lane >> 4;
    int K_ = g.K; asm volatile("" : "+s"(K_));
    const int K = K_, nt = K / BK;
    unsigned voffB[2]; unsigned cC[2]; int cR[2];
    unsigned vA0[2], vA1[2];
#pragma unroll
    for (int i = 0; i < 2; ++i) { int R, C; stage_rc(tid * 16 + i * 8192, R, C); const int Rb = Epi::PERM ? ((R & ~31) + perm32(R & 31)) : R;
        cR[i] = R; cC[i] = (unsigned)C * 2u; voffB[i] = (unsigned)(Rb * K + C) * 2u; vA0[i] = (unsigned)(R * K + C) * 2u; vA1[i] = vA0[i]; }
    const size_t kstep = (size_t)(BK * 2);
    const size_t hstep = (size_t)HALF * K * 2;
    const size_t tstep = 2 * hstep;
    const unsigned ldsw = (unsigned)wid * 1024u;
    const int aoff = lds_byte(wr * 64 + fr, fq * 8), boff = lds_byte(wc * 32 + fr, fq * 8);
#define PG8_SA(b, h) (((b) * 2 + (h)) * HTB)
#define PG8_SB(b, h) ((4 + (b) * 2 + (h)) * HTB)
#define PG8_STAGE(bufoff, gbase, voff) do { _Pragma("unroll") for (int _i = 0; _i < 2; ++_i) \
        __builtin_amdgcn_global_load_lds((const unsigned*)((const char*)(gbase) + (voff)[_i]), (PG8_LAS unsigned*)(lds + (bufoff) + ldsw + _i * 8192), 16, 0, 0); } while (0)
#define PG8_LDA(dst, b, h) do { _Pragma("unroll") for (int m = 0; m < 4; ++m) _Pragma("unroll") for (int k = 0; k < 2; ++k) dst[m][k] = *(const PG8_LAS f16x8*)(lds + PG8_SA(b, h) + aoff + m * 2048 + k * 1024); } while (0)
#define PG8_LDB(dst, b, h) do { _Pragma("unroll") for (int n = 0; n < 2; ++n) _Pragma("unroll") for (int k = 0; k < 2; ++k) dst[n][k] = *(const PG8_LAS f16x8*)(lds + PG8_SB(b, h) + boff + n * 2048 + k * 1024); } while (0)
#define PG8_MMA(ai, bj, At, Bt) do { __builtin_amdgcn_s_setprio(1); _Pragma("unroll") for (int m = 0; m < 4; ++m) _Pragma("unroll") for (int n = 0; n < 2; ++n) _Pragma("unroll") for (int k = 0; k < 2; ++k) \
        acc[ai][bj][m][n] = __builtin_amdgcn_mfma_f32_16x16x32_f16(Bt[n][k], At[m][k], acc[ai][bj][m][n], 0, 0, 0); __builtin_amdgcn_s_setprio(0); } while (0)
#define PG8_WAIT_V(n) asm volatile("s_waitcnt vmcnt(" #n ")" ::: "memory")
#define PG8_WAIT_L(n) asm volatile("s_waitcnt lgkmcnt(" #n ")" ::: "memory")
#define PG8_BAR __builtin_amdgcn_s_barrier()
#define PG8_SCHED __builtin_amdgcn_sched_barrier(0)
#define PG8_ABASE(u_) (GATHER ? (const char*)g.A : (const char*)g.A + (size_t)(u_).pm * tstep)
#define PG8_AH1 (GATHER ? (size_t)0 : hstep)
#define PG8_GATHER_OFF(u_, d0, d1) do { if (GATHER) { _Pragma("unroll") for (int _i = 0; _i < 2; ++_i) { \
        int r0_ = g.rowmap[(u_).pm * BM + cR[_i]], r1_ = g.rowmap[(u_).pm * BM + HALF + cR[_i]]; r0_ = r0_ < 0 ? 0 : r0_; r1_ = r1_ < 0 ? 0 : r1_; \
        d0[_i] = (unsigned)r0_ * (unsigned)(K * 2) + cC[_i]; d1[_i] = (unsigned)r1_ * (unsigned)(K * 2) + cC[_i]; } } } while (0)
    Unit cur, nxt; int ui = 0;
    if (!S.next(0, cur)) return;
    f32x4 acc[2][2][4][2];
#pragma unroll
    for (int a = 0; a < 2; ++a)
#pragma unroll
        for (int b = 0; b < 2; ++b)
#pragma unroll
            for (int m = 0; m < 4; ++m)
#pragma unroll
                for (int n = 0; n < 2; ++n) acc[a][b][m][n] = (f32x4){0.f, 0.f, 0.f, 0.f};
    f16x8 At[4][2], B0[2][2], B1[2][2];
    PG8_GATHER_OFF(cur, vA0, vA1);
    const char* cA = PG8_ABASE(cur); const char* cB = (const char*)g.Bt + (size_t)cur.eb * g.bstride + (size_t)cur.pn * tstep;
    PG8_STAGE(PG8_SB(0, 0), cB, voffB); PG8_STAGE(PG8_SB(0, 1), cB + hstep, voffB); PG8_STAGE(PG8_SA(0, 0), cA, vA0); PG8_STAGE(PG8_SA(0, 1), cA + PG8_AH1, vA1);
    if (wr == 1) PG8_BAR;
    PG8_WAIT_V(2); PG8_BAR;
    PG8_STAGE(PG8_SB(1, 0), cB + kstep, voffB); PG8_STAGE(PG8_SA(1, 0), cA + kstep, vA0); PG8_STAGE(PG8_SB(1, 1), cB + hstep + kstep, voffB);
    PG8_WAIT_V(6); PG8_BAR;
    for (;;) {
        const bool has_next = S.next(ui + 1, nxt);
        unsigned nA0[2] = {vA0[0], vA0[1]}, nA1[2] = {vA1[0], vA1[1]};
        if (has_next) PG8_GATHER_OFF(nxt, nA0, nA1);
        const char* nA = has_next ? PG8_ABASE(nxt) : cA; const char* nB = has_next ? (const char*)g.Bt + (size_t)nxt.eb * g.bstride + (size_t)nxt.pn * tstep : cB;
        for (int t = 0; t < nt; t += 2) {
            const bool last = (t == nt - 2);
            const char* a1 = cA + (size_t)(t + 1) * kstep;
            const char* a2 = last ? nA : cA + (size_t)(t + 2) * kstep; const char* b2 = last ? nB : cB + (size_t)(t + 2) * kstep;
            const char* a3 = a2 + kstep; const char* b3 = b2 + kstep;
            unsigned w0[2], w1[2];
#pragma unroll
            for (int i = 0; i < 2; ++i) { w0[i] = last ? nA0[i] : vA0[i]; w1[i] = last ? nA1[i] : vA1[i]; }
            PG8_LDB(B0, 0, 0); if constexpr (!HALFB) PG8_LDB(B1, 0, 1); PG8_SCHED; PG8_LDA(At, 0, 0); PG8_STAGE(PG8_SA(1, 1), a1 + PG8_AH1, vA1);
            PG8_WAIT_V(8); PG8_WAIT_L(0); PG8_BAR; PG8_MMA(0, 0, At, B0); if constexpr (!HALFB) PG8_MMA(0, 1, At, B1); PG8_BAR; PG8_SCHED;
            PG8_LDA(At, 0, 1); PG8_STAGE(PG8_SB(0, 0), b2, voffB); PG8_STAGE(PG8_SB(0, 1), b2 + hstep, voffB); PG8_STAGE(PG8_SA(0, 0), a2, w0);
            PG8_WAIT_V(8); PG8_WAIT_L(0); PG8_BAR; PG8_MMA(1, 0, At, B0); if constexpr (!HALFB) PG8_MMA(1, 1, At, B1); PG8_BAR; PG8_SCHED;
            PG8_LDB(B0, 1, 0); if constexpr (!HALFB) PG8_LDB(B1, 1, 1); PG8_SCHED; PG8_LDA(At, 1, 0); PG8_STAGE(PG8_SA(0, 1), a2 + PG8_AH1, w1);
            PG8_WAIT_V(8); PG8_WAIT_L(0); PG8_BAR; PG8_MMA(0, 0, At, B0); if constexpr (!HALFB) PG8_MMA(0, 1, At, B1); PG8_BAR; PG8_SCHED;
            PG8_LDA(At, 1, 1); PG8_STAGE(PG8_SB(1, 0), b3, voffB); PG8_STAGE(PG8_SB(1, 1), b3 + hstep, voffB); PG8_STAGE(PG8_SA(1, 0), a3, w0);
            PG8_WAIT_V(8); PG8_WAIT_L(0); PG8_BAR; PG8_MMA(1, 0, At, B0); if constexpr (!HALFB) PG8_MMA(1, 1, At, B1); PG8_BAR; PG8_SCHED;
        }
        if (wr == 0) PG8_BAR;
        E(acc, cur, wr, wc, fr, fq);
        if (!has_next) break;
#pragma unroll
        for (int a = 0; a < 2; ++a)
#pragma unroll
            for (int b = 0; b < 2; ++b)
#pragma unroll
                for (int m = 0; m < 4; ++m)
#pragma unroll
                    for (int n = 0; n < 2; ++n) acc[a][b][m][n] = (f32x4){0.f, 0.f, 0.f, 0.f};
        cur = nxt; cA = nA; cB = nB; ++ui;
#pragma unroll
        for (int i = 0; i < 2; ++i) { vA0[i] = nA0[i]; vA1[i] = nA1[i]; }
        if (wr == 1) PG8_BAR;
    }
    PG8_WAIT_V(0);
    PG8_BAR;
#undef PG8_SA
#undef PG8_SB
#undef PG8_STAGE
#undef PG8_LDA
#undef PG8_LDB
#undef PG8_MMA
#undef PG8_WAIT_V
#undef PG8_WAIT_L
#undef PG8_BAR
#undef PG8_SCHED
#undef PG8_ABASE
#undef PG8_AH1
#undef PG8_GATHER_OFF
}
}

struct EpiInProj {
    static constexpr bool PERM = true;
    h16 *Q, *K, *V, *QI, *KI, *GB, *Z; float* WI; const float *qn, *kn;
    __device__ __forceinline__ void operator()(const f32x4 (&acc)[2][2][4][2], const pg8::Unit& u, int wr, int wc, int fr, int fq) const {
        const int row0 = u.pm * 256 + wr * 64 + fr; const int pn = u.pn;
        if (pn < 4) {
            const bool isq = pn < 2; const float* g = isq ? qn : kn; h16* O = isq ? Q : K; const int head = 4 * (pn & 1) + wc; const float sc = isq ? QSCALE : 1.f;
            f32x4 gv[2][2];
#pragma unroll
            for (int bj = 0; bj < 2; ++bj)
#pragma unroll
                for (int n = 0; n < 2; ++n) gv[bj][n] = *(const f32x4*)(g + 32 * bj + 8 * fq + 4 * n) * sc;
#pragma unroll
            for (int ai = 0; ai < 2; ++ai)
#pragma unroll
                for (int m = 0; m < 4; ++m) {
                    float ss = 0.f;
#pragma unroll
                    for (int bj = 0; bj < 2; ++bj)
#pragma unroll
                        for (int n = 0; n < 2; ++n) { const f32x4 v = acc[ai][bj][m][n]; ss += (v[0] * v[0] + v[1] * v[1]) + (v[2] * v[2] + v[3] * v[3]); }
                    { const auto a_ = __builtin_amdgcn_permlane16_swap(__builtin_bit_cast(unsigned, ss), __builtin_bit_cast(unsigned, ss), false, false); const unsigned x_ = a_[0], y_ = a_[1]; ss = __builtin_bit_cast(float, x_) + __builtin_bit_cast(float, y_); }
                    { const auto a_ = __builtin_amdgcn_permlane32_swap(__builtin_bit_cast(unsigned, ss), __builtin_bit_cast(unsigned, ss), false, false); const unsigned x_ = a_[0], y_ = a_[1]; ss = __builtin_bit_cast(float, x_) + __builtin_bit_cast(float, y_); }
                    const float rstd = rsqrtf(ss * (1.f / 64.f) + EPS);
                    const int R = row0 + ai * 128 + m * 16;
                    if (isq) { h16* rowp = O + (size_t)R * 512 + head * 64 + 8 * fq;
#pragma unroll
                        for (int bj = 0; bj < 2; ++bj) *(u32x4*)(rowp + 32 * bj) = pk8h(acc[ai][bj][m][0] * rstd * gv[bj][0], acc[ai][bj][m][1] * rstd * gv[bj][1]); }
                    else {
                        h16* tp = O + ((size_t)((R >> 12) * 8 + head) * 64 + ((R & 4095) >> 6)) * 4096 + (R & 63) * 8;
#pragma unroll
                        for (int bj = 0; bj < 2; ++bj) *(u32x4*)(tp + (4 * bj + fq) * 512) = pk8h(acc[ai][bj][m][0] * rstd * gv[bj][0], acc[ai][bj][m][1] * rstd * gv[bj][1]); }
                }
        } else if (pn < 8) {
            h16* O = pn < 6 ? V : QI; const int head = 4 * (pn & 1) + wc;
#pragma unroll
            for (int ai = 0; ai < 2; ++ai)
#pragma unroll
                for (int m = 0; m < 4; ++m) { const int R = row0 + ai * 128 + m * 16;
                    if (pn >= 6) { h16* rowp = O + (size_t)R * 512 + head * 64 + 8 * fq;
#pragma unroll
                        for (int bj = 0; bj < 2; ++bj) *(u32x4*)(rowp + 32 * bj) = pk8h(acc[ai][bj][m][0], acc[ai][bj][m][1]); }
                    else {
                        const int kv = R & 63; h16* tp = O + ((size_t)((R >> 12) * 8 + head) * 64 + ((R & 4095) >> 6)) * 4096 + ((kv >> 4) * 64 + (kv & 15) * 4 + fq) * 8;
#pragma unroll
                        for (int bj = 0; bj < 2; ++bj) *(u32x4*)(tp + bj * 2048) = pk8h(acc[ai][bj][m][0], acc[ai][bj][m][1]); } }
        } else if (pn == 8) {
#pragma unroll
            for (int ai = 0; ai < 2; ++ai)
#pragma unroll
                for (int m = 0; m < 4; ++m) { const size_t row = (size_t)(row0 + ai * 128 + m * 16);
                    if (wc < 2) { const int R = (int)row, c8 = 4 * wc + fq;
                        *(u32x4*)(KI + ((((size_t)(R >> 12) * 128 + ((R & 4095) >> 5)) * 4 + (c8 >> 1)) * 64 + (R & 31) + 32 * (c8 & 1)) * 8) = pk8h(acc[ai][0][m][0], acc[ai][0][m][1]); }
                    else if (wc == 2 && fq == 0) { *(f32x4*)(WI + row * 8) = acc[ai][0][m][0]; *(f32x4*)(WI + row * 8 + 4) = acc[ai][0][m][1]; } }
        } else if (pn < 11) {
            const int colb = 256 * (pn - 9) + 32 * wc + 8 * fq;
#pragma unroll
            for (int ai = 0; ai < 2; ++ai)
#pragma unroll
                for (int m = 0; m < 4; ++m) { h16* rowp = GB + (size_t)(row0 + ai * 128 + m * 16) * 512 + colb;
#pragma unroll
                    for (int bj = 0; bj < 2; ++bj) *(u32x4*)(rowp + 128 * bj) = pk8h(acc[ai][bj][m][0], acc[ai][bj][m][1]); }
        } else {
            const int ch = 128 * (pn - 11) + 32 * wc + 8 * fq;
#pragma unroll
            for (int ai = 0; ai < 2; ++ai)
#pragma unroll
                for (int m = 0; m < 4; ++m) *(u32x4*)(Z + (size_t)(row0 + ai * 128 + m * 16) * 512 + ch) = pk8h(acc[ai][0][m][0] * acc[ai][1][m][0], acc[ai][0][m][1] * acc[ai][1][m][1]);
        }
    }
};
struct EpiOutProj {
    static constexpr bool PERM = false;
    const float* x; float* out; const float* mod;
    __device__ __forceinline__ void operator()(const f32x4 (&acc)[2][2][4][2], const pg8::Unit& u, int wr, int wc, int fr, int fq) const {
        const int row0 = u.pm * 256 + wr * 64 + fr; const int b = (u.pm * 256) >> 12; const int col0 = u.pn * 256 + wc * 32 + 4 * fq;
        f32x4 gv[2][2];
#pragma unroll
        for (int bj = 0; bj < 2; ++bj)
#pragma unroll
            for (int n = 0; n < 2; ++n) gv[bj][n] = *(const f32x4*)(mod + (size_t)b * 6144 + 2048 + col0 + bj * 128 + n * 16);
#pragma unroll
        for (int ai = 0; ai < 2; ++ai)
#pragma unroll
            for (int m = 0; m < 4; ++m) { const size_t off = (size_t)(row0 + ai * 128 + m * 16) * 1024 + col0;
#pragma unroll
                for (int bj = 0; bj < 2; ++bj)
#pragma unroll
                    for (int n = 0; n < 2; ++n) { const f32x4 xv = *(const f32x4*)(x + off + bj * 128 + n * 16); *(f32x4*)(out + off + bj * 128 + n * 16) = xv + gv[bj][n] * acc[ai][bj][m][n]; } }
    }
};
struct EpiMoeUp {
    static constexpr bool PERM = true;
    h16* HID;
    __device__ __forceinline__ void operator()(const f32x4 (&acc)[2][2][4][2], const pg8::Unit& u, int wr, int wc, int fr, int fq) const {
        const int row0 = u.pm * 256 + wr * 64 + fr; const int f0 = 128 * u.pn + 32 * wc + 8 * fq;
#pragma unroll
        for (int ai = 0; ai < 2; ++ai)
#pragma unroll
            for (int m = 0; m < 4; ++m) { f32x4 hv[2];
#pragma unroll
                for (int n = 0; n < 2; ++n) { const f32x4 a = acc[ai][0][m][n], bb = acc[ai][1][m][n];
#pragma unroll
                    for (int i = 0; i < 4; ++i) hv[n][i] = silu_f(a[i]) * bb[i]; }
                *(u32x4*)(HID + (size_t)(row0 + ai * 128 + m * 16) * 256 + f0) = pk8h(hv[0], hv[1]); }
    }
};
struct EpiMoeDown {
    static constexpr bool PERM = true;
    h16* Y;
    __device__ __forceinline__ void operator()(const f32x4 (&acc)[2][2][4][2], const pg8::Unit& u, int wr, int wc, int fr, int fq) const {
        const int row0 = u.pm * 256 + wr * 64 + fr; const int c0 = 256 * u.pn + 32 * wc + 8 * fq;
#pragma unroll
        for (int ai = 0; ai < 2; ++ai)
#pragma unroll
            for (int m = 0; m < 4; ++m) { h16* rowp = Y + (size_t)(row0 + ai * 128 + m * 16) * 1024 + c0;
#pragma unroll
                for (int bj = 0; bj < 2; ++bj) *(u32x4*)(rowp + 128 * bj) = pk8h(acc[ai][bj][m][0], acc[ai][bj][m][1]); }
    }
};

struct Args { const float* in[21]; float* out; unsigned char* ws; int ph_lo, ph_hi; };
struct Frame {
    LAS unsigned char* lds; unsigned char* ldsg;
    int tid, lane, wave, vcu, G;
    const float* const __attribute__((address_space(4)))* in; float* out; unsigned char* ws;
};

#define XB_TMO      128
#define XB_XCNT(j)  (256  + 64 * (j))
#define XB_XSUB(j)  (1280 + 64 * (j))
#define XB_XGEN(j)  (2304 + 64 * (j))
#define XB_TOP      3328
#define XB_TOPGEN   3392
#define XCD_BAR_WORDS 3456
#define XB_SPIN_CAP (1u << 20)
__device__ __forceinline__ unsigned xb_ld(unsigned* p)              { return __hip_atomic_load(p, __ATOMIC_RELAXED, __HIP_MEMORY_SCOPE_AGENT); }
__device__ __forceinline__ unsigned xb_add(unsigned* p, unsigned v) { return __hip_atomic_fetch_add(p, v, __ATOMIC_RELAXED, __HIP_MEMORY_SCOPE_AGENT); }
__device__ __forceinline__ unsigned xb_xcc_id() { return (unsigned)__builtin_amdgcn_s_getreg((3 << 11) | 20) & 0xFu; }
#define XB_SPIN(cond, bar) do { unsigned _sp = 0; while (cond) { __builtin_amdgcn_s_sleep(1); \
    if ((++_sp & 255u) == 0u) { if (xb_ld(&(bar)[XB_TMO])) break; if (_sp > XB_SPIN_CAP) { atomicAdd(&(bar)[XB_TMO], 1u); break; } } } } while (0)
struct XcdBarrier { unsigned* bar; unsigned x; volatile LAS unsigned* st; };
__device__ __forceinline__ XcdBarrier xcd_barrier_post(unsigned* bar, volatile LAS unsigned* st) {
    XcdBarrier b; b.bar = bar; b.x = xb_xcc_id(); b.st = st;
    if (threadIdx.x == 0) (void)xb_add(&bar[XB_XCNT(b.x)], 1u);
    return b;
}
__device__ __forceinline__ void xcd_barrier_complete(unsigned* bar, unsigned x, unsigned& nloc, unsigned& nx) {
    const unsigned G = gridDim.x * gridDim.y * gridDim.z;
    unsigned sum, cnt, mine, sp = 0u;
    for (;;) {
        sum = 0u; cnt = 0u; mine = 0u;
#pragma unroll
        for (unsigned j = 0; j < 16; ++j) { const unsigned c = xb_ld(&bar[XB_XCNT(j)]); sum += c; cnt += (c > 0u) ? 1u : 0u; mine = (j == x) ? c : mine; }
        if (sum == G) break;
        __builtin_amdgcn_s_sleep(1);
        if ((++sp & 255u) == 0u) { if (xb_ld(&bar[XB_TMO])) break; if (sp > XB_SPIN_CAP) { atomicAdd(&bar[XB_TMO], 1u); break; } }
    }
    nloc = mine > 0u ? mine : 1u; nx = cnt > 0u ? cnt : 1u;
}
__device__ __forceinline__ void xcd_barrier(const XcdBarrier& b) {
    asm volatile("s_waitcnt vmcnt(0)" ::: "memory");
    __syncthreads();
    if (threadIdx.x == 0) {
        unsigned* bar = b.bar;
        __builtin_amdgcn_s_waitcnt(0);
        unsigned nloc = b.st[0], nx = b.st[1];
        if (nloc == 0u) { xcd_barrier_complete(bar, b.x, nloc, nx); b.st[0] = nloc; b.st[1] = nx; }
        const unsigned old = xb_add(&bar[XB_XSUB(b.x)], 1u);
        const unsigned gen = old / nloc;
        if (old + 1u == (gen + 1u) * nloc) {
            __builtin_amdgcn_fence(__ATOMIC_RELEASE, "agent");
            asm volatile("s_waitcnt vmcnt(0)" ::: "memory");
            const unsigned og = xb_add(&bar[XB_TOP], 1u);
            const unsigned tg = og / nx;
            if (og + 1u == (tg + 1u) * nx) xb_add(&bar[XB_TOPGEN], 1u);
            else XB_SPIN(xb_ld(&bar[XB_TOPGEN]) == tg, bar);
            __builtin_amdgcn_fence(__ATOMIC_ACQUIRE, "agent");
            xb_add(&bar[XB_XGEN(b.x)], 1u);
            asm volatile("s_waitcnt vmcnt(0)" ::: "memory");
        } else {
            XB_SPIN(xb_ld(&bar[XB_XGEN(b.x)]) == gen, bar);
            __builtin_amdgcn_fence(__ATOMIC_ACQUIRE, "agent");
            asm volatile("s_waitcnt vmcnt(0)" ::: "memory");
        }
    }
    __syncthreads();
}

template <bool NTS = false>
__device__ __forceinline__ void transpose_item(const float* src, int ldw, int nvalid, int k0, h16* dst, int K, LAS float* scr, int lane) {
    const int c4 = lane & 7, rsub = lane >> 3;
    f32x4 v[8];
#pragma unroll
    for (int i = 0; i < 8; ++i) v[i] = (4 * c4 < nvalid) ? NT_LD(f32x4, src + (size_t)(k0 + 8 * i + rsub) * ldw + 4 * c4) : (f32x4){0.f, 0.f, 0.f, 0.f};
#pragma unroll
    for (int i = 0; i < 8; ++i) { LAS float* p = scr + (8 * i + rsub) * 33 + 4 * c4; p[0] = v[i][0]; p[1] = v[i][1]; p[2] = v[i][2]; p[3] = v[i][3]; }
    LDS_WAIT(); asm volatile("" ::: "memory");
    const int c = lane & 7;
#pragma unroll
    for (int j = 0; j < 4; ++j) { const int nn = (lane >> 3) + 8 * j; const LAS float* s = scr + (8 * c) * 33 + nn;
        u32x4 o; o.x = pk2h(s[0 * 33], s[1 * 33]); o.y = pk2h(s[2 * 33], s[3 * 33]); o.z = pk2h(s[4 * 33], s[5 * 33]); o.w = pk2h(s[6 * 33], s[7 * 33]);
        if (NTS) NT_ST(u32x4, dst + (size_t)nn * K + k0 + 8 * c, o); else *(u32x4*)(dst + (size_t)nn * K + k0 + 8 * c) = o; }
    LDS_WAIT(); asm volatile("" ::: "memory");
}
__device__ __forceinline__ int win_group_src(int g, int& nvalid) {
    const int tile = g >> 3, p = (g & 7) * 32, bj = p >> 7, wc = (p >> 5) & 3; nvalid = 32;
    if (tile < 8) { const int seg = tile >> 1; return seg * 512 + 64 * (4 * (tile & 1) + wc) + 32 * bj; }
    if (tile == 8) { if (p < 64) return 2048 + p; if (p == 64) { nvalid = 8; return 2112; } nvalid = 0; return 0; }
    if (tile < 11) return 2120 + 256 * (tile - 9) + p;
    return (bj == 0 ? 2632 : 3144) + 128 * (tile - 11) + 32 * wc;
}
__device__ __forceinline__ void p0_prologue(Frame& F) {
    LAS float* scr = (LAS float*)(F.lds + F.wave * 16384);
    const int gw = F.vcu * NWAVES + F.wave, NGW = F.G * NWAVES;
    const float* w_in = F.in[6]; const float* w_out = F.in[12]; const float* w_gate = F.in[18]; const float* w_up = F.in[19]; const float* w_down = F.in[20];
    h16* WINT = (h16*)(F.ws + WS_WINT); h16* WOUTT = (h16*)(F.ws + WS_WOUTT); h16* WGUT = (h16*)(F.ws + WS_WGUT); h16* WDT = (h16*)(F.ws + WS_WDT);
    constexpr int I_IN = 120 * 16, I_OUT = 32 * 16, I_GU = 32 * 16 * 16, I_D = 32 * 32 * 4, I_MOD = 96 * 16;
    constexpr int NITEMS = I_IN + I_OUT + I_GU + I_D + I_MOD;
    for (int it = gw; it < NITEMS; it += NGW) {
        int r = it;
        if (r < I_MOD) {
            const int cc = r % 96, ks = r / 96; const int col = cc * 64 + F.lane, k0 = ks * 64;
            const float* c = F.in[1]; const float* w_ada = F.in[3];
            float ca[8];
#pragma unroll
            for (int b = 0; b < 8; ++b) ca[b] = silu_f(c[b * 1024 + k0 + F.lane]);
            float a[8] = {0.f, 0.f, 0.f, 0.f, 0.f, 0.f, 0.f, 0.f};
#pragma unroll 8
            for (int kk = 0; kk < 64; ++kk) { const float w = NT_LD(float, w_ada + (size_t)(k0 + kk) * 6144 + col);
#pragma unroll
                for (int b = 0; b < 8; ++b) a[b] += __builtin_bit_cast(float, __builtin_amdgcn_readlane(__builtin_bit_cast(int, ca[b]), kk)) * w; }
            float* mp = (float*)(F.ws + WS_MODP) + (size_t)ks * 8 * 6144;
#pragma unroll
            for (int b = 0; b < 8; ++b) mp[b * 6144 + col] = a[b];
            continue;
        }
        r -= I_MOD;
        if (r < I_IN) { const int g = r >> 4, kb = r & 15; int nv; const int s0 = win_group_src(g, nv); transpose_item(w_in + s0, 3656, nv, kb * 64, WINT + (size_t)g * 32 * 1024, 1024, scr, F.lane); continue; } r -= I_IN;
        if (r < I_OUT) { const int g = r >> 4, kb = r & 15; transpose_item<true>(w_out + g * 32, 1024, 32, kb * 64, WOUTT + (size_t)g * 32 * 1024, 1024, scr, F.lane); continue; } r -= I_OUT;
        if (r < I_GU) { const int e = r >> 8, g = (r >> 4) & 15, kb = r & 15; const int p = g * 32, t2 = p >> 8, bj = (p >> 7) & 1, wc = (p >> 5) & 3; const int f = 128 * t2 + 32 * wc;
            transpose_item<true>((bj == 0 ? w_gate : w_up) + (size_t)e * 1024 * 256 + f, 256, 32, kb * 64, WGUT + ((size_t)e * 512 + p) * 1024, 1024, scr, F.lane); continue; } r -= I_GU;
        { const int e = r >> 7, g = (r >> 2) & 31, kb = r & 3; transpose_item<true>(w_down + (size_t)e * 256 * 1024 + g * 32, 1024, 32, kb * 64, WDT + ((size_t)e * 1024 + g * 32) * 256, 256, scr, F.lane); }
    }
    { const float* wgr = F.in[14]; const float* wer = F.in[16]; h16* WRL = (h16*)(F.ws + WS_WRL);
      for (int idx = F.vcu * NTHR + F.tid; idx < 36 * 1024; idx += F.G * NTHR) { const int o = idx >> 10, rem = idx & 1023, ln = rem >> 4, ji = rem & 15, col = 4 * ln + 256 * (ji >> 2) + (ji & 3);
          WRL[idx] = (h16)(o < 4 ? wgr[col * 4 + o] : wer[col * 32 + (o - 4)]); } }
}

__device__ __forceinline__ void p1_norm1(Frame& F) {
    const float* modp = (const float*)(F.ws + WS_MODP); float* mod = (float*)(F.ws + WS_MOD); const float* b_ada = F.in[4];
    LAS float* sh = (LAS float*)F.lds; LAS float* sc = sh + 1024;
    const int b = F.vcu >> 5;
    for (int i = F.tid; i < 2048; i += NTHR) { float s = b_ada[i];
#pragma unroll
        for (int ks = 0; ks < 16; ++ks) s += modp[((size_t)ks * 8 + b) * 6144 + i];
        sh[i] = s; }
    if (F.tid < 192) { const int idx = F.vcu * 192 + F.tid; const int bb = idx / 6144, cc = idx % 6144; float s = b_ada[cc];
#pragma unroll
        for (int ks = 0; ks < 16; ++ks) s += modp[((size_t)ks * 8 + bb) * 6144 + cc];
        mod[idx] = s; }
    __syncthreads();
    const float* x = F.in[0]; const float* g1 = F.in[5]; h16* H = (h16*)(F.ws + WS_H);
    f32x4 gg[4], s1[4], h1[4];
#pragma unroll
    for (int j = 0; j < 4; ++j) { const int col = 4 * F.lane + 256 * j; gg[j] = *(const f32x4*)(g1 + col); h1[j] = *(const LAS f32x4*)(sh + col); s1[j] = *(const LAS f32x4*)(sc + col);
        gg[j] = gg[j] * (s1[j] + 1.f); }
    f32x4 vn[4];
    { const size_t row = (size_t)F.vcu * 128 + F.wave * 16;
#pragma unroll
      for (int j = 0; j < 4; ++j) vn[j] = NT_LD(f32x4, x + row * 1024 + 4 * F.lane + 256 * j); }
    for (int rr = 0; rr < 16; ++rr) {
        const size_t row = (size_t)F.vcu * 128 + F.wave * 16 + rr; const size_t rown = row + (rr < 15 ? 1 : 0);
        f32x4 v[4]; float ss = 0.f;
#pragma unroll
        for (int j = 0; j < 4; ++j) { v[j] = vn[j]; vn[j] = NT_LD(f32x4, x + rown * 1024 + 4 * F.lane + 256 * j); ss += (v[j][0] * v[j][0] + v[j][1] * v[j][1]) + (v[j][2] * v[j][2] + v[j][3] * v[j][3]); }
        const float rstd = rsqrtf(dpp_sum_f32(ss) * (1.f / 1024.f) + EPS);
#pragma unroll
        for (int j = 0; j < 4; ++j) { const f32x4 o = v[j] * rstd * gg[j] + h1[j]; u32x2 w; w.x = pk2h(o[0], o[1]); w.y = pk2h(o[2], o[3]); *(u32x2*)(H + row * 1024 + 4 * F.lane + 256 * j) = w; }
    }
}

__device__ __forceinline__ void p3_conv(Frame& F) {
    const h16* Z = (const h16*)(F.ws + WS_Z); const h16* GB = (const h16*)(F.ws + WS_GB); h16* MG = (h16*)(F.ws + WS_MERGED);
    const float* cw = F.in[9]; const float* cn = F.in[11];
    const int gw = F.vcu * NWAVES + F.wave, NGW = F.G * NWAVES; const int ch = 8 * F.lane;
    float w0[8], w1[8], w2[8], gn[8];
#pragma unroll
    for (int i = 0; i < 8; ++i) { w0[i] = cw[ch + i]; w1[i] = cw[512 + ch + i]; w2[i] = cw[1024 + ch + i]; gn[i] = cn[ch + i]; }
    for (int it = gw; it < M / 16; it += NGW) {
        const int t0 = it * 16; const bool first = (t0 & (SEQ - 1)) == 0;
        f16x8 zm2 = {}, zm1 = {};
        if (!first) { zm2 = *(const f16x8*)(Z + (size_t)(t0 - 2) * 512 + ch); zm1 = *(const f16x8*)(Z + (size_t)(t0 - 1) * 512 + ch); }
        f16x8 zn = NT_LD(f16x8, Z + (size_t)t0 * 512 + ch), gbn = NT_LD(f16x8, GB + (size_t)t0 * 512 + ch);
        for (int tt = 0; tt < 16; ++tt) {
            const size_t t = (size_t)t0 + tt; const size_t tn = t + (tt < 15 ? 1 : 0);
            const f16x8 z0 = zn, gb = gbn;
            zn = NT_LD(f16x8, Z + tn * 512 + ch); gbn = NT_LD(f16x8, GB + tn * 512 + ch);
            float y[8]; float ss = 0.f;
#pragma unroll
            for (int i = 0; i < 8; ++i) { y[i] = (float)gb[i] * (w0[i] * (float)zm2[i] + w1[i] * (float)zm1[i] + w2[i] * (float)z0[i]); ss += y[i] * y[i]; }
            ss += __shfl_xor(ss, 1); ss += __shfl_xor(ss, 2); ss += __shfl_xor(ss, 4);
            const float rstd = rsqrtf(ss * (1.f / 64.f) + EPS);
            u32x4 o; o.x = pk2h(y[0] * rstd * gn[0], y[1] * rstd * gn[1]); o.y = pk2h(y[2] * rstd * gn[2], y[3] * rstd * gn[3]); o.z = pk2h(y[4] * rstd * gn[4], y[5] * rstd * gn[5]); o.w = pk2h(y[6] * rstd * gn[6], y[7] * rstd * gn[7]);
            *(u32x4*)(MG + t * 1024 + 512 + ch) = o;
            zm2 = zm1; zm1 = z0;
        }
    }
}

constexpr int IX_ROW = 4352, IX_NEG = 8 * IX_ROW * 4, IX_BM = IX_NEG + 256, IX_ST = IX_BM + 4096;
__device__ __forceinline__ unsigned fkey(float f) { const unsigned u = __builtin_bit_cast(unsigned, f); return u ^ ((u >> 31) ? 0xFFFFFFFFu : 0x80000000u); }
__device__ __forceinline__ float fkey_inv(unsigned k) { const unsigned u = (k >> 31) ? (k ^ 0x80000000u) : ~k; return __builtin_bit_cast(float, u); }
__device__ __forceinline__ float probit_lo(float p) {
    if (p < 0.02425f) { const float q = __builtin_amdgcn_sqrtf(-2.f * __logf(p));
        return (((((-7.784894002430293e-03f * q - 3.223964580411365e-01f) * q - 2.400758277161838e+00f) * q - 2.549732539343734e+00f) * q + 4.374664141464968e+00f) * q + 2.938163982698783e+00f) *
               __builtin_amdgcn_rcpf((((7.784695709041462e-03f * q + 3.224671290700398e-01f) * q + 2.445134137142996e+00f) * q + 3.754408661907416e+00f) * q + 1.f); }
    const float q = p - 0.5f, r = q * q;
    return (((((-3.969683028665376e+01f * r + 2.209460984245205e+02f) * r - 2.759285104469687e+02f) * r + 1.383577518672690e+02f) * r - 3.066479806614716e+01f) * r + 2.506628277459239e+00f) * q *
           __builtin_amdgcn_rcpf(((((-5.447609879822406e+01f * r + 1.615858368580409e+02f) * r - 1.556989798598866e+02f) * r + 6.680131188771972e+01f) * r - 1.328068155288572e+01f) * r + 1.f);
}
__device__ __forceinline__ void row_sum2(float v, float& h0, float& h1) {
    v += __builtin_bit_cast(float, __builtin_amdgcn_update_dpp(0, __builtin_bit_cast(int, v), 0xB1, 0xf, 0xf, false));
    v += __builtin_bit_cast(float, __builtin_amdgcn_update_dpp(0, __builtin_bit_cast(int, v), 0x4E, 0xf, 0xf, false));
    v += __builtin_bit_cast(float, __builtin_amdgcn_update_dpp(0, __builtin_bit_cast(int, v), 0x141, 0xf, 0xf, false));
    v += __builtin_bit_cast(float, __builtin_amdgcn_update_dpp(0, __builtin_bit_cast(int, v), 0x140, 0xf, 0xf, false));
    h0 = __builtin_bit_cast(float, __builtin_amdgcn_readlane(__builtin_bit_cast(int, v), 0)) + __builtin_bit_cast(float, __builtin_amdgcn_readlane(__builtin_bit_cast(int, v), 16));
    h1 = __builtin_bit_cast(float, __builtin_amdgcn_readlane(__builtin_bit_cast(int, v), 32)) + __builtin_bit_cast(float, __builtin_amdgcn_readlane(__builtin_bit_cast(int, v), 48));
}
__device__ __forceinline__ unsigned eval_mask(const float (&v)[64], float x, unsigned& a, unsigned& b) {
    unsigned ma = 0u, mb = 0u;
#pragma unroll
    for (int i = 31; i >= 0; --i) { ma = __builtin_amdgcn_alignbit(ma, __builtin_bit_cast(unsigned, v[i] - x), 31); mb = __builtin_amdgcn_alignbit(mb, __builtin_bit_cast(unsigned, v[32 + i] - x), 31); }
    a = ma; b = mb;
    return dpp_sum_u32(64u - (unsigned)__builtin_popcount(ma) - (unsigned)__builtin_popcount(mb));
}
__device__ __forceinline__ unsigned eval_mask_pk(const float (&v)[64], float x, unsigned& a, unsigned& b) {
    unsigned ma = 0u, mb = 0u; const f32x2 xx = {x, x};
#pragma unroll
    for (int i = 30; i >= 0; i -= 2) { const f32x2 da = (f32x2){v[i], v[i + 1]} - xx, db = (f32x2){v[32 + i], v[33 + i]} - xx;
        const float a1 = da[1], a0 = da[0], b1 = db[1], b0 = db[0];
        ma = __builtin_amdgcn_alignbit(ma, __builtin_bit_cast(unsigned, a1), 31); ma = __builtin_amdgcn_alignbit(ma, __builtin_bit_cast(unsigned, a0), 31);
        mb = __builtin_amdgcn_alignbit(mb, __builtin_bit_cast(unsigned, b1), 31); mb = __builtin_amdgcn_alignbit(mb, __builtin_bit_cast(unsigned, b0), 31); }
    a = ma; b = mb;
    return dpp_sum_u32(64u - (unsigned)__builtin_popcount(ma) - (unsigned)__builtin_popcount(mb));
}
__device__ __forceinline__ unsigned eval_mask32(const float (&v)[64], float x, unsigned& a, unsigned& b) {
    unsigned ma = 0u;
#pragma unroll
    for (int i = 31; i >= 0; --i) ma = __builtin_amdgcn_alignbit(ma, __builtin_bit_cast(unsigned, v[i] - x), 31);
    a = ma; b = 0xFFFFFFFFu;
    return dpp_sum_u32(32u - (unsigned)__builtin_popcount(ma));
}
__device__ __forceinline__ unsigned eval_mask_pk32(const float (&v)[64], float x, unsigned& a, unsigned& b) {
    unsigned ma = 0u; const f32x2 xx = {x, x};
#pragma unroll
    for (int i = 30; i >= 0; i -= 2) { const f32x2 da = (f32x2){v[i], v[i + 1]} - xx; const float a1 = da[1], a0 = da[0];
        ma = __builtin_amdgcn_alignbit(ma, __builtin_bit_cast(unsigned, a1), 31); ma = __builtin_amdgcn_alignbit(ma, __builtin_bit_cast(unsigned, a0), 31); }
    a = ma; b = 0xFFFFFFFFu;
    return dpp_sum_u32(32u - (unsigned)__builtin_popcount(ma));
}
__device__ __forceinline__ unsigned eval_any(const float (&v)[64], float x, unsigned& a, unsigned& b, bool sh) {
    const unsigned ux = __builtin_bit_cast(unsigned, x) & 0x7FFFFFFFu;
    if (ux != 0u && ux < 0x00800000u) return sh ? eval_mask32(v, x, a, b) : eval_mask(v, x, a, b);
    return sh ? eval_mask_pk32(v, x, a, b) : eval_mask_pk(v, x, a, b);
}
__device__ __forceinline__ float probit(float p) { return p > 0.5f ? -probit_lo(1.f - p) : probit_lo(p); }
__device__ __forceinline__ unsigned count_ge(const float (&v)[64], float x) {
    unsigned c = 0;
#pragma unroll
    for (int i = 0; i < 64; ++i) c += (v[i] >= x) ? 1u : 0u;
    return dpp_sum_u32(c);
}
__device__ __forceinline__ float relu_i(float x) { const int i = __builtin_bit_cast(int, x); return __builtin_bit_cast(float, i > 0 ? i : 0); }
constexpr int IX_CTR = IX_ST + 512;
__device__ __forceinline__ void p3_indexer(Frame& F) {
    const h16* QI = (const h16*)(F.ws + WS_QI); const h16* KI = (const h16*)(F.ws + WS_KI); const float* WI = (const float*)(F.ws + WS_WI); u64* BM = (u64*)(F.ws + WS_BM);
    LAS float* sc = (LAS float*)F.lds;
    LAS float* st = (LAS float*)(F.lds + IX_ST);
    LAS unsigned* ctr = (LAS unsigned*)(F.lds + IX_CTR);
    const int lane = F.lane, wid = F.wave, r32 = lane & 31, hi = lane >> 5;
    if (F.tid < 64) ((LAS float*)(F.lds + IX_NEG))[F.tid] = -__builtin_inff();
    if (F.tid < 2) ctr[F.tid] = 0u;
    __syncthreads();
    const int hq = (r32 >> 2) & 1, rr = (r32 & 3) + 4 * (r32 >> 3), jq = 2 * hq + (rr >> 3), hh = rr & 7;
    f16x8 af[2][4]; f32x4 wraw[2][2][2];
#define IX_QLOAD(u_) do { const int c_ = F.vcu & 31; const size_t rb_ = (size_t)(F.vcu >> 5) * SEQ + (size_t)((u_) * 32 + (((u_) & 1) ? (31 - c_) : c_)) * 8; \
        _Pragma("unroll") for (int rb = 0; rb < 2; ++rb) { const h16* qp = QI + (rb_ + 4 * rb + jq) * 512 + hh * 64 + hi * 8; \
            _Pragma("unroll") for (int ks = 0; ks < 4; ++ks) af[rb][ks] = *(const f16x8*)(qp + ks * 16); \
            _Pragma("unroll") for (int j2 = 0; j2 < 2; ++j2) { const float* wp = WI + (rb_ + 4 * rb + 2 * hi + j2) * 8; wraw[rb][j2][0] = *(const f32x4*)wp; wraw[rb][j2][1] = *(const f32x4*)(wp + 4); } } } while (0)
    IX_QLOAD(0);
    for (int u = 0; u < 16; ++u) {
        const int b = F.vcu >> 5, t0 = (u * 32 + ((u & 1) ? (31 - (F.vcu & 31)) : (F.vcu & 31))) * 8;
        const size_t rowb = (size_t)b * SEQ;
        const int nj = (t0 + 8 + 63) >> 6;
        {
            float wv[2][16];
#pragma unroll
            for (int rb = 0; rb < 2; ++rb)
#pragma unroll
                for (int j2 = 0; j2 < 2; ++j2)
#pragma unroll
                    for (int i = 0; i < 4; ++i) { wv[rb][8 * j2 + i] = wraw[rb][j2][0][i] * IDX_SCALE; wv[rb][8 * j2 + 4 + i] = wraw[rb][j2][1][i] * IDX_SCALE; }
            float ssum[2][2] = {{0.f, 0.f}, {0.f, 0.f}}, ssq[2][2] = {{0.f, 0.f}, {0.f, 0.f}};
            const h16* kbase = KI + (size_t)b * (128 * 2048) + lane * 8;
#define IX_TICKET(t_) do { asm volatile("ds_add_rtn_u32 %0, %1, %2" : "=v"(t_) : "v"(ctr_addr + 4u * (unsigned)(u & 1)), "v"(1u) : "memory"); } while (0)
#define IX_TGET(t_) ({ int g_; asm volatile("s_waitcnt lgkmcnt(0)\n\tv_readfirstlane_b32 %0, %1" : "=s"(g_) : "v"(t_) : "memory"); g_ >> 6; })
#define IX_LOAD(dst, g_) do { const int gg_ = (g_) < nj ? (g_) : nj - 1; _Pragma("unroll") for (int q = 0; q < 2; ++q) { const h16* kp = kbase + (size_t)(2 * gg_ + q) * 2048; \
                _Pragma("unroll") for (int ks = 0; ks < 4; ++ks) dst[q][ks] = *(const f16x8*)(kp + ks * 512); } } while (0)
#define IX_MMA(x0, x1, kt) do { x0 = f32x16{}; x1 = f32x16{}; \
                _Pragma("unroll") for (int ks = 0; ks < 4; ++ks) { x0 = __builtin_amdgcn_mfma_f32_32x32x16_f16(af[0][ks], kt[ks], x0, 0, 0, 0); x1 = __builtin_amdgcn_mfma_f32_32x32x16_f16(af[1][ks], kt[ks], x1, 0, 0, 0); } } while (0)
#define IX_VAL(x0, x1, tile_, DIAG) do { const int tile = (tile_); const int key = tile * 32 + r32; const int pos = key + 4 * (key >> 6); \
                _Pragma("unroll") for (int rb = 0; rb < 2; ++rb) { float s0 = 0.f, s1 = 0.f; \
                    _Pragma("unroll") for (int r = 0; r < 8; ++r) { const float d0 = rb ? x1[r] : x0[r], d1 = rb ? x1[8 + r] : x0[8 + r]; \
                        s0 = __builtin_fmaf(relu_i(d0), wv[rb][r], s0); s1 = __builtin_fmaf(relu_i(d1), wv[rb][8 + r], s1); } \
                    float z0 = s0, z1 = s1; \
                    if (DIAG) { if (tile * 32 + 31 > t0) { const int tq = t0 + 4 * rb + 2 * hi; const bool v0 = key <= tq, v1 = key <= tq + 1; z0 = v0 ? s0 : 0.f; z1 = v1 ? s1 : 0.f; s0 = v0 ? s0 : -__builtin_inff(); s1 = v1 ? s1 : -__builtin_inff(); } } \
                    ssum[rb][0] += z0; ssq[rb][0] = __builtin_fmaf(z0, z0, ssq[rb][0]); ssum[rb][1] += z1; ssq[rb][1] = __builtin_fmaf(z1, z1, ssq[rb][1]); \
                    sc[(4 * rb + 2 * hi) * IX_ROW + pos] = s0; sc[(4 * rb + 2 * hi + 1) * IX_ROW + pos] = s1; } } while (0)
            const int nf = nj - 1;
            const unsigned ctr_addr = (unsigned)(size_t)ctr;
            f16x8 kA[2][4], kB[2][4]; f32x16 a0, a1, b0, b1;
            unsigned tk; IX_TICKET(tk); int g0 = IX_TGET(tk), g1, gl = g0; bool lastInA = true;
            IX_LOAD(kA, g0);
            if (g0 < nf) {
                IX_TICKET(tk); g1 = IX_TGET(tk); IX_LOAD(kB, g1);
                IX_MMA(a0, a1, kA[0]);
                for (;;) {
                    IX_TICKET(tk);
                    IX_MMA(b0, b1, kA[1]); IX_VAL(a0, a1, 2 * g0, false);
                    IX_MMA(a0, a1, kB[0]); IX_VAL(b0, b1, 2 * g0 + 1, false);
                    const int g2 = IX_TGET(tk);
                    if (g1 >= nf) { gl = g1; lastInA = false; break; }
                    IX_LOAD(kA, g2);
                    IX_TICKET(tk);
                    IX_MMA(b0, b1, kB[1]); IX_VAL(a0, a1, 2 * g1, false);
                    IX_MMA(a0, a1, kA[0]); IX_VAL(b0, b1, 2 * g1 + 1, false);
                    g0 = g2; g1 = IX_TGET(tk);
                    if (g0 >= nf) { gl = g0; lastInA = true; break; }
                    IX_LOAD(kB, g1);
                }
            }
            if (gl == nf) {
                if (lastInA) { IX_MMA(a0, a1, kA[0]); IX_VAL(a0, a1, 2 * nf, true); IX_MMA(b0, b1, kA[1]); IX_VAL(b0, b1, 2 * nf + 1, true); }
                else         { IX_MMA(a0, a1, kB[0]); IX_VAL(a0, a1, 2 * nf, true); IX_MMA(b0, b1, kB[1]); IX_VAL(b0, b1, 2 * nf + 1, true); }
            }
#undef IX_TICKET
#undef IX_TGET
#undef IX_LOAD
#undef IX_MMA
#undef IX_VAL
#pragma unroll
            for (int rb = 0; rb < 2; ++rb)
#pragma unroll
                for (int j2 = 0; j2 < 2; ++j2) { float s0_, s1_, q0_, q1_; row_sum2(ssum[rb][j2], s0_, s1_); row_sum2(ssq[rb][j2], q0_, q1_);
                    if (lane == 0) { LAS float* sp = st + wid * 16 + (4 * rb + j2) * 2; sp[0] = s0_; sp[1] = q0_; sp[4] = s1_; sp[5] = q1_; } }
            IX_QLOAD(u < 15 ? u + 1 : 15);
        }
        __syncthreads();
        if (F.tid == 0) ctr[(u + 1) & 1] = 0u;
        const int t = t0 + wid, n = t + 1;
        const bool sh = (t0 + 8 <= 2048);
        float v[64]; float ssum_ = 0.f, ssq_ = 0.f;
        if (n > 256) {
            if (sh) {
                const LAS float* cp = (lane < 2 * nj) ? (sc + wid * IX_ROW + lane * 32 + 4 * (lane >> 1)) : (const LAS float*)(F.lds + IX_NEG);
#pragma unroll
                for (int i = 0; i < 8; ++i) { const f32x4 x = *(const LAS f32x4*)(cp + 4 * i); v[4 * i] = x[0]; v[4 * i + 1] = x[1]; v[4 * i + 2] = x[2]; v[4 * i + 3] = x[3]; }
#pragma unroll
                for (int i = 32; i < 64; ++i) v[i] = -__builtin_inff();
            } else {
                const LAS float* cp = (lane < nj) ? (sc + wid * IX_ROW + lane * 68) : (const LAS float*)(F.lds + IX_NEG);
#pragma unroll
                for (int i = 0; i < 16; ++i) { const f32x4 x = *(const LAS f32x4*)(cp + 4 * i); v[4 * i] = x[0]; v[4 * i + 1] = x[1]; v[4 * i + 2] = x[2]; v[4 * i + 3] = x[3]; }
            }
#pragma unroll
            for (int w = 0; w < NWAVES; ++w) { ssum_ += st[w * 16 + wid * 2]; ssq_ += st[w * 16 + wid * 2 + 1]; }
        } else {
#pragma unroll
            for (int i = 0; i < 64; ++i) v[i] = 0.f;
        }
        __syncthreads();
        unsigned mlo = 0u, mhi = 0u;
        if (n <= 256) {
            const int rem = n - 64 * lane;
            if (rem > 0) { mlo = rem >= 32 ? 0xFFFFFFFFu : ((1u << rem) - 1u); mhi = rem >= 64 ? 0xFFFFFFFFu : (rem > 32 ? ((1u << (rem - 32)) - 1u) : 0u); }
        } else {
            const float fn = (float)n, rfn = __builtin_amdgcn_rcpf(fn), mean = ssum_ * rfn; const float var = fmaxf(ssq_ * rfn - mean * mean, 1e-20f), sd = __builtin_amdgcn_sqrtf(var);
            const float zq = -probit(256.f * rfn);
            const float dens = fmaxf(fn * 0.3989423f * __expf(-0.5f * zq * zq) * __builtin_amdgcn_rcpf(sd), 1e-3f);
            float xl = -3.0e38f, xh = __builtin_inff(), cl = fn, ch = 0.f; bool hasL = false, hasH = false; int side = 0, zst = 0;
            float x = mean + fminf(fmaxf(zq, -6.f), 6.f) * sd, step = 0.f; unsigned na = 0u, nb = 0u;
            float tie_v = 0.f; int tie_need = 0;
            const float DMIN = __builtin_bit_cast(float, 1u);
            int it = 0; unsigned kl2 = fkey(xl), kh2 = fkey(xh);
            for (;;) {
                ++it;
                unsigned kx = fkey(x);
                if (!(kx > kl2 && kx < kh2)) kx = kl2 + ((kh2 - kl2) >> 1);
                x = fkey_inv(kx);
                const unsigned c = eval_any(v, x, na, nb, sh);
                if (c == 256u) break;
                if (c > 256u) { xl = x; kl2 = kx; cl = (float)c; hasL = true; if (side == 1) ch = 256.f + 0.5f * (ch - 256.f); side = 1; }
                else          { xh = x; kh2 = kx; ch = (float)c; hasH = true; if (side == 2) cl = 256.f + 0.5f * (cl - 256.f); side = 2; }
                if (kh2 - kl2 <= 1u) {
                    const unsigned chx = eval_any(v, xh, na, nb, sh); tie_v = xl; tie_need = 256 - (int)chx; break; }
                if (!(hasL && hasH)) { step = (step == 0.f) ? fminf(fabsf((float)c - 256.5f) * __builtin_amdgcn_rcpf(dens) * 1.25f + 0.02f * sd, 2.f * sd) : 2.f * step; x = (c > 256u) ? x + step : x - step; }
                else if (zst == 0 && it >= 2 && xl <= 0.f && xh > DMIN) { zst = 1; x = DMIN; }
                else if (zst == 1 && xh == DMIN && xl < 0.f) { zst = 2; x = 0.f; }
                else if (it >= 8 && (it & 1)) x = fkey_inv(kl2 + ((kh2 - kl2) >> 1));
                else x = xl + (xh - xl) * ((cl - 256.5f) * __builtin_amdgcn_rcpf(cl - ch));
            }
            mlo = ~na; mhi = ~nb;
            if (tie_need > 0) {
                unsigned ce = 0;
#pragma unroll
                for (int i = 0; i < 64; ++i) ce += (v[i] == tie_v) ? 1u : 0u;
                unsigned pre = ce;
#pragma unroll
                for (int o = 1; o < 64; o <<= 1) { const unsigned y = __shfl_up(pre, o); pre += (lane >= o) ? y : 0u; }
                int allow = tie_need - (int)(pre - ce); allow = allow < 0 ? 0 : allow;
#pragma unroll
                for (int i = 0; i < 64; ++i) { if (v[i] == tie_v && allow > 0) { if (i < 32) mlo |= 1u << i; else mhi |= 1u << (i - 32); --allow; } }
            }
        }
        if (sh && n > 256) {
            const unsigned oth = (unsigned)__builtin_amdgcn_update_dpp(0, (int)mlo, 0xB1, 0xf, 0xf, false);
            const int T = lane >> 1;
            if (!(lane & 1) && T <= 4 * (t0 >> 8) + 3) BM[((size_t)b * 64 + T) * 4096 + t] = ((u64)oth << 32) | mlo;
        } else if (lane <= 4 * (t0 >> 8) + 3) BM[((size_t)b * 64 + lane) * 4096 + t] = ((u64)mhi << 32) | mlo;
    }
    __syncthreads();
}

constexpr int AL_K = 0, AL_V = 16384, AL_M = 32768, AL_LUT = 36864, AL_WS = 37888, AL_GN = 39936, AL_OST = 40960;
constexpr int OST_STRIDE = 68;
__device__ __forceinline__ float sel_bfi(unsigned m, unsigned a, unsigned b) { unsigned d; asm("v_bfi_b32 %0, %1, %2, %3" : "=v"(d) : "v"(m), "v"(a), "s"(b)); return __builtin_bit_cast(float, d); }
__device__ __forceinline__ int crow(int r, int hi) { return (r & 3) + 8 * (r >> 2) + 4 * hi; }
struct AttnPre { u32x4 k0, v0, k1, v1; u64 m0, m1; f16x8 q[4]; };
__device__ __forceinline__ void attn_prefetch(Frame& F, int b, int h, int qb, AttnPre& P) {
    const int lane = F.lane, wid = F.wave, r32 = lane & 31, hi = lane >> 5; const int q0 = qb * 256;
    const h16* ksrc = (const h16*)(F.ws + WS_K) + (size_t)(b * 8 + h) * 64 * 4096 + wid * 512 + lane * 8; const h16* vsrc = (const h16*)(F.ws + WS_V) + (size_t)(b * 8 + h) * 64 * 4096 + wid * 512 + lane * 8;
    const u64* msrc = (const u64*)(F.ws + WS_BM) + (size_t)b * 64 * 4096 + q0 + wid * 32 + r32;
    P.k0 = *(const u32x4*)ksrc; P.v0 = *(const u32x4*)vsrc; P.k1 = *(const u32x4*)(ksrc + 4096); P.v1 = *(const u32x4*)(vsrc + 4096); P.m0 = msrc[0]; P.m1 = msrc[4096];
    const h16* qp = (const h16*)(F.ws + WS_Q) + ((size_t)b * SEQ + q0 + wid * 32 + r32) * 512 + h * 64 + hi * 8;
#pragma unroll
    for (int d0 = 0; d0 < 4; ++d0) P.q[d0] = *(const f16x8*)(qp + d0 * 16);
}
__device__ __forceinline__ void attn_unit(Frame& F, int b, int h, int qb, int qbn, float cfar, AttnPre& P) {
    const h16* Q = (const h16*)(F.ws + WS_Q); const h16* Kg = (const h16*)(F.ws + WS_K); const h16* Vg = (const h16*)(F.ws + WS_V); const u64* BM = (const u64*)(F.ws + WS_BM);
    h16* MG = (h16*)(F.ws + WS_MERGED);
    const int tid = F.tid, lane = F.lane, wid = F.wave, r32 = lane & 31, hi = lane >> 5, grp = wid >> 2;
    const size_t rowb = (size_t)b * SEQ; const int q0 = qb * 256;
    LAS unsigned char* L = F.lds;
    LAS float* lut = (LAS float*)(L + AL_M); LAS float* wsf = (LAS float*)(L + AL_WS) + wid * 64; LAS float* ost = (LAS float*)(L + AL_OST) + wid * (32 * OST_STRIDE);
    const int NT = (q0 + 256) / 64;
    const h16* ksrc = Kg + (size_t)(b * 8 + h) * 64 * 4096 + wid * 512 + lane * 8;
    const h16* vsrc = Vg + (size_t)(b * 8 + h) * 64 * 4096 + wid * 512 + lane * 8;
    const u64* msrc = BM + (size_t)b * 64 * 4096 + q0 + wid * 32 + r32;
    u32x4 kreg, vreg;
#define A_LOAD(t) do { kreg = *(const u32x4*)(ksrc + (size_t)(t) * 4096); vreg = *(const u32x4*)(vsrc + (size_t)(t) * 4096); } while (0)
#define A_STORE(buf) do { *(LAS u32x4*)(L + AL_K + (buf) * 8192 + wid * 1024 + lane * 16) = kreg; *(LAS u32x4*)(L + AL_V + (buf) * 8192 + wid * 1024 + lane * 16) = vreg; } while (0)
#define A_BAR() asm volatile("s_barrier" ::: "memory")
    const int qpos = q0 + wid * 32 + r32;
    const int qmin = q0 + wid * 32;
    const unsigned NEGINF = 0xFF800000u;
    float mref = 0.f, lrun = 0.f; bool hasmass = false; f32x16 o[2]; o[0] = f32x16{}; o[1] = f32x16{};
    f32x16 p0, p1;
#define A_COP(t_, mw_) do { const unsigned wl = (unsigned)(mw_) >> (4 * hi), wh = (unsigned)((mw_) >> 32) >> (4 * hi); \
        if ((qmin - (64 * (t_) + 63)) >= 128) { const unsigned cb = __builtin_bit_cast(unsigned, cfar - mref); \
            _Pragma("unroll") for (int r = 0; r < 16; ++r) { const int c = (r & 3) + 8 * (r >> 2); const unsigned s0 = (unsigned)__builtin_amdgcn_sbfe((int)wl, c, 1), s1 = (unsigned)__builtin_amdgcn_sbfe((int)wh, c, 1); \
                p0[r] = sel_bfi(s0, cb, NEGINF); p1[r] = sel_bfi(s1, cb, NEGINF); } \
        } else { const LAS float* lp = lut + (qpos - 64 * (t_) - 4 * hi + (96 - 59));     \
            _Pragma("unroll") for (int r = 0; r < 16; ++r) { const int c = (r & 3) + 8 * (r >> 2); \
                const unsigned s0 = (unsigned)__builtin_amdgcn_sbfe((int)wl, c, 1), s1 = (unsigned)__builtin_amdgcn_sbfe((int)wh, c, 1); \
                const unsigned c0 = __builtin_bit_cast(unsigned, lp[59 - c] - mref), c1 = __builtin_bit_cast(unsigned, lp[27 - c] - mref); \
                p0[r] = sel_bfi(s0, c0, NEGINF); p1[r] = sel_bfi(s1, c1, NEGINF); } } } while (0)
    u64 mw = P.m0, mwn = P.m1;
    kreg = P.k1; vreg = P.v1;
    *(LAS u32x4*)(L + AL_K + wid * 1024 + lane * 16) = P.k0; *(LAS u32x4*)(L + AL_V + wid * 1024 + lane * 16) = P.v0;
    f16x8 qr[4];
#pragma unroll
    for (int d0 = 0; d0 < 4; ++d0) qr[d0] = P.q[d0];
    __syncthreads();
    if (grp == 1) A_BAR();
    A_COP(0, mw); mw = mwn;
    const int vboff = ((lane >> 4) & 1) * 32 + (lane & 3) * 8 + (4 * hi + ((lane & 15) >> 2)) * 64;
    const int NTw = (qmin + 31) / 64 + 1;
    for (int t = 0; t < NTw; ++t) {
        const int cur = t & 1;
        f16x8 kfr[8];
        { const LAS unsigned char* kb = L + AL_K + cur * 8192 + hi * 1024 + r32 * 16;
#pragma unroll
          for (int d0 = 0; d0 < 4; ++d0) { kfr[2 * d0] = *(const LAS f16x8*)(kb + d0 * 2048); kfr[2 * d0 + 1] = *(const LAS f16x8*)(kb + d0 * 2048 + 512); } }
        A_STORE(cur ^ 1);
        { const int tl = (t + 2 < NT) ? t + 2 : NT - 1; A_LOAD(tl); mwn = msrc[(size_t)tl * 4096]; }
        s16x4 vlo[8], vhi[8];
        { LAS unsigned char* vb = L + AL_V + cur * 8192 + vboff;
#pragma unroll
          for (int i = 0; i < 8; ++i) { vlo[i] = __builtin_amdgcn_ds_read_tr16_b64_v4i16((LAS s16x4*)(vb + (i >> 2) * 4096 + (i & 3) * 1024)); vhi[i] = __builtin_amdgcn_ds_read_tr16_b64_v4i16((LAS s16x4*)(vb + (i >> 2) * 4096 + (i & 3) * 1024 + 512)); } }
        __builtin_amdgcn_sched_barrier(0);
#pragma unroll
        for (int d0 = 0; d0 < 4; ++d0) { p0 = __builtin_amdgcn_mfma_f32_32x32x16_f16(kfr[2 * d0], qr[d0], p0, 0, 0, 0); p1 = __builtin_amdgcn_mfma_f32_32x32x16_f16(kfr[2 * d0 + 1], qr[d0], p1, 0, 0, 0); }
        __builtin_amdgcn_sched_barrier(0);
        asm volatile("s_waitcnt lgkmcnt(0)\n\ts_barrier" ::: "memory");
        __builtin_amdgcn_sched_barrier(0);
        float rs = 0.f, rs1 = 0.f;
#pragma unroll
        for (int r = 0; r < 16; ++r) { p0[r] = __builtin_amdgcn_exp2f(p0[r]); p1[r] = __builtin_amdgcn_exp2f(p1[r]);
            rs += p0[r]; asm("" : "+v"(rs)); rs1 += p1[r]; asm("" : "+v"(rs1)); }
        rs += rs1;
        float pm; { const auto sw_ = __builtin_amdgcn_permlane32_swap(__builtin_bit_cast(unsigned, rs), __builtin_bit_cast(unsigned, rs), false, false); const unsigned lo_ = sw_[0], hi_ = sw_[1];
          pm = __builtin_bit_cast(float, lo_) + __builtin_bit_cast(float, hi_); }
        const bool need = (pm > 256.f) || (!hasmass && pm > 0.f);
        if (__any(need)) {
            const float f = need ? 1.f / pm : 1.f;
            mref += need ? __builtin_amdgcn_logf(pm) : 0.f;
            rs *= f; lrun *= f;
#pragma unroll
            for (int r = 0; r < 16; ++r) { float a_ = p0[r], b_ = p1[r]; asm("v_mul_f32 %0, %0, %1" : "+v"(a_) : "v"(f)); asm("v_mul_f32 %0, %0, %1" : "+v"(b_) : "v"(f)); p0[r] = a_; p1[r] = b_; }
            if (hi == 0) wsf[r32] = f;
            LDS_WAIT();
#pragma unroll
            for (int r = 0; r < 16; ++r) { const float a = wsf[crow(r, hi)]; o[0][r] *= a; o[1][r] *= a; }
        }
        hasmass = hasmass || (pm > 0.f);
        lrun += rs;
        u32x4 pw[4];
        pw[0] = (u32x4){pk2h(p0[0], p0[1]), pk2h(p0[2], p0[3]), pk2h(p0[4], p0[5]), pk2h(p0[6], p0[7])};
        pw[1] = (u32x4){pk2h(p0[8], p0[9]), pk2h(p0[10], p0[11]), pk2h(p0[12], p0[13]), pk2h(p0[14], p0[15])};
        pw[2] = (u32x4){pk2h(p1[0], p1[1]), pk2h(p1[2], p1[3]), pk2h(p1[4], p1[5]), pk2h(p1[6], p1[7])};
        pw[3] = (u32x4){pk2h(p1[8], p1[9]), pk2h(p1[10], p1[11]), pk2h(p1[12], p1[13]), pk2h(p1[14], p1[15])};
        __builtin_amdgcn_sched_barrier(0);
#pragma unroll
        for (int d0 = 0; d0 < 2; ++d0)
#pragma unroll
            for (int ks = 0; ks < 4; ++ks) { const int i = d0 * 4 + ks;
                typedef short s16x8 __attribute__((ext_vector_type(8)));
                const s16x8 vv = {vlo[i][0], vlo[i][1], vlo[i][2], vlo[i][3], vhi[i][0], vhi[i][1], vhi[i][2], vhi[i][3]};
                o[d0] = __builtin_amdgcn_mfma_f32_32x32x16_f16(__builtin_bit_cast(f16x8, pw[ks]), __builtin_bit_cast(f16x8, vv), o[d0], 0, 0, 0); }
        A_COP(t + 1, mw); mw = mwn;
        A_BAR();
    }
    for (int t = NTw; t < NT; ++t) {
        A_STORE((t & 1) ^ 1);
        { const int tl = (t + 2 < NT) ? t + 2 : NT - 1; A_LOAD(tl); }
        asm volatile("s_waitcnt lgkmcnt(0)\n\ts_barrier" ::: "memory");
        A_BAR();
    }
    if (grp == 0) A_BAR();
    attn_prefetch(F, b, h, qbn, P);
#undef A_LOAD
#undef A_STORE
#undef A_BAR
#undef A_COP
    lrun += __shfl_xor(lrun, 32);
    if (hi == 0) wsf[r32] = 1.f / lrun;
    LDS_WAIT();
#pragma unroll
    for (int r = 0; r < 16; ++r) { const float rl = wsf[crow(r, hi)]; const int qrow = crow(r, hi);
        ost[qrow * OST_STRIDE + r32] = o[0][r] * rl; ost[qrow * OST_STRIDE + 32 + r32] = o[1][r] * rl; }
    LDS_WAIT();
    { const int row = lane >> 1, hf = lane & 1; const LAS float* rp = ost + row * OST_STRIDE + hf * 32;
      f32x4 xv[8]; float ss = 0.f;
#pragma unroll
      for (int i = 0; i < 8; ++i) { xv[i] = *(const LAS f32x4*)(rp + 4 * i); ss += (xv[i][0] * xv[i][0] + xv[i][1] * xv[i][1]) + (xv[i][2] * xv[i][2] + xv[i][3] * xv[i][3]); }
      ss += __shfl_xor(ss, 1);
      const float rstd = rsqrtf(ss * (1.f / 64.f) + EPS);
      const LAS float* gn = (const LAS float*)(L + AL_GN) + hf * 32;
      h16* op = MG + (rowb + q0 + wid * 32 + row) * 1024 + h * 64 + hf * 32;
#pragma unroll
      for (int i = 0; i < 4; ++i) { const f32x4 g0 = *(const LAS f32x4*)(gn + 8 * i), g1 = *(const LAS f32x4*)(gn + 8 * i + 4);
          *(u32x4*)(op + 8 * i) = pk8h(xv[2 * i] * rstd * g0, xv[2 * i + 1] * rstd * g1); } }
    __syncthreads();
}
__device__ __forceinline__ void p4_attention(Frame& F) {
    const int bh = F.vcu >> 2, c = F.vcu & 3, b = bh >> 3, h = bh & 7;
    { LAS float* lut = (LAS float*)(F.lds + AL_M);
      if (F.tid < 320) { const int d = F.tid - 96; lut[F.tid] = d < 0 ? 0.f : F.in[2][T5_BKT[d > 128 ? 128 : d] * 8 + h] * LOG2E; }
      if (F.tid >= 192 && F.tid < 256) ((LAS float*)(F.lds + AL_GN))[F.tid - 192] = F.in[10][h * 64 + F.tid - 192]; }
    const float cfar = F.in[2][31 * 8 + h] * LOG2E;
    AttnPre P; attn_prefetch(F, b, h, 2 * c, P);
    __syncthreads();
    for (int i = 0; i < 4; ++i) { const int qb = (i == 0) ? 2 * c : (i == 1) ? 15 - 2 * c : (i == 2) ? 2 * c + 1 : 14 - 2 * c; const int qbn = (i == 0) ? 15 - 2 * c : (i == 1) ? 2 * c + 1 : 14 - 2 * c;
        attn_unit(F, b, h, qb, qbn, cfar, P); }
}

__device__ __forceinline__ void p6_norm2_route(Frame& F) {
    const float* mod = (const float*)(F.ws + WS_MOD); const float* g2 = F.in[13]; h16* H2 = (h16*)(F.ws + WS_H); const float* x0 = F.in[0]; const h16* AO = (const h16*)(F.ws + WS_AO);
    const h16* WRLg = (const h16*)(F.ws + WS_WRL);
    LAS h16* wrl = (LAS h16*)F.lds;
    LAS unsigned* lcnt = (LAS unsigned*)(F.lds + 73728);
    LAS unsigned* lbase = lcnt + 32;
    LAS unsigned* rinfo = (LAS unsigned*)(F.lds + 73728 + 256);
    for (int i = F.tid; i < 36 * 1024 / 8; i += NTHR) *(LAS u32x4*)(wrl + i * 8) = *(const u32x4*)(WRLg + i * 8);
    if (F.tid < 32) lcnt[F.tid] = 0u;
    __syncthreads();
    const int b = F.vcu >> 5;
    const float* bgr = F.in[15]; const float* ber = F.in[17];
    f32x4 gg[4], hh[4], g1[4];
#pragma unroll
    for (int j = 0; j < 4; ++j) { const int col = 4 * F.lane + 256 * j; gg[j] = *(const f32x4*)(g2 + col) * (*(const f32x4*)(mod + (size_t)b * 6144 + 4096 + col) + 1.f); hh[j] = *(const f32x4*)(mod + (size_t)b * 6144 + 3072 + col);
        g1[j] = *(const f32x4*)(mod + (size_t)b * 6144 + 2048 + col); }
    f32x4 vn[4]; f16x4 an[4];
    { const size_t row = (size_t)F.vcu * 128 + F.wave * 16;
#pragma unroll
      for (int j = 0; j < 4; ++j) { vn[j] = NT_LD(f32x4, x0 + row * 1024 + 4 * F.lane + 256 * j); an[j] = *(const f16x4*)(AO + row * 1024 + 4 * F.lane + 256 * j); } }
    for (int rr = 0; rr < 16; ++rr) {
        const int lrow = F.wave * 16 + rr; const size_t row = (size_t)F.vcu * 128 + lrow; const size_t rown = row + (rr < 15 ? 1 : 0);
        f32x4 v[4]; float ss = 0.f;
#pragma unroll
        for (int j = 0; j < 4; ++j) { const f16x4 a4 = an[j]; const f32x4 af = {(float)a4[0], (float)a4[1], (float)a4[2], (float)a4[3]}; v[j] = vn[j] + g1[j] * af;
            vn[j] = NT_LD(f32x4, x0 + rown * 1024 + 4 * F.lane + 256 * j); an[j] = *(const f16x4*)(AO + rown * 1024 + 4 * F.lane + 256 * j);
            ss += (v[j][0] * v[j][0] + v[j][1] * v[j][1]) + (v[j][2] * v[j][2] + v[j][3] * v[j][3]); }
        const float rstd = rsqrtf(dpp_sum_f32(ss) * (1.f / 1024.f) + EPS);
#pragma unroll
        for (int j = 0; j < 4; ++j) { v[j] = v[j] * rstd * gg[j] + hh[j]; u32x2 w; w.x = pk2h(v[j][0], v[j][1]); w.y = pk2h(v[j][2], v[j][3]); *(u32x2*)(H2 + row * 1024 + 4 * F.lane + 256 * j) = w; }
        float lg[4];
#pragma unroll
        for (int o = 0; o < 4; ++o) { const f16x8 wa = *(const LAS f16x8*)(wrl + (o * 64 + F.lane) * 16), wb = *(const LAS f16x8*)(wrl + (o * 64 + F.lane) * 16 + 8);
            float s = 0.f;
#pragma unroll
            for (int i = 0; i < 4; ++i) { s += v[0][i] * (float)wa[i]; s += v[1][i] * (float)wa[4 + i]; s += v[2][i] * (float)wb[i]; s += v[3][i] * (float)wb[4 + i]; }
            lg[o] = dpp_sum_f32(s) + bgr[o]; }
        int gs = 0; float gm = lg[0];
#pragma unroll
        for (int g = 1; g < 4; ++g) if (lg[g] > gm) { gm = lg[g]; gs = g; }
        float gden = 0.f;
#pragma unroll
        for (int g = 0; g < 4; ++g) gden += __expf(lg[g] - gm);
        const float pg = 1.f / gden;
        gs = __builtin_amdgcn_readfirstlane(gs);
        float el[8];
        { const LAS h16* wsel = wrl + ((4 + 8 * gs) * 64 + F.lane) * 16; const float* bsel = ber + 8 * gs;
#pragma unroll
          for (int e = 0; e < 8; ++e) { const f16x8 wa = *(const LAS f16x8*)(wsel + e * 1024), wb = *(const LAS f16x8*)(wsel + e * 1024 + 8);
            float s = 0.f;
#pragma unroll
            for (int i = 0; i < 4; ++i) { s += v[0][i] * (float)wa[i]; s += v[1][i] * (float)wa[4 + i]; s += v[2][i] * (float)wb[i]; s += v[3][i] * (float)wb[4 + i]; }
            el[e] = dpp_sum_f32(s) + bsel[e]; } }
        int e0 = 0; float m0 = el[0];
#pragma unroll
        for (int e = 1; e < 8; ++e) if (el[e] > m0) { m0 = el[e]; e0 = e; }
        int e1 = -1; float m1 = -__builtin_inff();
#pragma unroll
        for (int e = 0; e < 8; ++e) if (e != e0 && el[e] > m1) { m1 = el[e]; e1 = e; }
        const float p1 = __expf(m1 - m0); const float w0 = pg / (1.f + p1), w1 = pg * p1 / (1.f + p1);
        if (F.lane == 0) {
            const unsigned E0 = (unsigned)(gs * 8 + e0), E1 = (unsigned)(gs * 8 + e1);
            const unsigned r0 = atomicAdd((unsigned*)(lcnt + E0), 1u), r1 = atomicAdd((unsigned*)(lcnt + E1), 1u);
            rinfo[lrow * 8 + 0] = E0; rinfo[lrow * 8 + 1] = r0; rinfo[lrow * 8 + 2] = __builtin_bit_cast(unsigned, w0);
            rinfo[lrow * 8 + 3] = E1; rinfo[lrow * 8 + 4] = r1; rinfo[lrow * 8 + 5] = __builtin_bit_cast(unsigned, w1);
        }
    }
    __syncthreads();
    unsigned* gcnt = (unsigned*)(F.ws + WS_CTL) + CW_GCNT;
    if (F.tid < 32) lbase[F.tid] = atomicAdd(gcnt + F.tid, lcnt[F.tid]);
    __syncthreads();
    if (F.tid < 128) { unsigned* ro = (unsigned*)(F.ws + WS_ROUTE) + ((size_t)F.vcu * 128 + F.tid) * 8;
        const unsigned E0 = rinfo[F.tid * 8 + 0], E1 = rinfo[F.tid * 8 + 3];
        ro[0] = E0; ro[1] = lbase[E0] + rinfo[F.tid * 8 + 1]; ro[2] = rinfo[F.tid * 8 + 2]; ro[3] = E1; ro[4] = lbase[E1] + rinfo[F.tid * 8 + 4]; ro[5] = rinfo[F.tid * 8 + 5]; }
    __syncthreads();
}
__device__ __forceinline__ void expert_offsets(Frame& F, LAS unsigned* off) {
    const unsigned* gcnt = (const unsigned*)(F.ws + WS_CTL) + CW_GCNT;
    if (F.tid == 0) { unsigned a = 0; for (int e = 0; e < 32; ++e) { off[e] = a; a += (__hip_atomic_load(gcnt + e, RLX_AGENT) + 255u) & ~255u; } off[32] = a; }
    __syncthreads();
}
__device__ __forceinline__ void p7_rowmap(Frame& F) {
    LAS unsigned* off = (LAS unsigned*)F.lds;
    expert_offsets(F, off);
    int* rowmap = (int*)(F.ws + WS_ROWMAP); const unsigned* gcnt = (const unsigned*)(F.ws + WS_CTL) + CW_GCNT; int* tile_e = (int*)(F.ws + WS_CTL) + 1024;
    if (F.tid < 128) { const size_t tok = (size_t)F.vcu * 128 + F.tid; const unsigned* ro = (const unsigned*)(F.ws + WS_ROUTE) + tok * 8;
        rowmap[off[ro[0]] + ro[1]] = (int)tok; rowmap[off[ro[3]] + ro[4]] = (int)tok; }
    if (F.vcu < 32) { const int e = F.vcu; const unsigned c = __hip_atomic_load(gcnt + e, RLX_AGENT); for (unsigned r = off[e] + c + F.tid; r < off[e + 1]; r += NTHR) rowmap[r] = -1;
        for (unsigned t = off[e] / 256 + F.tid; t < off[e + 1] / 256; t += NTHR) tile_e[t] = e; }
    __syncthreads();
}
__device__ __forceinline__ void p10_combine(Frame& F) {
    LAS unsigned* off = (LAS unsigned*)F.lds;
    expert_offsets(F, off);
    const float* mod = (const float*)(F.ws + WS_MOD); const h16* Y = (const h16*)(F.ws + WS_Y); float* out = F.out; const float* x0 = F.in[0]; const h16* AO = (const h16*)(F.ws + WS_AO);
    const int b = F.vcu >> 5;
    f32x4 g2[4], g1[4];
#pragma unroll
    for (int j = 0; j < 4; ++j) { g2[j] = *(const f32x4*)(mod + (size_t)b * 6144 + 5120 + 4 * F.lane + 256 * j); g1[j] = *(const f32x4*)(mod + (size_t)b * 6144 + 2048 + 4 * F.lane + 256 * j); }
    const size_t rowbase = (size_t)F.vcu * 128 + F.wave * 16;
    unsigned P0l = 0u, P1l = 0u; float C0l = 0.f, C1l = 0.f;
    if (F.lane < 16) { const unsigned* ro = (const unsigned*)(F.ws + WS_ROUTE) + (rowbase + F.lane) * 8; P0l = off[ro[0]] + ro[1]; P1l = off[ro[3]] + ro[4]; C0l = __builtin_bit_cast(float, ro[2]); C1l = __builtin_bit_cast(float, ro[5]); }
    f16x4 y0n[4], y1n[4], an[4]; f32x4 xn[4];
    { const size_t p0 = (unsigned)__shfl((int)P0l, 0), p1 = (unsigned)__shfl((int)P1l, 0);
#pragma unroll
      for (int j = 0; j < 4; ++j) { const int col = 4 * F.lane + 256 * j; y0n[j] = NT_LD(f16x4, Y + p0 * 1024 + col); y1n[j] = NT_LD(f16x4, Y + p1 * 1024 + col); xn[j] = NT_LD(f32x4, x0 + rowbase * 1024 + col); an[j] = NT_LD(f16x4, AO + rowbase * 1024 + col); } }
    for (int rr = 0; rr < 16; ++rr) {
        const size_t row = rowbase + rr; const int rn = rr < 15 ? rr + 1 : rr;
        const float c0 = __shfl(C0l, rr), c1 = __shfl(C1l, rr);
        const size_t p0n = (unsigned)__shfl((int)P0l, rn), p1n = (unsigned)__shfl((int)P1l, rn);
#pragma unroll
        for (int j = 0; j < 4; ++j) { const int col = 4 * F.lane + 256 * j;
            const f16x4 y0 = y0n[j], y1 = y1n[j], a4 = an[j]; f32x4 xv = xn[j];
            y0n[j] = NT_LD(f16x4, Y + p0n * 1024 + col); y1n[j] = NT_LD(f16x4, Y + p1n * 1024 + col); xn[j] = NT_LD(f32x4, x0 + (rowbase + rn) * 1024 + col); an[j] = NT_LD(f16x4, AO + (rowbase + rn) * 1024 + col);
#pragma unroll
            for (int i = 0; i < 4; ++i) xv[i] = (xv[i] + g1[j][i] * (float)a4[i]) + g2[j][i] * (c0 * (float)y0[i] + c1 * (float)y1[i]);
            NT_ST(f32x4, out + row * 1024 + col, xv); }
    }
}
constexpr int N_PHASES = 12;
__global__ void __launch_bounds__(NTHR, 2) mega_fwd(Args args) {
    extern __shared__ __attribute__((aligned(16))) unsigned char lds_raw[];
    Frame F;
    F.lds = (LAS unsigned char*)lds_raw; F.ldsg = lds_raw;
    F.tid = threadIdx.x; F.lane = F.tid & 63; F.wave = __builtin_amdgcn_readfirstlane(F.tid >> 6);
    F.G = gridDim.x; { const int bx = blockIdx.x; F.vcu = (F.G % 8 == 0) ? (bx % 8) * (F.G / 8) + bx / 8 : bx; }
    F.in = (const float* const __attribute__((address_space(4)))*)__builtin_amdgcn_kernarg_segment_ptr();
    F.out = args.out; F.ws = args.ws;
    volatile LAS unsigned* MISC = (volatile LAS unsigned*)(F.lds + MISC_OFF);
    if (F.tid < 16) MISC[F.tid] = 0u;
    __syncthreads();
    const int lo = args.ph_lo, hi = args.ph_hi;
    XcdBarrier bar; bar.bar = (unsigned*)(F.ws + WS_CTL) + CW_BAR; bar.x = 0; bar.st = nullptr;
    if (hi - lo > 1) bar = xcd_barrier_post((unsigned*)(F.ws + WS_CTL) + CW_BAR, MISC + 8);
#define IN(k) (lo <= (k) && (k) < hi)
#define STAMP(k) do {} while (0)
#define SEAM(k) do { if (IN(k) && IN((k) + 1)) xcd_barrier(bar); STAMP((k) + 1); } while (0)
    STAMP(0);
    if (IN(0)) { p0_prologue(F); }
    if (lo < 0) { cg::this_grid().sync(); }
    SEAM(0);
    if (IN(1)) { p1_norm1(F); }
    SEAM(1);
    if (IN(2)) {
        pg8::Gemm g{(const h16*)(F.ws + WS_H), (const h16*)(F.ws + WS_WINT), M, NINP, DM, 0, nullptr}; pg8::StaticOrder S; S.init(M, NINP - 256, F.G, (int)blockIdx.x, 8);
        EpiInProj E{(h16*)(F.ws + WS_Q), (h16*)(F.ws + WS_K), (h16*)(F.ws + WS_V), (h16*)(F.ws + WS_QI), (h16*)(F.ws + WS_KI), (h16*)(F.ws + WS_GB), (h16*)(F.ws + WS_Z), (float*)(F.ws + WS_WI), F.in[7], F.in[8]};
        pg8::gemm_phase<EpiInProj, pg8::StaticOrder, false>(F.lds, g, S, E);
        pg8::ColumnOrder S8{8, M / 256, F.G, F.vcu};
        pg8::gemm_phase<EpiInProj, pg8::ColumnOrder, false, true>(F.lds, g, S8, E);
    }
    SEAM(2);
    if (IN(3)) { p3_conv(F); p3_indexer(F); }
    SEAM(3);
    if (IN(4)) { p4_attention(F); }
    SEAM(4);
    if (IN(5)) {
        pg8::Gemm g{(const h16*)(F.ws + WS_MERGED), (const h16*)(F.ws + WS_WOUTT), M, DM, DM, 0, nullptr}; pg8::StaticOrder S; S.init(M, DM, F.G, (int)blockIdx.x);
        EpiMoeDown E{(h16*)(F.ws + WS_AO)};
        pg8::gemm_phase<EpiMoeDown, pg8::StaticOrder, false>(F.lds, g, S, E);
    }
    SEAM(5);
    if (IN(6)) { p6_norm2_route(F); }
    SEAM(6);
    if (IN(7)) { p7_rowmap(F); }
    SEAM(7);
    if (IN(8) || IN(9) || IN(10)) {
        LAS unsigned* off = (LAS unsigned*)(F.lds + RING_BYTES); expert_offsets(F, off); const int ntiles = (int)(off[32] / 256u); __syncthreads();
        const int* tile_e = (const int*)(F.ws + WS_CTL) + 1024;
        const int n8 = 2 * ntiles, R8 = n8 / F.G, rem8 = n8 - R8 * F.G;
        const int pmA = (R8 * F.G) / 2;
        const int n9 = 4 * ntiles; constexpr int PB = 4, PA = 2;
        int nB = PB * (F.G - rem8) + PA * rem8; nB = nB < 4 * pmA ? nB : 4 * pmA; nB = nB < n9 ? nB : n9;
        const pg8::Gemm gU{(const h16*)(F.ws + WS_H), (const h16*)(F.ws + WS_WGUT), 0, 512, DM, (size_t)512 * 1024 * 2, (const int*)(F.ws + WS_ROWMAP)};
        const pg8::Gemm gD{(const h16*)(F.ws + WS_HID), (const h16*)(F.ws + WS_WDT), 0, 1024, EFF, (size_t)1024 * 256 * 2, nullptr};
        const EpiMoeUp EU{(h16*)(F.ws + WS_HID)}; const EpiMoeDown ED{(h16*)(F.ws + WS_Y)};
        if (IN(8)) { pg8::GroupedOrder S{tile_e, 2, F.vcu, F.G, R8}; pg8::gemm_phase<EpiMoeUp, pg8::GroupedOrder, true>(F.lds, gU, S, EU); }
        SEAM(8);
        if (IN(9)) {
            if (F.vcu < rem8) { pg8::GroupedOrder S{tile_e, 2, R8 * F.G + F.vcu, F.G, 1}; pg8::gemm_phase<EpiMoeUp, pg8::GroupedOrder, true>(F.lds, gU, S, EU); }
            { const bool up = F.vcu < rem8; const int f = up ? PB * (F.G - rem8) + PA * F.vcu : PB * (F.vcu - rem8); const int cap = up ? PA : PB; int n = nB - f; n = n < 0 ? 0 : (n > cap ? cap : n);
              pg8::GroupedOrder S{tile_e, 4, f, 1, n}; pg8::gemm_phase<EpiMoeDown, pg8::GroupedOrder, false>(F.lds, gD, S, ED); }
        }
        SEAM(9);
        if (IN(10)) { const int f = nB + F.vcu; const int n = f < n9 ? (n9 - f + F.G - 1) / F.G : 0;
            pg8::GroupedOrder S{tile_e, 4, f, F.G, n}; pg8::gemm_phase<EpiMoeDown, pg8::GroupedOrder, false>(F.lds, gD, S, ED); }
    }
    SEAM(10);
    if (IN(11)) { p10_combine(F); }

#undef IN
#undef SEAM
}

extern "C" void kernel_launch(void* const* d_in, const int* in_sizes, int n_in, void* d_out, int out_size, void* d_ws, size_t ws_size, hipStream_t stream) {
    static int grid = 0;
    if (grid == 0) {
        if (n_in != 21 || out_size != M * DM || ws_size < WS_END) { fprintf(stderr, "kernel_launch: unexpected shapes (n_in %d out %d ws %zu)\n", n_in, out_size, ws_size); grid = -1; return; }
        int dev = 0, cus = 0, per_cu = 0;
        (void)hipGetDevice(&dev); (void)hipDeviceGetAttribute(&cus, hipDeviceAttributeMultiprocessorCount, dev);
        if (hipFuncSetAttribute((const void*)mega_fwd, hipFuncAttributeMaxDynamicSharedMemorySize, LDS_BYTES) != hipSuccess) { fprintf(stderr, "kernel_launch: hipFuncSetAttribute failed\n"); grid = -1; return; }
        if (hipOccupancyMaxActiveBlocksPerMultiprocessor(&per_cu, (const void*)mega_fwd, NTHR, LDS_BYTES) != hipSuccess || per_cu < 1) { fprintf(stderr, "kernel_launch: occupancy query says %d\n", per_cu); per_cu = 1; }
        (void)hipGetLastError();
        grid = cus;
        if (grid != 256) { fprintf(stderr, "kernel_launch: built for 256 CUs, got %d\n", grid); }
    }
    if (grid < 0) return;
    (void)hipMemsetAsync((char*)d_ws + WS_CTL, 0, CTL_ZERO_BYTES, stream);
    Args a{};
    for (int i = 0; i < 21; ++i) a.in[i] = (const float*)d_in[i];
    a.out = (float*)d_out; a.ws = (unsigned char*)d_ws;
#if MK_N_LAUNCHES == 1
    a.ph_lo = 0; a.ph_hi = N_PHASES;
    void* kargs[] = {&a};
    hipError_t e = hipLaunchCooperativeKernel((const void*)mega_fwd, dim3(grid), dim3(NTHR), kargs, LDS_BYTES, stream);
    if (e != hipSuccess) fprintf(stderr, "cooperative launch failed: %s\n", hipGetErrorString(e));
#else
    for (int p = 0; p < N_PHASES; ++p) { a.ph_lo = p; a.ph_hi = p + 1; hipLaunchKernelGGL(mega_fwd, dim3(grid), dim3(NTHR), LDS_BYTES, stream, a); }
#endif
}
```
